# Optimizing an MI355X kernel written in HIP

```python
import jax, jax.numpy as jnp
from jax import lax
import numpy as np

D_MODEL = 1024
BATCH = 16
SEQ = 256
DEPTH = 4
DEC_BATCH = 4
DEC_SEQ = 4096
PAST_LEN = 256

GRID_W = 64
N_MIXERS = 3
N_A = (DEPTH + 2) // 3
N_B = (DEPTH + 1) // 3
N_C = DEPTH // 3
N_HEADS = 16
KV_HEADS = 4
GROUP = N_HEADS // KV_HEADS
HEAD_DIM = 64
QKV_DIM = (N_HEADS + 2 * KV_HEADS) * HEAD_DIM
WINDOW = 128
BLOCK = 128
Q_LORA = 384
KV_LORA = 256
NOPE_DIM = 64
ROPE_DIM = 32
V_DIM = 64
D_FF = 4 * D_MODEL
ROPE_THETA = 10000.0
EPS = 1e-6
NEG_INF = -1e30
ATTN_SCALE = HEAD_DIM ** -0.5
MLA_SCALE = (NOPE_DIM + ROPE_DIM) ** -0.5

kernel_name = 'hybrid_diffusion_prefix_trunk_step'


def rmsnorm(x, g):
    xf = x.astype(jnp.float32)
    y = xf * lax.rsqrt(jnp.mean(xf * xf, axis=-1, keepdims=True) + EPS)
    return (y * g.astype(jnp.float32)).astype(x.dtype)


def grid_positions(t_len):
    n_rows = t_len // GRID_W
    rows = jnp.repeat(jnp.arange(n_rows), GRID_W).astype(jnp.float32)
    cols = jnp.tile(jnp.arange(GRID_W), n_rows).astype(jnp.float32)
    return rows, cols


def _rope_1d(x, pos):
    d = x.shape[-1]
    freqs = ROPE_THETA ** (-jnp.arange(0, d, 2, dtype=jnp.float32) / d)
    ang = pos[:, None] * freqs[None, :]
    cos = jnp.cos(ang)[:, None, :].astype(x.dtype)
    sin = jnp.sin(ang)[:, None, :].astype(x.dtype)
    x1, x2 = jnp.split(x, 2, axis=-1)
    return jnp.concatenate([x1 * cos - x2 * sin, x1 * sin + x2 * cos], axis=-1)


def rope_2d(x, rows, cols):
    half = x.shape[-1] // 2
    return jnp.concatenate([_rope_1d(x[..., :half], rows), _rope_1d(x[..., half:], cols)], axis=-1)


def ada_mod(cond, w, b):
    m = jax.nn.silu(cond) @ w + b
    return jnp.split(m[..., None, :], 6, axis=-1)


def modulate(h, shift, scale):
    return h * (1.0 + scale) + shift


def attend(q, k, v, scale, sink=None, mask=None):
    s = jnp.einsum('bqhgd,bkhd->bhgqk', q, k, preferred_element_type=jnp.float32) * scale
    if mask is not None:
        s = jnp.where(mask, s, NEG_INF)
    if sink is not None:
        sink_col = jnp.broadcast_to(sink.astype(jnp.float32)[None, :, :, None, None], s.shape[:-1] + (1,))
        p = jax.nn.softmax(jnp.concatenate([sink_col, s], axis=-1), axis=-1)[..., 1:]
    else:
        p = jax.nn.softmax(s, axis=-1)
    return jnp.einsum('bhgqk,bkhd->bqhgd', p.astype(v.dtype), v)


def merge_blocks(o):
    o = jnp.moveaxis(o, 0, 1)
    return o.reshape((o.shape[0], o.shape[1] * o.shape[2]) + o.shape[3:])


def blocked_attend(q, k, v, scale, sink=None):
    t_len = q.shape[1]

    def one(b):
        qb = lax.dynamic_slice_in_dim(q, b * BLOCK, BLOCK, axis=1)
        return attend(qb, k, v, scale, sink)

    return merge_blocks(lax.map(one, jnp.arange(t_len // BLOCK)))


def split_qkv(qkv):
    b, t, _ = qkv.shape
    q, k, v = jnp.split(qkv, [N_HEADS * HEAD_DIM, (N_HEADS + KV_HEADS) * HEAD_DIM], axis=-1)
    return (q.reshape(b, t, N_HEADS, HEAD_DIM), k.reshape(b, t, KV_HEADS, HEAD_DIM),
            v.reshape(b, t, KV_HEADS, HEAD_DIM))


def mixer_a_context(h, w_qkv, sink, w_o):
    b, s, _ = h.shape
    q, k, v = split_qkv(h @ w_qkv)
    o = blocked_attend(q.reshape(b, s, KV_HEADS, GROUP, HEAD_DIM), k, v, ATTN_SCALE, sink.reshape(KV_HEADS, GROUP))
    return o.reshape(b, s, N_HEADS * HEAD_DIM) @ w_o, k, v


def mixer_a_latent(h, ctx_k, ctx_v, w_qkv, sink, w_o, rows, cols):
    b, t, _ = h.shape
    p_len = ctx_k.shape[1]
    q, k, v = split_qkv(h @ w_qkv)
    q = rope_2d(q, rows, cols).reshape(b, t, KV_HEADS, GROUP, HEAD_DIM)
    k = rope_2d(k, rows, cols)
    pad = ((0, 0), (BLOCK, BLOCK), (0, 0), (0, 0))
    kp = jnp.pad(k, pad)
    vp = jnp.pad(v, pad)
    q_off = jnp.arange(BLOCK)[:, None]
    k_off = jnp.arange(3 * BLOCK)[None, :] - BLOCK
    ctx_mask = jnp.ones((BLOCK, p_len), dtype=bool)
    sink_g = sink.reshape(KV_HEADS, GROUP)

    def one(blk):
        start = blk * BLOCK
        qb = lax.dynamic_slice_in_dim(q, start, BLOCK, axis=1)
        kb = lax.dynamic_slice_in_dim(kp, start, 3 * BLOCK, axis=1)
        vb = lax.dynamic_slice_in_dim(vp, start, 3 * BLOCK, axis=1)
        kpos = start + k_off
        win = (jnp.abs(q_off - k_off) <= WINDOW) & (kpos >= 0) & (kpos < t)
        mask = jnp.concatenate([ctx_mask, win], axis=1)
        return attend(qb, jnp.concatenate([ctx_k, kb], axis=1), jnp.concatenate([ctx_v, vb], axis=1),
                      ATTN_SCALE, sink_g, mask)

    o = merge_blocks(lax.map(one, jnp.arange(t // BLOCK)))
    return o.reshape(b, t, N_HEADS * HEAD_DIM) @ w_o


def mla_project(h, w_dq, g_q, w_uq, w_dkv, g_kv):
    b, t, _ = h.shape
    q = (rmsnorm(h @ w_dq, g_q) @ w_uq).reshape(b, t, N_HEADS, NOPE_DIM + ROPE_DIM)
    ckv = h @ w_dkv
    c_kv = rmsnorm(ckv[..., :KV_LORA], g_kv)
    k_rope = ckv[..., KV_LORA:]
    return q, c_kv, k_rope


def mla_expand(c_kv, k_rope, w_ukv):
    b, t, _ = c_kv.shape
    kv = (c_kv @ w_ukv).reshape(b, t, N_HEADS, NOPE_DIM + V_DIM)
    k_nope, v = kv[..., :NOPE_DIM], kv[..., NOPE_DIM:]
    k = jnp.concatenate([k_nope, jnp.broadcast_to(k_rope[:, :, None, :], (b, t, N_HEADS, ROPE_DIM))], axis=-1)
    return k, v


def mixer_b_context(h, w_dq, g_q, w_uq, w_dkv, g_kv, w_ukv, w_o):
    b, s, _ = h.shape
    q, c_kv, k_rope = mla_project(h, w_dq, g_q, w_uq, w_dkv, g_kv)
    k, v = mla_expand(c_kv, k_rope, w_ukv)
    o = blocked_attend(q[:, :, :, None, :], k, v, MLA_SCALE)
    return o.reshape(b, s, N_HEADS * V_DIM) @ w_o, c_kv, k_rope


def mixer_b_latent(h, ctx_ckv, ctx_krope, w_dq, g_q, w_uq, w_dkv, g_kv, w_ukv, w_o, rows, cols):
    b, t, _ = h.shape
    q, c_kv, k_rope = mla_project(h, w_dq, g_q, w_uq, w_dkv, g_kv)
    q = jnp.concatenate([q[..., :NOPE_DIM], rope_2d(q[..., NOPE_DIM:], rows, cols)], axis=-1)
    k_rope = rope_2d(k_rope[:, :, None, :], rows, cols)[:, :, 0, :]
    k_lat, v_lat = mla_expand(c_kv, k_rope, w_ukv)
    k_ctx, v_ctx = mla_expand(ctx_ckv, ctx_krope, w_ukv)
    k_all = jnp.concatenate([k_ctx, k_lat], axis=1)
    v_all = jnp.concatenate([v_ctx, v_lat], axis=1)
    o = blocked_attend(q[:, :, :, None, :], k_all, v_all, MLA_SCALE)
    return o.reshape(b, t, N_HEADS * V_DIM) @ w_o


def mixer_c_context(h, w_qkv, g_q, g_k, w_o):
    b, s, _ = h.shape
    q, k, v = split_qkv(h @ w_qkv)
    q = rmsnorm(q, g_q)
    k = rmsnorm(k, g_k)
    o = blocked_attend(q.reshape(b, s, KV_HEADS, GROUP, HEAD_DIM), k, v, ATTN_SCALE)
    return o.reshape(b, s, N_HEADS * HEAD_DIM) @ w_o, k, v


def mixer_c_latent(h, ctx_k, ctx_v, w_qkv, g_q, g_k, w_o, rows, cols):
    b, t, _ = h.shape
    q, k, v = split_qkv(h @ w_qkv)
    q = rope_2d(rmsnorm(q, g_q), rows, cols).reshape(b, t, KV_HEADS, GROUP, HEAD_DIM)
    k = rope_2d(rmsnorm(k, g_k), rows, cols)
    k_all = jnp.concatenate([ctx_k, k], axis=1)
    v_all = jnp.concatenate([ctx_v, v], axis=1)
    o = blocked_attend(q, k_all, v_all, ATTN_SCALE)
    return o.reshape(b, t, N_HEADS * HEAD_DIM) @ w_o


def sq_relu_mlp(h, w_in, w_out):
    return jnp.square(jax.nn.relu(h @ w_in)) @ w_out


def setup_inputs(seed: int = 0) -> dict:
    key = jax.random.key(seed)
    ks = jax.random.split(key, 32)

    def nrm(k, shape, scale=1.0):
        return jax.random.normal(k, shape, jnp.float32) * scale

    def gain(k, shape):
        return 1.0 + 0.02 * jax.random.normal(k, shape, jnp.float32)

    d = D_MODEL
    return {
        'x_prompt': nrm(ks[0], (BATCH, SEQ, d)),
        'x_sample': nrm(ks[1], (DEC_BATCH, DEC_SEQ, d)),
        'c': nrm(ks[2], (DEC_BATCH, d)),
        'cache_a_k': nrm(ks[3], (DEC_BATCH, N_A, PAST_LEN, KV_HEADS, HEAD_DIM)),
        'cache_a_v': nrm(ks[4], (DEC_BATCH, N_A, PAST_LEN, KV_HEADS, HEAD_DIM)),
        'cache_b_ckv': nrm(ks[5], (DEC_BATCH, N_B, PAST_LEN, KV_LORA)),
        'cache_b_krope': nrm(ks[6], (DEC_BATCH, N_B, PAST_LEN, ROPE_DIM)),
        'cache_c_k': nrm(ks[7], (DEC_BATCH, N_C, PAST_LEN, KV_HEADS, HEAD_DIM)),
        'cache_c_v': nrm(ks[8], (DEC_BATCH, N_C, PAST_LEN, KV_HEADS, HEAD_DIM)),
        'c_ctx': nrm(ks[9], (d,)),
        'w_ada': nrm(ks[10], (DEPTH, d, 6 * d), 0.5 * d ** -0.5),
        'b_ada': nrm(ks[11], (DEPTH, 6 * d), 0.02),
        'norm_g': gain(ks[12], (DEPTH, 2, d)),
        'w_mlp_in': nrm(ks[13], (DEPTH, d, D_FF), d ** -0.5),
        'w_mlp_out': nrm(ks[14], (DEPTH, D_FF, d), D_FF ** -0.5),
        'a_w_qkv': nrm(ks[15], (N_A, d, QKV_DIM), d ** -0.5),
        'a_sink': nrm(ks[16], (N_A, N_HEADS), 0.5),
        'a_w_o': nrm(ks[17], (N_A, N_HEADS * HEAD_DIM, d), (N_HEADS * HEAD_DIM) ** -0.5),
        'b_w_dq': nrm(ks[18], (N_B, d, Q_LORA), d ** -0.5),
        'b_g_q': gain(ks[19], (N_B, Q_LORA)),
        'b_w_uq': nrm(ks[20], (N_B, Q_LORA, N_HEADS * (NOPE_DIM + ROPE_DIM)), Q_LORA ** -0.5),
        'b_w_dkv': nrm(ks[21], (N_B, d, KV_LORA + ROPE_DIM), d ** -0.5),
        'b_g_kv': gain(ks[22], (N_B, KV_LORA)),
        'b_w_ukv': nrm(ks[23], (N_B, KV_LORA, N_HEADS * (NOPE_DIM + V_DIM)), KV_LORA ** -0.5),
        'b_w_o': nrm(ks[24], (N_B, N_HEADS * V_DIM, d), (N_HEADS * V_DIM) ** -0.5),
        'c_w_qkv': nrm(ks[25], (N_C, d, QKV_DIM), d ** -0.5),
        'c_g_q': gain(ks[26], (N_C, HEAD_DIM)),
        'c_g_k': gain(ks[27], (N_C, HEAD_DIM)),
        'c_w_o': nrm(ks[28], (N_C, N_HEADS * HEAD_DIM, d), (N_HEADS * HEAD_DIM) ** -0.5),
        'g_final': gain(ks[29], (d,)),
    }


def reference(x_prompt, x_sample, c, cache_a_k, cache_a_v, cache_b_ckv, cache_b_krope, cache_c_k, cache_c_v,
              c_ctx, w_ada, b_ada, norm_g, w_mlp_in, w_mlp_out,
              a_w_qkv, a_sink, a_w_o,
              b_w_dq, b_g_q, b_w_uq, b_w_dkv, b_g_kv, b_w_ukv, b_w_o,
              c_w_qkv, c_g_q, c_g_k, c_w_o, g_final):
    rows, cols = grid_positions(x_sample.shape[1])
    xp, xs = x_prompt, x_sample
    st_a_k, st_a_v, st_b_ckv, st_b_kr, st_c_k, st_c_v = [], [], [], [], [], []
    for i in range(DEPTH):
        kind = i % N_MIXERS
        j = i // N_MIXERS
        sh_p, sc_p, gt_p, sh2_p, sc2_p, gt2_p = ada_mod(c_ctx, w_ada[i], b_ada[i])
        sh_s, sc_s, gt_s, sh2_s, sc2_s, gt2_s = ada_mod(c, w_ada[i], b_ada[i])
        hp = modulate(rmsnorm(xp, norm_g[i, 0]), sh_p, sc_p)
        hs = modulate(rmsnorm(xs, norm_g[i, 0]), sh_s, sc_s)
        if kind == 0:
            op, k_ctx, v_ctx = mixer_a_context(hp, a_w_qkv[j], a_sink[j], a_w_o[j])
            st_a_k.append(k_ctx)
            st_a_v.append(v_ctx)
            os_ = mixer_a_latent(hs, cache_a_k[:, j], cache_a_v[:, j], a_w_qkv[j], a_sink[j], a_w_o[j], rows, cols)
        elif kind == 1:
            op, ckv_ctx, kr_ctx = mixer_b_context(hp, b_w_dq[j], b_g_q[j], b_w_uq[j], b_w_dkv[j], b_g_kv[j],
                                                  b_w_ukv[j], b_w_o[j])
            st_b_ckv.append(ckv_ctx)
            st_b_kr.append(kr_ctx)
            os_ = mixer_b_latent(hs, cache_b_ckv[:, j], cache_b_krope[:, j], b_w_dq[j], b_g_q[j], b_w_uq[j],
                                 b_w_dkv[j], b_g_kv[j], b_w_ukv[j], b_w_o[j], rows, cols)
        else:
            op, k_ctx, v_ctx = mixer_c_context(hp, c_w_qkv[j], c_g_q[j], c_g_k[j], c_w_o[j])
            st_c_k.append(k_ctx)
            st_c_v.append(v_ctx)
            os_ = mixer_c_latent(hs, cache_c_k[:, j], cache_c_v[:, j], c_w_qkv[j], c_g_q[j], c_g_k[j], c_w_o[j],
                                 rows, cols)
        xp = xp + gt_p * op
        xs = xs + gt_s * os_
        hp = modulate(rmsnorm(xp, norm_g[i, 1]), sh2_p, sc2_p)
        hs = modulate(rmsnorm(xs, norm_g[i, 1]), sh2_s, sc2_s)
        xp = xp + gt2_p * sq_relu_mlp(hp, w_mlp_in[i], w_mlp_out[i])
        xs = xs + gt2_s * sq_relu_mlp(hs, w_mlp_in[i], w_mlp_out[i])
    y_prompt = rmsnorm(xp, g_final)
    y_sample = rmsnorm(xs, g_final)
    state_a_k = jnp.stack(st_a_k, axis=1)
    state_a_v = jnp.stack(st_a_v, axis=1)
    state_b_ckv = jnp.stack(st_b_ckv, axis=1)
    state_b_krope = jnp.stack(st_b_kr, axis=1)
    state_c_k = jnp.stack(st_c_k, axis=1)
    state_c_v = jnp.stack(st_c_v, axis=1)
    return (y_prompt, y_sample, state_a_k, state_a_v, state_b_ckv, state_b_krope, state_c_k, state_c_v)
```

```cpp
#include <hip/hip_runtime.h>
#include <hip/hip_cooperative_groups.h>
#include <cstdio>
#include <cstdint>
namespace cg = cooperative_groups;
#define LAS __attribute__((address_space(3)))
__device__ __forceinline__ int opaque_tid() { int t = threadIdx.x; asm volatile("" : "+v"(t)); return t; }
namespace pg8 {
#define PG8_LAS __attribute__((address_space(3)))
typedef unsigned short bf16_t;
typedef short bf16x8 __attribute__((ext_vector_type(8)));
typedef float f32x4 __attribute__((ext_vector_type(4)));
typedef unsigned u32x4 __attribute__((ext_vector_type(4)));
constexpr int BM = 256, BK = 64, HALF = 128, HTB = HALF * BK * 2  , STAGE_BYTES = 8 * HTB, NXCD = 8, WGM = 8;

__host__ __device__ __forceinline__ int lds_byte(int r, int c) { const int st = (r >> 4) * 2 + (c >> 5), rr = r & 15, cc = c & 31, ob = rr * 64 + cc * 2; return st * 1024 + (ob ^ (((ob >> 9) & 1) << 5)); }
__host__ __device__ __forceinline__ void stage_rc(int b, int& R, int& C) { const int st = b / 1024, sb = b % 1024, swz = sb ^ (((sb >> 9) & 1) << 5); R = (st >> 1) * 16 + swz / 64; C = (st & 1) * 32 + (swz % 64) / 2; }
__host__ __device__ __forceinline__ int perm32(int rho) { const int n = rho >> 4, i = rho & 15; return 8 * (i >> 2) + 4 * n + (i & 3); }

struct Unit { int pm, pn, kt0, nt, split; };
struct Gemm { const bf16_t* A; const bf16_t* Bt; int M, N, K; };

struct StaticOrder {
    int nM, nN, nwg, G, c, ntk, rounds, rem, sp;
    __host__ __device__ void init(int M, int N, int G_, int c_, int ntk_ = 0, bool SPLIT = false) { nM = M / BM; nN = N / BM; nwg = nM * nN; G = G_; c = c_; ntk = ntk_;
        rounds = 0; rem = 0; sp = (SPLIT && G == 256 && nM == 80 && nN == 4 && (ntk & 7) == 0) ? 4 : 1; }
    __host__ __device__ Unit get(int i) const {
        Unit u; u.pm = 0; u.pn = 0; u.kt0 = 0; u.nt = 0; u.split = 0;
        if (sp == 4) {
            if (i == 0) { const int id = (c & 7) * 32 + (c >> 3); u.pm = 16 + (id >> 2); u.pn = id & 3; u.nt = ntk; }
            else if (i == 1) { const int t = c >> 2, part = c & 3; u.pm = t >> 2; u.pn = t & 3; u.nt = ntk >> 2; u.kt0 = part * u.nt; u.split = 1 + part; }
            return u; }
        const long LL = (long)i * G + c;
        if (LL < nwg) {
            int wgid = (int)LL; { const int q = nwg / NXCD, r = nwg % NXCD, xcd = wgid % NXCD, off = wgid / NXCD; wgid = (xcd < r ? xcd * (q + 1) : r * (q + 1) + (xcd - r) * q) + off; }
            const int nig = WGM * nN, gid = wgid / nig, fm = gid * WGM, gsz = (nM - fm) < WGM ? (nM - fm) : WGM;
            u.pm = fm + ((wgid % nig) % gsz); u.pn = (wgid % nig) / gsz; u.nt = ntk; }
        return u; }
    __host__ __device__ bool next(int i, Unit& u) const { u = get(i); return u.nt > 0; }
    __device__ __forceinline__ void a_ready(const Unit&) const {}
    __device__ __forceinline__ void done(const Unit&) const {}
};

__device__ __forceinline__ unsigned cvt_pk_bf16(float lo, float hi) { unsigned r; asm volatile("v_cvt_pk_bf16_f32 %0, %1, %2" : "=v"(r) : "v"(lo), "v"(hi)); return r; }
template <class Epi, class Sched, bool ALIGN_EPI = false, bool SP2 = false>
__device__ __forceinline__ void gemm_phase(PG8_LAS unsigned char* lds, const Gemm g, const Sched& S, const Epi& E) {
    const int tid = opaque_tid(), wid = __builtin_amdgcn_readfirstlane(tid >> 6), lane = tid & 63, wr = wid >> 2, wc = wid & 3, fr = lane & 15, fq = lane >> 4;
    const int K = g.K;
    unsigned voffA[2], voffB[2];
#pragma unroll
    for (int i = 0; i < 2; ++i) { int R, C; stage_rc(tid * 16 + i * 8192, R, C); const int Rb = Epi::PERM ? ((R & ~31) + perm32(R & 31)) : R;
        voffA[i] = (unsigned)(R * K + C) * 2u; voffB[i] = (unsigned)(Rb * K + C) * 2u; }
    const size_t kstep = (size_t)(BK * 2);
    const size_t hstep = (size_t)HALF * K * 2;
    const size_t tstep = 2 * hstep;
    const unsigned ldsw = (unsigned)wid * 1024u;
    const int aoff = lds_byte(wr * 64 + fr, fq * 8), boff = lds_byte(wc * 32 + fr, fq * 8);
#define PG8_SA(b, h) (((b) * 2 + (h)) * HTB)
#define PG8_SB(b, h) ((4 + (b) * 2 + (h)) * HTB)
#define PG8_STAGE(bufoff, gbase, voff) do { _Pragma("unroll") for (int _i = 0; _i < 2; ++_i) \
        __builtin_amdgcn_global_load_lds((const unsigned*)((const char*)(gbase) + (voff)[_i]), (PG8_LAS unsigned*)(lds + (bufoff) + ldsw + _i * 8192), 16, 0, 0); } while (0)
#define PG8_LDA(dst, b, h) do { _Pragma("unroll") for (int m = 0; m < 4; ++m) _Pragma("unroll") for (int k = 0; k < 2; ++k) dst[m][k] = *(const PG8_LAS bf16x8*)(lds + PG8_SA(b, h) + aoff + m * 2048 + k * 1024); } while (0)
#define PG8_LDB(dst, b, h) do { _Pragma("unroll") for (int n = 0; n < 2; ++n) _Pragma("unroll") for (int k = 0; k < 2; ++k) dst[n][k] = *(const PG8_LAS bf16x8*)(lds + PG8_SB(b, h) + boff + n * 2048 + k * 1024); } while (0)
#define PG8_MMA(ai, bj, At, Bt) do { __builtin_amdgcn_s_setprio(1); _Pragma("unroll") for (int m = 0; m < 4; ++m) _Pragma("unroll") for (int n = 0; n < 2; ++n) _Pragma("unroll") for (int k = 0; k < 2; ++k) \
        acc[ai][bj][m][n] = __builtin_amdgcn_mfma_f32_16x16x32_bf16(Bt[n][k], At[m][k], acc[ai][bj][m][n], 0, 0, 0); __builtin_amdgcn_s_setprio(0); } while (0)
#define PG8_WAIT_V(n) asm volatile("s_waitcnt vmcnt(" #n ")" ::: "memory")
#define PG8_WAIT_L(n) asm volatile("s_waitcnt lgkmcnt(" #n ")" ::: "memory")
#define PG8_BAR __builtin_amdgcn_s_barrier()
#define PG8_SCHED __builtin_amdgcn_sched_barrier(0)
    Unit cur, nxt; int ui = 0;
    if (!S.next(0, cur)) return;
    f32x4 acc[2][2][4][2];
#pragma unroll
    for (int a = 0; a < 2; ++a)
#pragma unroll
        for (int b = 0; b < 2; ++b)
#pragma unroll
            for (int m = 0; m < 4; ++m)
#pragma unroll
                for (int n = 0; n < 2; ++n) acc[a][b][m][n] = (f32x4){0.f, 0.f, 0.f, 0.f};
    bf16x8 At[4][2], B0[2][2], B1[2][2];
    const char* cA = (const char*)g.A + (size_t)cur.pm * tstep + (size_t)cur.kt0 * kstep; const char* cB = (const char*)g.Bt + (size_t)cur.pn * tstep + (size_t)cur.kt0 * kstep;
    S.a_ready(cur);
    if constexpr (SP2) {
        PG8_STAGE(PG8_SB(0, 0), cB, voffB); PG8_STAGE(PG8_SB(0, 1), cB + hstep, voffB); PG8_STAGE(PG8_SA(0, 0), cA, voffA); PG8_STAGE(PG8_SA(0, 1), cA + hstep, voffA);
        if (wr == 1) PG8_BAR;
        PG8_WAIT_V(2); PG8_BAR;
        PG8_STAGE(PG8_SB(1, 0), cB + kstep, voffB); PG8_STAGE(PG8_SA(1, 0), cA + kstep, voffA); PG8_STAGE(PG8_SB(1, 1), cB + hstep + kstep, voffB);
        PG8_WAIT_V(6); PG8_BAR;
    } else {
        PG8_STAGE(PG8_SB(0, 0), cB, voffB); PG8_STAGE(PG8_SA(0, 0), cA, voffA); PG8_STAGE(PG8_SB(0, 1), cB + hstep, voffB); PG8_STAGE(PG8_SA(0, 1), cA + hstep, voffA);
        if (wr == 1) PG8_BAR;
        PG8_WAIT_V(4); PG8_BAR;
        PG8_STAGE(PG8_SB(1, 0), cB + kstep, voffB); PG8_STAGE(PG8_SA(1, 0), cA + kstep, voffA); PG8_STAGE(PG8_SB(1, 1), cB + hstep + kstep, voffB);
        PG8_WAIT_V(6); PG8_BAR;
    }
    for (;;) {
        const bool has_next = S.next(ui + 1, nxt);
        const char* nA = has_next ? (const char*)g.A + (size_t)nxt.pm * tstep + (size_t)nxt.kt0 * kstep : cA; const char* nB = has_next ? (const char*)g.Bt + (size_t)nxt.pn * tstep + (size_t)nxt.kt0 * kstep : cB;
        const int nt = cur.nt;
        for (int t = 0; t < nt; t += 2) {
            asm volatile("" : "+v"(voffA[0]), "+v"(voffA[1]), "+v"(voffB[0]), "+v"(voffB[1]));
            const bool last = (t == nt - 2);
            const char* a1 = cA + (size_t)(t + 1) * kstep;
            const char* a2 = last ? nA : cA + (size_t)(t + 2) * kstep; const char* b2 = last ? nB : cB + (size_t)(t + 2) * kstep;
            const char* a3 = a2 + kstep; const char* b3 = b2 + kstep;
            if (last && has_next) S.a_ready(nxt);
            if constexpr (SP2) {
            PG8_LDB(B0, 0, 0); PG8_LDB(B1, 0, 1); PG8_SCHED; PG8_LDA(At, 0, 0); PG8_STAGE(PG8_SA(1, 1), a1 + hstep, voffA);
            PG8_WAIT_V(8); PG8_WAIT_L(0); PG8_BAR; PG8_MMA(0, 0, At, B0); PG8_MMA(0, 1, At, B1); PG8_BAR; PG8_SCHED;
            PG8_LDA(At, 0, 1); PG8_STAGE(PG8_SB(0, 0), b2, voffB); PG8_STAGE(PG8_SB(0, 1), b2 + hstep, voffB); PG8_STAGE(PG8_SA(0, 0), a2, voffA);
            PG8_WAIT_V(8); PG8_WAIT_L(0); PG8_BAR; PG8_MMA(1, 0, At, B0); PG8_MMA(1, 1, At, B1); PG8_BAR; PG8_SCHED;
            PG8_LDB(B0, 1, 0); PG8_LDB(B1, 1, 1); PG8_SCHED; PG8_LDA(At, 1, 0); PG8_STAGE(PG8_SA(0, 1), a2 + hstep, voffA);
            PG8_WAIT_V(8); PG8_WAIT_L(0); PG8_BAR; PG8_MMA(0, 0, At, B0); PG8_MMA(0, 1, At, B1); PG8_BAR; PG8_SCHED;
            PG8_LDA(At, 1, 1); PG8_STAGE(PG8_SB(1, 0), b3, voffB); PG8_STAGE(PG8_SB(1, 1), b3 + hstep, voffB); PG8_STAGE(PG8_SA(1, 0), a3, voffA);
            PG8_WAIT_V(8); PG8_WAIT_L(0); PG8_BAR; PG8_MMA(1, 0, At, B0); PG8_MMA(1, 1, At, B1); PG8_BAR; PG8_SCHED;
            } else {
            PG8_LDB(B0, 0, 0); PG8_SCHED; PG8_LDA(At, 0, 0); PG8_STAGE(PG8_SA(1, 1), a1 + hstep, voffA);
            PG8_WAIT_L(8); PG8_BAR; PG8_WAIT_L(0); PG8_MMA(0, 0, At, B0); PG8_BAR; PG8_SCHED;
            PG8_LDB(B1, 0, 1); PG8_STAGE(PG8_SB(0, 0), b2, voffB);
            PG8_BAR; PG8_WAIT_L(0); PG8_MMA(0, 1, At, B1); PG8_BAR;
            PG8_LDA(At, 0, 1); PG8_STAGE(PG8_SA(0, 0), a2, voffA);
            PG8_BAR; PG8_WAIT_L(0); PG8_MMA(1, 0, At, B0); PG8_BAR; PG8_SCHED;
            PG8_STAGE(PG8_SB(0, 1), b2 + hstep, voffB);
            PG8_WAIT_V(6); PG8_BAR; PG8_MMA(1, 1, At, B1); PG8_BAR;
            PG8_LDB(B0, 1, 0); PG8_SCHED; PG8_LDA(At, 1, 0); PG8_STAGE(PG8_SA(0, 1), a2 + hstep, voffA);
            PG8_WAIT_L(8); PG8_BAR; PG8_WAIT_L(0); PG8_MMA(0, 0, At, B0); PG8_BAR; PG8_SCHED;
            PG8_LDB(B1, 1, 1); PG8_STAGE(PG8_SB(1, 0), b3, voffB);
            PG8_BAR; PG8_WAIT_L(0); PG8_MMA(0, 1, At, B1); PG8_BAR;
            PG8_LDA(At, 1, 1); PG8_STAGE(PG8_SA(1, 0), a3, voffA);
            PG8_BAR; PG8_WAIT_L(0); PG8_MMA(1, 0, At, B0); PG8_BAR; PG8_SCHED;
            PG8_STAGE(PG8_SB(1, 1), b3 + hstep, voffB);
            PG8_WAIT_V(6); PG8_BAR; PG8_MMA(1, 1, At, B1); PG8_BAR;
            }
        }
        if constexpr (ALIGN_EPI) { if (wr == 0) PG8_BAR; }
        if constexpr (!Epi::AFTER_DRAIN) { E(acc, cur, wr, wc, fr, fq); S.done(cur); }
        if (!has_next) break;
#pragma unroll
        for (int a = 0; a < 2; ++a)
#pragma unroll
            for (int b = 0; b < 2; ++b)
#pragma unroll
                for (int m = 0; m < 4; ++m)
#pragma unroll
                    for (int n = 0; n < 2; ++n) acc[a][b][m][n] = (f32x4){0.f, 0.f, 0.f, 0.f};
        cur = nxt; cA = nA; cB = nB; ++ui;
        if constexpr (ALIGN_EPI) { if (wr == 1) PG8_BAR; }
    }
    PG8_WAIT_V(0);
    if constexpr (!ALIGN_EPI) { if (wr == 0) PG8_BAR; }
    PG8_BAR;
    if constexpr (Epi::AFTER_DRAIN) { E.fused(acc, cur, wr, wc, fr, fq, lds, wid, lane); S.done(cur); }
#undef PG8_SA
#undef PG8_SB
#undef PG8_STAGE
#undef PG8_LDA
#undef PG8_LDB
#undef PG8_MMA
#undef PG8_WAIT_V
#undef PG8_WAIT_L
#undef PG8_BAR
#undef PG8_SCHED
}
}
namespace att {
using bf16x8 = __attribute__((ext_vector_type(8))) short;
using s16x4  = __attribute__((ext_vector_type(4))) short;
using f32x16 = __attribute__((ext_vector_type(16))) float;
using u32x4  = __attribute__((ext_vector_type(4))) unsigned;
using u32x2  = __attribute__((ext_vector_type(2))) unsigned;
constexpr int NW = 8, QBLK = 32, KVBLK = 64;
constexpr int SHM_V = 16384, SHM_K = 16384, SHM_ATTN = 3 * SHM_V + 3 * SHM_K + NW * 64 * 4;
#define KSWZ(row, colB) ((row) * 256 + ((colB) ^ (((row) & 7) << 4)))
#define SBAR() __builtin_amdgcn_sched_barrier(0)
__device__ __forceinline__ int crow(int r, int hi) { return (r & 3) + 8 * (r >> 2) + 4 * hi; }
__device__ __forceinline__ unsigned cvtpk(float lo, float hi) { unsigned r; asm volatile("v_cvt_pk_bf16_f32 %0, %1, %2" : "=v"(r) : "v"(lo), "v"(hi)); return r; }

#define MX3(a, b, c) __builtin_fmaxf(__builtin_fmaxf((a), (b)), (c))
template <bool FIRST>
__device__ __forceinline__ void partialSM(f32x16& p0, f32x16& p1, float& m_reg, f32x16& negm, float& alpha, const float thr) {
  float a = MX3(p0[0], p0[1], p1[0]), b = MX3(p0[2], p0[3], p1[1]); a = MX3(a, p1[2], p1[3]);
#pragma unroll
  for (int r = 4; r < 16; r += 4) { a = MX3(a, p0[r], p0[r + 1]); b = MX3(b, p0[r + 2], p0[r + 3]); a = MX3(a, p1[r], p1[r + 1]); b = MX3(b, p1[r + 2], p1[r + 3]); }
  float pmax = fmaxf(a, b);
  { auto rr = __builtin_amdgcn_permlane32_swap(__float_as_uint(pmax), __float_as_uint(pmax), false, false);
    pmax = fmaxf(__uint_as_float(rr[0]), __uint_as_float(rr[1])); }
  alpha = 1.f;
  if (FIRST || !__builtin_expect(__all(pmax <= thr), 1)) {
    const float dl = FIRST ? pmax : fmaxf(pmax, 0.f);
    alpha = __builtin_amdgcn_exp2f(-dl); m_reg += dl;
#pragma unroll
    for (int r = 0; r < 16; ++r) { p0[r] -= dl; p1[r] -= dl; }
#pragma unroll
    for (int r = 0; r < 16; ++r) negm[r] = -m_reg;
  }
#pragma unroll
  for (int r = 0; r < 16; ++r) p0[r] = __builtin_amdgcn_exp2f(p0[r]);
}
__device__ __forceinline__ void finishSM(f32x16& p0, f32x16& p1, bf16x8& pa0, bf16x8& pa1, bf16x8& pa2, bf16x8& pa3) {
#pragma unroll
  for (int r = 0; r < 16; ++r) p1[r] = __builtin_amdgcn_exp2f(p1[r]);
#define PK4(P, BASE, OUT) do { unsigned a0 = cvtpk(P[BASE + 0], P[BASE + 1]), a1 = cvtpk(P[BASE + 2], P[BASE + 3]);   \
    unsigned b0 = cvtpk(P[BASE + 4], P[BASE + 5]), b1 = cvtpk(P[BASE + 6], P[BASE + 7]);                              \
    auto r0 = __builtin_amdgcn_permlane32_swap(a0, b0, false, false); auto r1 = __builtin_amdgcn_permlane32_swap(a1, b1, false, false); \
    u32x4 w = {r0[0], r1[0], r0[1], r1[1]}; OUT = *reinterpret_cast<bf16x8*>(&w); } while (0)
  PK4(p0, 0, pa0); PK4(p0, 8, pa1); PK4(p1, 0, pa2); PK4(p1, 8, pa3);
#undef PK4
}
template <int DQK>
__device__ __forceinline__ void qkt(f32x16& p0, f32x16& p1, const char* Ks, const bf16x8* qr, const f32x16& negm, int r32, int hi) {
  p0 = negm; p1 = negm;
  __builtin_amdgcn_s_setprio(1);
#pragma unroll
  for (int d0 = 0; d0 < DQK / 16; ++d0) { int cb = (d0 * 16 + hi * 8) * 2;
    bf16x8 b0 = *reinterpret_cast<const bf16x8*>(Ks + KSWZ(r32, cb));
    bf16x8 b1 = *reinterpret_cast<const bf16x8*>(Ks + KSWZ(32 + r32, cb));
    p0 = __builtin_amdgcn_mfma_f32_32x32x16_bf16(b0, qr[d0], p0, 0, 0, 0);
    p1 = __builtin_amdgcn_mfma_f32_32x32x16_bf16(b1, qr[d0], p1, 0, 0, 0); }
  __builtin_amdgcn_s_setprio(0);
}
__device__ __forceinline__ int v_st(int k, int c) { const int kk = (k & ~0xC) | ((k & 4) << 1) | ((k & 8) >> 1); return ((kk >> 3) * 4 + (c >> 5)) * 512 + ((kk & 7) * 32 + (c & 31)) * 2; }
__device__ __forceinline__ int v_rd_base(int lane) { return ((lane & 3) << 3) | (((lane >> 2) & 3) << 6) | (((lane >> 4) & 1) << 5) | (((lane >> 5) & 1) << 8); }
constexpr int v_rd_off(int d0, int ks, int half) { return d0 * 512 + ks * 4096 + half * 2048; }
template <int OFF> __device__ __forceinline__ s16x4 tr_read(int vb) {
  s16x4 r; asm volatile("ds_read_b64_tr_b16 %0, %1 offset:%2" : "=&v"(r) : "v"(vb), "i"(OFF) : "memory"); return r;
}
struct VFrag { s16x4 l[4], h[4]; };
template <int D0> __device__ __forceinline__ void v_reads(VFrag& f, int vb) {
  f.l[0] = tr_read<v_rd_off(D0, 0, 0)>(vb); f.h[0] = tr_read<v_rd_off(D0, 0, 1)>(vb); f.l[1] = tr_read<v_rd_off(D0, 1, 0)>(vb); f.h[1] = tr_read<v_rd_off(D0, 1, 1)>(vb);
  f.l[2] = tr_read<v_rd_off(D0, 2, 0)>(vb); f.h[2] = tr_read<v_rd_off(D0, 2, 1)>(vb); f.l[3] = tr_read<v_rd_off(D0, 3, 0)>(vb); f.h[3] = tr_read<v_rd_off(D0, 3, 1)>(vb);
}
__device__ __forceinline__ void pv_mma(f32x16* o, f32x16& lacc, VFrag& f, int vb, bf16x8 pa0, bf16x8 pa1, bf16x8 pa2, bf16x8 pa3) {
  const bf16x8 ones = {0x3F80, 0x3F80, 0x3F80, 0x3F80, 0x3F80, 0x3F80, 0x3F80, 0x3F80};
  asm volatile("s_waitcnt lgkmcnt(0)" ::: "memory"); SBAR();
#define PK(L, H) (bf16x8){L[0], L[1], L[2], L[3], H[0], H[1], H[2], H[3]}
  o[0] = __builtin_amdgcn_mfma_f32_32x32x16_bf16(pa0, PK(f.l[0], f.h[0]), o[0], 0, 0, 0);
  o[0] = __builtin_amdgcn_mfma_f32_32x32x16_bf16(pa1, PK(f.l[1], f.h[1]), o[0], 0, 0, 0);
  o[0] = __builtin_amdgcn_mfma_f32_32x32x16_bf16(pa2, PK(f.l[2], f.h[2]), o[0], 0, 0, 0);
  o[0] = __builtin_amdgcn_mfma_f32_32x32x16_bf16(pa3, PK(f.l[3], f.h[3]), o[0], 0, 0, 0);
  SBAR(); v_reads<1>(f, vb); SBAR();
  lacc = __builtin_amdgcn_mfma_f32_32x32x16_bf16(pa0, ones, lacc, 0, 0, 0);
  lacc = __builtin_amdgcn_mfma_f32_32x32x16_bf16(pa1, ones, lacc, 0, 0, 0);
  lacc = __builtin_amdgcn_mfma_f32_32x32x16_bf16(pa2, ones, lacc, 0, 0, 0);
  lacc = __builtin_amdgcn_mfma_f32_32x32x16_bf16(pa3, ones, lacc, 0, 0, 0);
  asm volatile("s_waitcnt lgkmcnt(0)" ::: "memory"); SBAR();
  o[1] = __builtin_amdgcn_mfma_f32_32x32x16_bf16(pa0, PK(f.l[0], f.h[0]), o[1], 0, 0, 0);
  o[1] = __builtin_amdgcn_mfma_f32_32x32x16_bf16(pa1, PK(f.l[1], f.h[1]), o[1], 0, 0, 0);
  o[1] = __builtin_amdgcn_mfma_f32_32x32x16_bf16(pa2, PK(f.l[2], f.h[2]), o[1], 0, 0, 0);
  o[1] = __builtin_amdgcn_mfma_f32_32x32x16_bf16(pa3, PK(f.l[3], f.h[3]), o[1], 0, 0, 0);
#undef PK
}
struct Unit {
  const unsigned short* Q; const unsigned short* K; const unsigned short* KR; const unsigned short* V; unsigned short* O;
  int ldq, ldk, NT, kstart, q0;
  float C, thr_raw, sinkl2;
};
__device__ __forceinline__ void wmask(f32x16& p0, f32x16& p1, int tilepos, int qpos, int hi) {
#pragma unroll
  for (int r = 0; r < 16; ++r) { const int k0 = tilepos + crow(r, hi); int d0 = qpos - k0; d0 = d0 < 0 ? -d0 : d0; int d1 = qpos - (k0 + 32); d1 = d1 < 0 ? -d1 : d1;
    if (d0 > 128) p0[r] = -1e30f; if (d1 > 128) p1[r] = -1e30f; }
}
template <int DQK, bool WINDOW>
__device__ __forceinline__ void attn_unit(const Unit& U, char* lds) {
  const int tid = opaque_tid(), wid = __builtin_amdgcn_readfirstlane(tid >> 6), lane = tid & 63, r32 = lane & 31, hi = lane >> 5;
  char* V_lds = lds; char* K_lds = lds + 3 * SHM_V;
  float* ws = (float*)(lds + 3 * SHM_V + 3 * SHM_K) + wid * 64; float* li_l = ws; float* al_l = ws + 32;
  const float thr = 11.5415603f;
  float m_reg = 0.f; f32x16 o[2] = {}; f32x16 lacc = {}; f32x16 negm = {}; bf16x8 qr[DQK / 16];
  const unsigned short* Qw = U.Q + (long)(wid * QBLK + r32) * U.ldq + hi * 8;
#pragma unroll
  for (int d0 = 0; d0 < DQK / 16; ++d0) qr[d0] = *reinterpret_cast<const bf16x8*>(Qw + d0 * 16);
  const int sr = tid >> 3, sc = (tid & 7) * 8, vst0 = v_st(sr, sc), kst0 = KSWZ(sr, sc * 2);
  const int srr = (tid >> 2) & 63, scr = (tid & 3) * 8, kst1 = KSWZ(srr, (64 + scr) * 2);
  const bool do_r = (DQK == 96) && (tid < 256);
  const int vb0 = (int)(uintptr_t)V_lds + v_rd_base(lane);
  const int ldk = U.ldk, kstart = U.kstart;
  const int qpos = U.q0 + wid * QBLK + r32; const int qlo = U.q0 + wid * QBLK;
  struct { bf16x8 vs, ks, rs; } sr_[3];
#define KROW(j) ((long)(64 * (j) + ((j) >= 4 ? kstart : 0)))
#define SLOAD(i, j) do { const long kr_ = KROW(j); sr_[i].vs = *reinterpret_cast<const bf16x8*>(U.V + (kr_ + sr) * ldk + sc); \
    sr_[i].ks = *reinterpret_cast<const bf16x8*>(U.K + (kr_ + sr) * ldk + sc); \
    if (DQK == 96) { if (do_r) sr_[i].rs = *reinterpret_cast<const bf16x8*>(U.KR + (kr_ + srr) * 32 + scr); } } while (0)
#define SWRITE(soff, i) do { *(bf16x8*)(V_lds + (soff) + vst0) = sr_[i].vs; *(bf16x8*)(K_lds + (soff) + kst0) = sr_[i].ks; \
    if (DQK == 96) { if (do_r) *(bf16x8*)(K_lds + (soff) + kst1) = sr_[i].rs; } } while (0)
#define RESC(a) do { if (__any((a) < 1.f)) { if (hi == 0) al_l[r32] = (a); asm volatile("s_waitcnt lgkmcnt(0)" ::: "memory"); \
    _Pragma("unroll") for (int r = 0; r < 16; ++r) { const float f_ = al_l[crow(r, hi)]; o[0][r] *= f_; o[1][r] *= f_; lacc[r] *= f_; } } } while (0)
#define WMASK(P0, P1, j) do { if (WINDOW) { if ((j) >= 4) wmask(P0, P1, kstart + 64 * ((j) - 4), qpos, hi); } } while (0)
#define QKM(P0, P1, KP, j) do { \
    if (WINDOW && (j) >= 4) { const int tp_ = kstart + 64 * ((j) - 4); \
      if (tp_ + 63 < qlo - 128 || tp_ > qlo + 31 + 128) { _Pragma("unroll") for (int r_ = 0; r_ < 16; ++r_) { P0[r_] = -1e30f; P1[r_] = -1e30f; } } \
      else { qkt<DQK>(P0, P1, KP, qr, negm, r32, hi); if (!(tp_ >= qlo + 31 - 128 && tp_ + 63 <= qlo + 128)) wmask(P0, P1, tp_, qpos, hi); } } \
    else qkt<DQK>(P0, P1, KP, qr, negm, r32, hi); } while (0)
#define ROT() do { const int t_ = s_prev; s_prev = s_cur; s_cur = s_next; s_next = t_; } while (0)
  static_assert(SHM_V == SHM_K, "one slot offset serves both rings");
  f32x16 pA0, pA1, pB0, pB1; float alA, alB; bf16x8 pa0, pa1, pa2, pa3; const int NT = U.NT; VFrag vf;
  int s_prev = 2 * SHM_V, s_cur = 0, s_next = SHM_V;
  SLOAD(1, 0); SLOAD(2, 1); if (2 < NT) SLOAD(0, 2);
  SWRITE(0, 1); SWRITE(SHM_V, 2);
  __syncthreads();
  qkt<DQK>(pA0, pA1, K_lds, qr, negm, r32, hi); partialSM<true>(pA0, pA1, m_reg, negm, alA, thr);
  ROT();
  for (int j = 1; j + 1 < NT; j += 2) {
    SWRITE(s_next, 0); if (j + 2 < NT) SLOAD(0, j + 2);
    SBAR(); QKM(pB0, pB1, K_lds + s_cur, j); v_reads<0>(vf, vb0 + s_prev);
    finishSM(pA0, pA1, pa0, pa1, pa2, pa3);
    pv_mma(o, lacc, vf, vb0 + s_prev, pa0, pa1, pa2, pa3); partialSM<false>(pB0, pB1, m_reg, negm, alB, thr);
    __syncthreads(); RESC(alB); ROT();
    if (j + 2 < NT) SWRITE(s_next, 0); if (j + 3 < NT) SLOAD(0, j + 3);
    SBAR(); QKM(pA0, pA1, K_lds + s_cur, j + 1); v_reads<0>(vf, vb0 + s_prev);
    finishSM(pB0, pB1, pa0, pa1, pa2, pa3);
    pv_mma(o, lacc, vf, vb0 + s_prev, pa0, pa1, pa2, pa3); partialSM<false>(pA0, pA1, m_reg, negm, alA, thr);
    __syncthreads(); RESC(alA); ROT();
  }
  SBAR(); QKM(pB0, pB1, K_lds + s_cur, NT - 1); v_reads<0>(vf, vb0 + s_prev);
  finishSM(pA0, pA1, pa0, pa1, pa2, pa3);
  pv_mma(o, lacc, vf, vb0 + s_prev, pa0, pa1, pa2, pa3); partialSM<false>(pB0, pB1, m_reg, negm, alB, thr);
  RESC(alB);
  SBAR(); v_reads<0>(vf, vb0 + s_cur); SBAR();
  finishSM(pB0, pB1, pa0, pa1, pa2, pa3);
  pv_mma(o, lacc, vf, vb0 + s_cur, pa0, pa1, pa2, pa3);
  if (hi == 0) li_l[r32] = __builtin_amdgcn_exp2f(fmaxf(U.sinkl2 - m_reg, -126.f));
  asm volatile("s_waitcnt lgkmcnt(0)" ::: "memory");
  float rli[16];
#pragma unroll
  for (int r = 0; r < 16; ++r) rli[r] = __builtin_amdgcn_rcpf(lacc[r] + li_l[crow(r, hi)]);
  unsigned short* Ow = U.O + (long)(wid * QBLK) * 1024;
#pragma unroll
  for (int r = 0; r < 16; ++r) { const int orow = crow(r, hi);
#pragma unroll
    for (int d0 = 0; d0 < 2; ++d0) { const float lo = o[d0][r] * rli[r]; const unsigned pk = cvtpk(lo, lo); Ow[(long)orow * 1024 + d0 * 32 + r32] = (unsigned short)(pk & 0xffffu); } }
  __syncthreads();
#undef KROW
#undef SLOAD
#undef SWRITE
#undef RESC
#undef WMASK
#undef QKM
#undef ROT
}
#undef SBAR
}
constexpr int DM = 1024, NP_ROWS = 4096, NS_ROWS = 16384, M_ROWS = 20480, EXT_ROWS = 21504, EXT_B = 4352, DFF = 4096;
constexpr float EPS_ = 1e-6f;
constexpr float LOG2_THETA = 13.287712379549449f;
constexpr float INV_2PI = 0.15915494309189535f;
typedef unsigned short bfu;
typedef float f32x4 __attribute__((ext_vector_type(4)));
typedef unsigned u32x4 __attribute__((ext_vector_type(4)));
typedef unsigned u32x2 __attribute__((ext_vector_type(2)));
__device__ __forceinline__ unsigned pkbf(float lo, float hi) { return pg8::cvt_pk_bf16(lo, hi); }
__device__ __forceinline__ void rope_cs(int pos, int i, float inv_den, float& c, float& s) {
    const float f = __builtin_amdgcn_exp2f(-(float)i * (LOG2_THETA * inv_den));
    const float rev = (float)pos * f * INV_2PI;
    c = __builtin_amdgcn_cosf(rev); s = __builtin_amdgcn_sinf(rev);
}
__device__ __forceinline__ int cond_of_row(int row) { return row < NP_ROWS ? 4 : ((row - NP_ROWS) >> 12); }
__device__ __forceinline__ int ext_of_row(int row) { return row < NP_ROWS ? row : (NP_ROWS + ((row - NP_ROWS) >> 12) * EXT_B + 256 + ((row - NP_ROWS) & 4095)); }

#define EPI_FENCE() asm volatile("" ::: "memory")
template <bool NORMC> struct EpiQKV {
    static constexpr bool PERM = false, AFTER_DRAIN = false;
    bfu* Q; bfu* Kb; bfu* Vb; float* stK; float* stV; const float* gq; const float* gk; int nstate;
    __device__ __forceinline__ void operator()(const f32x4 (&acc)[2][2][4][2], const pg8::Unit& u, int wr, int wc, int fr, int fq) const {
        asm volatile("" : "+v"(fr), "+v"(fq));
        const int pn = u.pn; const bool isQ = pn < 4, isK = pn == 4; const bool sample = u.pm >= 16;
        const bool dorope = sample && pn < 5;
        float frq[4];
#pragma unroll
        for (int j = 0; j < 4; ++j) frq[j] = __builtin_amdgcn_exp2f(-(float)(4 * fq + j) * (LOG2_THETA / 16.0f)) * INV_2PI;
        const unsigned cq = 64 * wc + 4 * fq;
#pragma unroll
        for (int ai = 0; ai < 2; ++ai)
#pragma unroll
            for (int m = 0; m < 4; ++m) {
                unsigned row = u.pm * 256 + ai * 128 + wr * 64 + m * 16 + fr; asm volatile("" : "+v"(row));
                f32x4 v[2][2];
#pragma unroll
                for (int bj = 0; bj < 2; ++bj)
#pragma unroll
                    for (int n = 0; n < 2; ++n) v[bj][n] = acc[ai][bj][m][n];
                if (NORMC && pn < 5) {
                    float ss = 0.f;
#pragma unroll
                    for (int bj = 0; bj < 2; ++bj)
#pragma unroll
                        for (int n = 0; n < 2; ++n) ss += (v[bj][n][0] * v[bj][n][0] + v[bj][n][1] * v[bj][n][1]) + (v[bj][n][2] * v[bj][n][2] + v[bj][n][3] * v[bj][n][3]);
                    ss += __shfl_xor(ss, 16); ss += __shfl_xor(ss, 32);
                    const float rstd = 1.0f / sqrtf(ss * (1.0f / 64.0f) + EPS_);
                    const float* g = (isQ ? gq : gk) + 4 * fq;
#pragma unroll
                    for (int bj = 0; bj < 2; ++bj)
#pragma unroll
                        for (int n = 0; n < 2; ++n) { const f32x4 gv = *(const f32x4*)(g + 32 * bj + 16 * n); v[bj][n] = v[bj][n] * rstd * gv; }
                }
                const unsigned t = (row - NP_ROWS) & 4095u;
                if (dorope) {
#pragma unroll
                    for (int bj = 0; bj < 2; ++bj) { const float pos = (float)(bj == 0 ? (t >> 6) : (t & 63u));
#pragma unroll
                        for (int j = 0; j < 4; ++j) { const float rev = pos * frq[j]; const float c = __builtin_amdgcn_cosf(rev), s = __builtin_amdgcn_sinf(rev); const float x1 = v[bj][0][j], x2 = v[bj][1][j];
                            v[bj][0][j] = x1 * c - x2 * s; v[bj][1][j] = x1 * s + x2 * c; } }
                }
                if (isQ) { bfu* p = Q + (row * 1024u + 256u * pn + cq);
#pragma unroll
                    for (int bj = 0; bj < 2; ++bj)
#pragma unroll
                        for (int n = 0; n < 2; ++n) { const f32x4 x = v[bj][n] * (0.125f * 1.4426950408889634f);     u32x2 w; w.x = pkbf(x[0], x[1]); w.y = pkbf(x[2], x[3]); *(u32x2*)(p + 32 * bj + 16 * n) = w; }
                } else {
                    const unsigned e = sample ? (NP_ROWS + ((row - NP_ROWS) >> 12) * EXT_B + 256u + t) : row;
                    bfu* p = (isK ? Kb : Vb) + (e * 256u + cq);
#pragma unroll
                    for (int bj = 0; bj < 2; ++bj)
#pragma unroll
                        for (int n = 0; n < 2; ++n) { const f32x4 x = v[bj][n]; u32x2 w; w.x = pkbf(x[0], x[1]); w.y = pkbf(x[2], x[3]); *(u32x2*)(p + 32 * bj + 16 * n) = w; }
                    if (!sample) { float* st = (isK ? stK : stV) + ((((row >> 8) * nstate) * 256u + (row & 255u)) * 256u + cq);
#pragma unroll
                        for (int bj = 0; bj < 2; ++bj)
#pragma unroll
                            for (int n = 0; n < 2; ++n) *(f32x4*)(st + 32 * bj + 16 * n) = v[bj][n]; }
                }
                EPI_FENCE();
            }
    }
};
struct EpiResid {
    static constexpr bool PERM = true, AFTER_DRAIN = false;
    float* x; const float* gate; bfu* P;
    __device__ __forceinline__ void operator()(const f32x4 (&acc)[2][2][4][2], const pg8::Unit& u, int wr, int wc, int fr, int fq) const {
        asm volatile("" : "+v"(fr), "+v"(fq));
        const int cond = cond_of_row(u.pm * 256); const unsigned c0 = u.pn * 256 + wc * 32 + 8 * fq; const float* g = gate + cond * 6144 + c0;
#pragma unroll
        for (int ai = 0; ai < 2; ++ai)
#pragma unroll
            for (int m = 0; m < 4; ++m) { const unsigned row = u.pm * 256 + ai * 128 + wr * 64 + m * 16 + fr; const unsigned off = row * 1024u + c0;
#pragma unroll
                for (int bj = 0; bj < 2; ++bj) { const f32x4 g0 = *(const f32x4*)(g + bj * 128), g1 = *(const f32x4*)(g + bj * 128 + 4);
                    const f32x4 y0 = g0 * acc[ai][bj][m][0], y1 = g1 * acc[ai][bj][m][1]; const unsigned o2 = off + bj * 128;
                    if (u.split) { u32x4 w; w.x = pkbf(y0[0], y0[1]); w.y = pkbf(y0[2], y0[3]); w.z = pkbf(y1[0], y1[1]); w.w = pkbf(y1[2], y1[3]); *(u32x4*)(P + ((size_t)(u.split - 1) * 4096 * 1024 + o2)) = w; }
                    else { const f32x4 b0 = *(const f32x4*)(x + o2), b1 = *(const f32x4*)(x + o2 + 4); *(f32x4*)(x + o2) = b0 + y0; *(f32x4*)(x + o2 + 4) = b1 + y1; } }
                EPI_FENCE(); }
    }
};
struct EpiSqRelu {
    static constexpr bool PERM = true, AFTER_DRAIN = false;
    bfu* O; int ldc;
    __device__ __forceinline__ void operator()(const f32x4 (&acc)[2][2][4][2], const pg8::Unit& u, int wr, int wc, int fr, int fq) const {
        asm volatile("" : "+v"(fr), "+v"(fq));
#pragma unroll
        for (int ai = 0; ai < 2; ++ai)
#pragma unroll
            for (int m = 0; m < 4; ++m) { const unsigned row = u.pm * 256 + ai * 128 + wr * 64 + m * 16 + fr; bfu* p = O + ((size_t)row * ldc + u.pn * 256 + wc * 32 + 8 * fq);
#pragma unroll
                for (int bj = 0; bj < 2; ++bj) { f32x4 v0 = acc[ai][bj][m][0], v1 = acc[ai][bj][m][1];
#pragma unroll
                    for (int j = 0; j < 4; ++j) { const float a = fmaxf(v0[j], 0.f), b = fmaxf(v1[j], 0.f); v0[j] = a * a; v1[j] = b * b; }
                    u32x4 w; w.x = pkbf(v0[0], v0[1]); w.y = pkbf(v0[2], v0[3]); w.z = pkbf(v1[0], v1[1]); w.w = pkbf(v1[2], v1[3]);
                    *(u32x4*)(p + bj * 128) = w; }
                EPI_FENCE(); }
    }
};
struct EpiUKV {
    static constexpr bool PERM = true, AFTER_DRAIN = false;
    bfu* Kn; bfu* Vb;
    __device__ __forceinline__ void operator()(const f32x4 (&acc)[2][2][4][2], const pg8::Unit& u, int wr, int wc, int fr, int fq) const {
        asm volatile("" : "+v"(fr), "+v"(fq));
        bfu* base = (wc < 2 ? Kn : Vb) + (2 * u.pn * 64 + 32 * (wc & 1) + 8 * fq);
#pragma unroll
        for (int ai = 0; ai < 2; ++ai)
#pragma unroll
            for (int m = 0; m < 4; ++m) { const unsigned row = u.pm * 256 + ai * 128 + wr * 64 + m * 16 + fr; bfu* p = base + row * 1024u;
#pragma unroll
                for (int bj = 0; bj < 2; ++bj) { const f32x4 v0 = acc[ai][bj][m][0], v1 = acc[ai][bj][m][1];
                    u32x4 w; w.x = pkbf(v0[0], v0[1]); w.y = pkbf(v0[2], v0[3]); w.z = pkbf(v1[0], v1[1]); w.w = pkbf(v1[2], v1[3]);
                    *(u32x4*)(p + bj * 64) = w; }
                EPI_FENCE(); }
    }
};
struct EpiF32 {
    static constexpr bool PERM = false, AFTER_DRAIN = false;
    float* T; int ldc;
    __device__ __forceinline__ void operator()(const f32x4 (&acc)[2][2][4][2], const pg8::Unit& u, int wr, int wc, int fr, int fq) const {
        asm volatile("" : "+v"(fr), "+v"(fq));
#pragma unroll
        for (int ai = 0; ai < 2; ++ai)
#pragma unroll
            for (int m = 0; m < 4; ++m) { const unsigned row = u.pm * 256 + ai * 128 + wr * 64 + m * 16 + fr; float* p = T + ((size_t)row * ldc + u.pn * 256 + wc * 32 + 4 * fq);
#pragma unroll
                for (int bj = 0; bj < 2; ++bj)
#pragma unroll
                    for (int n = 0; n < 2; ++n) *(f32x4*)(p + bj * 128 + n * 16) = acc[ai][bj][m][n];
                EPI_FENCE(); }
    }
};
struct EpiUQ {
    static constexpr bool PERM = false, AFTER_DRAIN = false;
    bfu* Q;
    __device__ __forceinline__ void operator()(const f32x4 (&acc)[2][2][4][2], const pg8::Unit& u, int wr, int wc, int fr, int fq) const {
        asm volatile("" : "+v"(fr), "+v"(fq));
        const bool sample = u.pm >= 16;
        float frq[4];
#pragma unroll
        for (int j = 0; j < 4; ++j) frq[j] = __builtin_amdgcn_exp2f(-(float)(4 * (fq & 1) + j) * (LOG2_THETA / 8.0f)) * INV_2PI;
        const bool lowhalf = fq < 2;
#pragma unroll
        for (int ai = 0; ai < 2; ++ai)
#pragma unroll
            for (int m = 0; m < 4; ++m) { unsigned row = u.pm * 256 + ai * 128 + wr * 64 + m * 16 + fr; asm volatile("" : "+v"(row)); const unsigned t = (row - NP_ROWS) & 4095u;
                bfu* p = Q + (row * 1536u + u.pn * 256 + wc * 32 + 4 * fq);
#pragma unroll
                for (int bj = 0; bj < 2; ++bj) {
                    const int g32 = (u.pn * 256 + bj * 128 + wc * 32) >> 5; const bool ropeg = (g32 % 3) == 2;
#pragma unroll
                    for (int n = 0; n < 2; ++n) { f32x4 v = acc[ai][bj][m][n];
                        if (sample && ropeg) { const float pos = (float)(n == 0 ? (t >> 6) : (t & 63u));
#pragma unroll
                            for (int j = 0; j < 4; ++j) { const float other = __shfl_xor(v[j], 32); const float rev = pos * frq[j]; const float c = __builtin_amdgcn_cosf(rev), s = __builtin_amdgcn_sinf(rev);
                                v[j] = lowhalf ? (v[j] * c - other * s) : (other * s + v[j] * c); } }
                        v = v * (0.10206207261596577f * 1.4426950408889634f);
                        u32x2 w; w.x = pkbf(v[0], v[1]); w.y = pkbf(v[2], v[3]);
                        *(u32x2*)(p + bj * 128 + n * 16) = w; } }
                EPI_FENCE(); }
    }
};
#define XB_TMO      128
#define XB_XCNT(j)  (256  + 64 * (j))
#define XB_XSUB(j)  (1280 + 64 * (j))
#define XB_XGEN(j)  (2304 + 64 * (j))
#define XB_TOP      3328
#define XB_TOPGEN   3392
#define XCD_BAR_WORDS 3456
#define XB_SPIN_CAP (1u << 18)

__device__ __forceinline__ unsigned xb_ld(unsigned* p)              { return __hip_atomic_load(p, __ATOMIC_RELAXED, __HIP_MEMORY_SCOPE_AGENT); }
__device__ __forceinline__ unsigned xb_add(unsigned* p, unsigned v) { return __hip_atomic_fetch_add(p, v, __ATOMIC_RELAXED, __HIP_MEMORY_SCOPE_AGENT); }
__device__ __forceinline__ unsigned xb_xcc_id() { return (unsigned)__builtin_amdgcn_s_getreg((3 << 11) | 20) & 0xFu; }
#define XB_SPIN(cond, bar) do { unsigned _sp = 0; while (cond) { __builtin_amdgcn_s_sleep(1); \
    if ((++_sp & 255u) == 0u) { if (xb_ld(&(bar)[XB_TMO])) break; if (_sp > XB_SPIN_CAP) { atomicAdd(&(bar)[XB_TMO], 1u); break; } } } } while (0)

struct XcdBarrier {
    unsigned* bar; unsigned x;
    volatile LAS unsigned* st;
};

__device__ __forceinline__ XcdBarrier xcd_barrier_post(unsigned* bar, volatile LAS unsigned* st) {
    XcdBarrier b; b.bar = bar; b.x = xb_xcc_id(); b.st = st;
    if (threadIdx.x == 0) (void)xb_add(&bar[XB_XCNT(b.x)], 1u);
    return b;
}
__device__ __forceinline__ void xcd_barrier_complete(unsigned* bar, unsigned x, unsigned& nloc, unsigned& nx) {
    const unsigned G = gridDim.x * gridDim.y * gridDim.z;
    unsigned sum, cnt, mine, sp = 0u;
    for (;;) {
        sum = 0u; cnt = 0u; mine = 0u;
#pragma unroll
        for (unsigned j = 0; j < 16; ++j) { const unsigned c = xb_ld(&bar[XB_XCNT(j)]); sum += c; cnt += (c > 0u) ? 1u : 0u; mine = (j == x) ? c : mine; }
        if (sum == G) break;
        __builtin_amdgcn_s_sleep(1);
        if ((++sp & 255u) == 0u) { if (xb_ld(&bar[XB_TMO])) break; if (sp > XB_SPIN_CAP) { atomicAdd(&bar[XB_TMO], 1u); break; } }
    }
    nloc = mine > 0u ? mine : 1u; nx = cnt > 0u ? cnt : 1u;
}

__device__ __forceinline__ void xcd_barrier(const XcdBarrier& b) {
    asm volatile("s_waitcnt vmcnt(0)" ::: "memory");
    __syncthreads();
    if (threadIdx.x == 0) {
        unsigned* bar = b.bar;
        __builtin_amdgcn_s_waitcnt(0);
        unsigned nloc = b.st[0], nx = b.st[1];
        if (nloc == 0u) { xcd_barrier_complete(bar, b.x, nloc, nx); b.st[0] = nloc; b.st[1] = nx; }
        const unsigned old = xb_add(&bar[XB_XSUB(b.x)], 1u);
        const unsigned gen = old / nloc;
        if (old + 1u == (gen + 1u) * nloc) {
            __builtin_amdgcn_fence(__ATOMIC_RELEASE, "agent");
            asm volatile("s_waitcnt vmcnt(0)" ::: "memory");
            const unsigned og = xb_add(&bar[XB_TOP], 1u);
            const unsigned tg = og / nx;
            if (og + 1u == (tg + 1u) * nx) xb_add(&bar[XB_TOPGEN], 1u);
            else XB_SPIN(xb_ld(&bar[XB_TOPGEN]) == tg, bar);
            __builtin_amdgcn_fence(__ATOMIC_ACQUIRE, "agent");
            xb_add(&bar[XB_XGEN(b.x)], 1u);
            asm volatile("s_waitcnt vmcnt(0)" ::: "memory");
        } else {
            XB_SPIN(xb_ld(&bar[XB_XGEN(b.x)]) == gen, bar);
            __builtin_amdgcn_fence(__ATOMIC_ACQUIRE, "agent");
            asm volatile("s_waitcnt vmcnt(0)" ::: "memory");
        }
    }
    __syncthreads();
}

constexpr size_t MiB = 1u << 20;
constexpr size_t WT_MLP_IN = 0;
constexpr size_t WT_MLP_OUT = 4 * (size_t)DM * DFF;
constexpr size_t WT_A_QKV = 8 * (size_t)DM * DFF;
constexpr size_t WT_A_O = WT_A_QKV + 2 * 1536 * 1024;
constexpr size_t WT_C_QKV = WT_A_O + 2 * 1024 * 1024;
constexpr size_t WT_C_O = WT_C_QKV + 1536 * 1024;
constexpr size_t WT_B_DQKV = WT_C_O + 1024 * 1024;
constexpr size_t WT_B_UQ = WT_B_DQKV + 768 * 1024;
constexpr size_t WT_B_UKV = WT_B_UQ + 1536 * 384;
constexpr size_t WT_B_O = WT_B_UKV + 2048 * 256;
constexpr size_t WT_END = WT_B_O + 1024 * 1024;
static_assert(WT_END * 2 <= 88 * MiB, "WT region");
constexpr size_t WS_WT = 0, WS_MODS = 88 * MiB, WS_KR = 89 * MiB, WS_CKVN = 91 * MiB, WS_DQN = 102 * MiB, WS_H = 117 * MiB, WS_R1 = 157 * MiB;
constexpr size_t WS_Q = WS_R1, WS_K = WS_R1 + 60 * MiB, WS_V = WS_K + 42 * MiB, WS_T = WS_R1, WS_HID = WS_R1, WS_CTL = WS_R1 + 160 * MiB, WS_P = WS_CTL + 1 * MiB, WS_END = WS_P + 64 * MiB;

#define GAS1 __attribute__((address_space(1)))
struct Args { const GAS1 float* in[30]; GAS1 float* out; GAS1 unsigned char* ws; int ph_lo, ph_hi; };
struct ArgsH { const float* in[30]; float* out; unsigned char* ws; int ph_lo, ph_hi; };
static_assert(sizeof(Args) == sizeof(ArgsH), "Args layout");

__device__ __forceinline__ float wave_sum(float v) {
#pragma unroll
    for (int o = 1; o < 64; o <<= 1) v += __shfl_xor(v, o);
    return v;
}
template <int MAP>
__device__ __forceinline__ void transpose_item(const float* W, int K, int N, bfu* WT, int row_off, LAS float* scr, int item, int lane) {
    const int nblk = N / 32, kb = item / nblk, nb = item % nblk, k0 = 64 * kb, n0 = 32 * nb;
#pragma unroll 8
    for (int i = 0; i < 32; ++i) { const int kk = 2 * i + (lane >> 5); scr[kk * 33 + (lane & 31)] = W[(size_t)(k0 + kk) * N + n0 + (lane & 31)]; }
    asm volatile("s_waitcnt lgkmcnt(0)" ::: "memory");
    const int c = lane & 7;
#pragma unroll
    for (int j = 0; j < 4; ++j) { const int n = (lane >> 3) + 8 * j; const LAS float* s = scr + (8 * c) * 33 + n;
        u32x4 o; o.x = pkbf(s[0 * 33], s[1 * 33]); o.y = pkbf(s[2 * 33], s[3 * 33]); o.z = pkbf(s[4 * 33], s[5 * 33]); o.w = pkbf(s[6 * 33], s[7 * 33]);
        int src = n0 + n, dst;
        if (MAP == 1) { const int tile = src >> 8, loc = src & 255, hl = loc >> 6, d = loc & 63; dst = tile * 256 + (d >> 5) * 128 + hl * 32 + (d & 31); } else dst = row_off + src;
        *(u32x4*)(WT + (size_t)dst * K + k0 + 8 * c) = o; }
    asm volatile("s_waitcnt lgkmcnt(0)" ::: "memory");
}
struct Row4 { f32x4 a, b, c, d; };
__device__ __forceinline__ Row4 ldrow(const float* xrow, int lane) {
    Row4 r; r.a = *((const f32x4*)xrow + lane); r.b = *((const f32x4*)xrow + lane + 64); r.c = *((const f32x4*)xrow + lane + 128); r.d = *((const f32x4*)xrow + lane + 192); return r;
}
__device__ __forceinline__ void norm_row(const Row4 rw, float* xrow, const bfu* prow, const float* g, const float* shift, const float* scale, bfu* orow, int lane) {
    f32x4 v[4]; v[0] = rw.a; v[1] = rw.b; v[2] = rw.c; v[3] = rw.d; float s = 0.f;
#pragma unroll
    for (int j = 0; j < 4; ++j) {
        if (prow) { const u32x2* pp = (const u32x2*)prow + lane + 64 * j;
#pragma unroll
            for (int q = 0; q < 4; ++q) { const u32x2 w = pp[(size_t)q * 1048576]; v[j][0] += __uint_as_float(w.x << 16); v[j][1] += __uint_as_float(w.x & 0xffff0000u); v[j][2] += __uint_as_float(w.y << 16); v[j][3] += __uint_as_float(w.y & 0xffff0000u); }
            *((f32x4*)xrow + lane + 64 * j) = v[j]; } s += (v[j][0] * v[j][0] + v[j][1] * v[j][1]) + (v[j][2] * v[j][2] + v[j][3] * v[j][3]); }
    const float rstd = 1.0f / sqrtf(wave_sum(s) * (1.0f / 1024.0f) + EPS_);
#pragma unroll
    for (int j = 0; j < 4; ++j) { const int c = 4 * lane + 256 * j; const f32x4 gv = *(const f32x4*)(g + c), sh = *(const f32x4*)(shift + c), sc = *(const f32x4*)(scale + c);
        const f32x4 y = v[j] * rstd * gv * (sc + 1.0f) + sh; u32x2 w; w.x = pkbf(y[0], y[1]); w.y = pkbf(y[2], y[3]); *((u32x2*)orow + lane + 64 * j) = w; }
}
__device__ __forceinline__ void cvt_rows(const float* src, size_t src_stride, bfu* dst, size_t dst_stride, int nrows, int ncols, int gtid, int gthreads) {
    const int cpr = ncols / 8;
    for (long i = gtid; i < (long)nrows * cpr; i += gthreads) { const int r = (int)(i / cpr), c = (int)(i % cpr) * 8;
        const f32x4 a = *(const f32x4*)(src + (size_t)r * src_stride + c), b = *(const f32x4*)(src + (size_t)r * src_stride + c + 4);
        u32x4 w; w.x = pkbf(a[0], a[1]); w.y = pkbf(a[2], a[3]); w.z = pkbf(b[0], b[1]); w.w = pkbf(b[2], b[3]); *(u32x4*)(dst + (size_t)r * dst_stride + c) = w; }
}

#ifndef G_ALIGN
#define G_ALIGN true
#endif
#ifndef G_SP2
#define G_SP2 true
#endif
#ifndef QKV_SP2
#define QKV_SP2 true
#endif
struct LdsOrder {
    const LAS int* ul;
    __device__ __forceinline__ bool next(int i, pg8::Unit& u) const {
        if (i >= 16) return false;
        const LAS int* p = ul + i * 8;
        const int ok = __builtin_amdgcn_readfirstlane(p[0]); if (!ok) return false;
        u.pm = __builtin_amdgcn_readfirstlane(p[1]); u.pn = __builtin_amdgcn_readfirstlane(p[2]); u.kt0 = __builtin_amdgcn_readfirstlane(p[3]);
        u.nt = __builtin_amdgcn_readfirstlane(p[4]); u.split = __builtin_amdgcn_readfirstlane(p[5]); return true;
    }
    __device__ __forceinline__ void a_ready(const pg8::Unit&) const {}
    __device__ __forceinline__ void done(const pg8::Unit&) const {}
};
constexpr int LDS_UNITS = 131072;
template <class Epi, bool SP2 = G_SP2, bool SPLIT = false>
__device__ __forceinline__ void run_gemm(LAS unsigned char* lds, const bfu* A, const bfu* Bt, int M, int N, int K, const Epi& E) {
    int Kv = K; asm volatile("" : "+s"(Kv));
    LAS int* ul = (LAS int*)(lds + LDS_UNITS);
    { const int t = opaque_tid();
      if (t < 16) { int G_ = gridDim.x, bx_ = blockIdx.x; pg8::StaticOrder S; S.init(M, N, G_, bx_, Kv / 64, SPLIT); const pg8::Unit u = S.get(t);
          ul[t * 8 + 0] = u.nt > 0 ? 1 : 0; ul[t * 8 + 1] = u.pm; ul[t * 8 + 2] = u.pn; ul[t * 8 + 3] = u.kt0; ul[t * 8 + 4] = u.nt; ul[t * 8 + 5] = u.split; }
      __syncthreads(); }
    pg8::Gemm g{A, Bt, M, N, Kv}; LdsOrder S{ul};
    pg8::gemm_phase<Epi, LdsOrder, G_ALIGN, SP2>(lds, g, S, E);
    __syncthreads();
}

constexpr int LDS_BYTES = 147456, LDS_MISC = 147456 - 64;
constexpr int N_PHASES = 32;
#ifndef REP_ATT
#define REP_ATT 1
#endif
#ifndef REP_UP
#define REP_UP 1
#endif
#ifndef REP_RES
#define REP_RES 1
#endif
#ifndef REP_NORM
#define REP_NORM 1
#endif
#ifndef REP_P0
#define REP_P0 1
#endif
#ifndef PH_MASK
#define PH_MASK 0xffff
#endif
#define EN(k) (((PH_MASK) >> (k)) & 1)

typedef const __attribute__((address_space(4))) Args* KArgsP;
__device__ __forceinline__ KArgsP ka() { KArgsP p = (KArgsP)__builtin_amdgcn_kernarg_segment_ptr(); asm volatile("" : "+s"(p)); return p; }
__global__ void __launch_bounds__(512, 2) mega_fwd(Args args) {
    extern __shared__ __attribute__((aligned(16))) unsigned char lds[];
    cg::grid_group grid = cg::this_grid();
    const int lo = args.ph_lo, hi = args.ph_hi; int ph = 0;
    XcdBarrier xbar; xbar.bar = nullptr; xbar.x = 0; xbar.st = nullptr;
    if (hi - lo > 1) {
        volatile LAS unsigned* misc = (volatile LAS unsigned*)((LAS unsigned char*)lds + LDS_MISC);
        if (threadIdx.x < 16) misc[threadIdx.x] = 0u;
        __syncthreads();
        xbar = xcd_barrier_post((unsigned*)((unsigned char*)args.ws + WS_CTL), misc + 8);
    }
#define INP(i) ((const float*)A->in[i])
#define PHASE_LOCALS KArgsP A = ka(); const int tid = opaque_tid(), lane = tid & 63, wave = __builtin_amdgcn_readfirstlane(tid >> 6); \
    int G = gridDim.x, bx = blockIdx.x; asm volatile("" : "+s"(G), "+s"(bx)); const int vcu = (G % 8 == 0) ? (bx % 8) * (G / 8) + bx / 8 : bx; \
    const int gw = bx * 8 + wave, NGW = G * 8, gtid = bx * 512 + tid, GT = G * 512; (void)lane; (void)vcu; (void)gw; (void)NGW; (void)gtid; (void)GT; \
    LAS unsigned char* const ldsl = (LAS unsigned char*)lds; (void)ldsl; unsigned char* const ws = (unsigned char*)A->ws; float* const X = (float*)A->out; \
    bfu* const WT = (bfu*)(ws + WS_WT); float* const mods = (float*)(ws + WS_MODS); bfu* const KR = (bfu*)(ws + WS_KR); bfu* const CKVN = (bfu*)(ws + WS_CKVN); bfu* const DQN = (bfu*)(ws + WS_DQN); \
    bfu* const HB = (bfu*)(ws + WS_H); bfu* const QB = (bfu*)(ws + WS_Q); bfu* const KB = (bfu*)(ws + WS_K); bfu* const VB = (bfu*)(ws + WS_V); float* const TB = (float*)(ws + WS_T); bfu* const HID = (bfu*)(ws + WS_HID); \
    float* const st_a_k = X + 20971520; float* const st_a_v = X + 23068672; float* const st_b_ckv = X + 25165824; float* const st_b_kr = X + 26214400; float* const st_c_k = X + 26345472; float* const st_c_v = X + 27394048; \
    const float* const modl = mods + (size_t)layer * 5 * 6144; const float* const ng = INP(12) + (size_t)layer * 2 * 1024; \
    (void)WT; (void)KR; (void)CKVN; (void)DQN; (void)HB; (void)QB; (void)KB; (void)VB; (void)TB; (void)HID; (void)st_a_k; (void)st_a_v; (void)st_b_ckv; (void)st_b_kr; (void)st_c_k; (void)st_c_v; (void)modl; (void)ng;
#define PH_BEGIN if (ph >= lo && ph < hi) { PHASE_LOCALS
#ifndef REP_SYNC
#define REP_SYNC 1
#endif
#define PH_END if (ph + 1 < hi) { for (int rs_ = 0; rs_ < REP_SYNC; ++rs_) { if (ph == 0) grid.sync(); else xcd_barrier(xbar); } } } ++ph;

    { const int layer = 0;
    PH_BEGIN
    if constexpr (EN(0)) for (int rep_ = 0; rep_ < REP_P0; ++rep_) {
        if (rep_) __syncthreads();
        LAS float* scr = (LAS float*)(ldsl + wave * 16384);
        for (int seg = 0; seg < 20; ++seg) {
            const float* W; int K, N, map = 0, roff = 0; size_t dsto;
            if (seg < 4)       { W = INP(13) + (size_t)seg * DM * DFF; K = DM; N = DFF; dsto = WT_MLP_IN + (size_t)seg * DM * DFF; }
            else if (seg < 8)  { W = INP(14) + (size_t)(seg - 4) * DM * DFF; K = DFF; N = DM; dsto = WT_MLP_OUT + (size_t)(seg - 4) * DM * DFF; }
            else if (seg < 10) { W = INP(15) + (size_t)(seg - 8) * 1024 * 1536; K = 1024; N = 1536; dsto = WT_A_QKV + (size_t)(seg - 8) * 1536 * 1024; map = 1; }
            else if (seg < 12) { W = INP(17) + (size_t)(seg - 10) * 1024 * 1024; K = 1024; N = 1024; dsto = WT_A_O + (size_t)(seg - 10) * 1024 * 1024; }
            else if (seg == 12) { W = INP(25); K = 1024; N = 1536; dsto = WT_C_QKV; map = 1; }
            else if (seg == 13) { W = INP(28); K = 1024; N = 1024; dsto = WT_C_O; }
            else if (seg == 14) { W = INP(18); K = 1024; N = 384; dsto = WT_B_DQKV; }
            else if (seg == 15) { W = INP(21); K = 1024; N = 288; dsto = WT_B_DQKV; roff = 384; }
            else if (seg == 16) { W = INP(20); K = 384; N = 1536; dsto = WT_B_UQ; }
            else if (seg == 17) { W = INP(23); K = 256; N = 2048; dsto = WT_B_UKV; }
            else if (seg == 18) { W = INP(24); K = 1024; N = 1024; dsto = WT_B_O; }
            else break;
            const int nitems = (K / 64) * (N / 32);
            if (map == 1) { for (int it = gw; it < nitems; it += NGW) transpose_item<1>(W, K, N, WT + dsto, 0, scr, it, lane); }
            else          { for (int it = gw; it < nitems; it += NGW) transpose_item<0>(W, K, N, WT + dsto, roff, scr, it, lane); }
        }
        for (int i = gtid; i < 96 * 1024 / 8; i += GT) *(u32x4*)(WT + WT_B_DQKV + (size_t)672 * 1024 + (size_t)i * 8) = (u32x4){0u, 0u, 0u, 0u};
        { const f32x4* s0 = (const f32x4*)INP(0); const f32x4* s1 = (const f32x4*)INP(1); f32x4* d = (f32x4*)X;
          for (long i = gtid; i < (long)M_ROWS * 256; i += GT) d[i] = i < (long)NP_ROWS * 256 ? s0[i] : s1[i - (long)NP_ROWS * 256]; }
        __syncthreads();
        LAS float* sc = (LAS float*)ldsl;
        LAS float* part = (LAS float*)(ldsl + 20480);
        for (int i = tid; i < 5 * 1024; i += 512) { const int cnd = i >> 10, k = i & 1023; const float v = cnd < 4 ? INP(2)[cnd * 1024 + k] : INP(9)[k]; sc[i] = v / (1.0f + __expf(-v)); }
        __syncthreads();
        for (int item = bx; item < 4 * 96; item += G) {
            const int l = item / 96, cb = item % 96, col = cb * 64 + lane; const float* Wl = INP(10) + (size_t)l * 1024 * 6144;
            float a0 = 0.f, a1 = 0.f, a2 = 0.f, a3 = 0.f, a4 = 0.f;
#pragma unroll 8
            for (int kk = 0; kk < 128; ++kk) { const int k = wave * 128 + kk; const float w = Wl[(size_t)k * 6144 + col];
                a0 += sc[k] * w; a1 += sc[1024 + k] * w; a2 += sc[2048 + k] * w; a3 += sc[3072 + k] * w; a4 += sc[4096 + k] * w; }
            part[(wave * 5 + 0) * 64 + lane] = a0; part[(wave * 5 + 1) * 64 + lane] = a1; part[(wave * 5 + 2) * 64 + lane] = a2; part[(wave * 5 + 3) * 64 + lane] = a3; part[(wave * 5 + 4) * 64 + lane] = a4;
            __syncthreads();
            if (tid < 320) { const int cnd = tid >> 6, ln = tid & 63; float s = INP(11)[l * 6144 + cb * 64 + ln];
#pragma unroll
                for (int w8 = 0; w8 < 8; ++w8) s += part[(w8 * 5 + cnd) * 64 + ln];
                mods[((size_t)l * 5 + cnd) * 6144 + cb * 64 + ln] = s; }
            __syncthreads();
        }
    }
    PH_END
    }

    for (int layer = 0; layer < 4; ++layer) {
        const int kind = layer % 3, jj = layer / 3;
        PH_BEGIN
        if constexpr (EN(1))
        { Row4 nv_ = ldrow(X + (size_t)(gw < M_ROWS ? gw : 0) * 1024, lane);
        for (int r = gw; r < M_ROWS; r += NGW) { const Row4 v_ = nv_; { const int rn_ = r + NGW < M_ROWS ? r + NGW : r; nv_ = ldrow(X + (size_t)rn_ * 1024, lane); }
            const float* mc = modl + cond_of_row(r) * 6144; const bfu* pr = (G == 256 && layer > 0 && r < NP_ROWS) ? (const bfu*)(ws + WS_P) + (size_t)r * 1024 : nullptr; norm_row(v_, X + (size_t)r * 1024, pr, ng, mc, mc + 1024, HB + (size_t)r * 1024, lane); } }
        if constexpr (EN(1))
        for (int b = 0; b < 4; ++b) {
            const size_t e0 = NP_ROWS + (size_t)b * EXT_B;
            if (kind == 0)      { cvt_rows(INP(3) + (size_t)(b * 2 + jj) * 65536, 256, KB + e0 * 256, 256, 256, 256, gtid, GT); cvt_rows(INP(4) + (size_t)(b * 2 + jj) * 65536, 256, VB + e0 * 256, 256, 256, 256, gtid, GT); }
            else if (kind == 2) { cvt_rows(INP(7) + (size_t)b * 65536, 256, KB + e0 * 256, 256, 256, 256, gtid, GT); cvt_rows(INP(8) + (size_t)b * 65536, 256, VB + e0 * 256, 256, 256, 256, gtid, GT); }
            else                { cvt_rows(INP(5) + (size_t)b * 65536, 256, CKVN + e0 * 256, 256, 256, 256, gtid, GT); cvt_rows(INP(6) + (size_t)b * 8192, 32, KR + e0 * 32, 32, 256, 32, gtid, GT); }
        }
        PH_END
        if (kind == 1) {
            PH_BEGIN
            if constexpr (EN(2)) { EpiF32 E{TB, 1024}; run_gemm(ldsl, HB, WT + WT_B_DQKV, M_ROWS, 768, 1024, E); }
            PH_END
            PH_BEGIN
            if constexpr (EN(3))
            for (int r = gw; r < M_ROWS; r += NGW) {
                const float* tr = TB + (size_t)r * 1024; f32x4 v[3];
#pragma unroll
                for (int k = 0; k < 3; ++k) v[k] = *(const f32x4*)(tr + 4 * lane + 256 * k);
                float sq = (v[0][0] * v[0][0] + v[0][1] * v[0][1]) + (v[0][2] * v[0][2] + v[0][3] * v[0][3]);
                const float s1 = (v[1][0] * v[1][0] + v[1][1] * v[1][1]) + (v[1][2] * v[1][2] + v[1][3] * v[1][3]);
                const float s2 = (v[2][0] * v[2][0] + v[2][1] * v[2][1]) + (v[2][2] * v[2][2] + v[2][3] * v[2][3]);
                float skv = 0.f;
                if (lane < 32) { sq += s1; skv = s2; } else { skv = s1; }
                sq = wave_sum(sq); skv = wave_sum(skv);
                const float rq = 1.0f / sqrtf(sq * (1.0f / 384.0f) + EPS_), rkv = 1.0f / sqrtf(skv * (1.0f / 256.0f) + EPS_);
                const bool sample = r >= NP_ROWS; const int e = ext_of_row(r); const int t = (r - NP_ROWS) & 4095;
                { const f32x4 g = *(const f32x4*)(INP(19) + 4 * lane); const f32x4 y = v[0] * rq * g; u32x2 w; w.x = pkbf(y[0], y[1]); w.y = pkbf(y[2], y[3]); *(u32x2*)(DQN + (size_t)r * 384 + 4 * lane) = w; }
                if (lane < 32) {
                    { const f32x4 g = *(const f32x4*)(INP(19) + 256 + 4 * lane); const f32x4 y = v[1] * rq * g; u32x2 w; w.x = pkbf(y[0], y[1]); w.y = pkbf(y[2], y[3]); *(u32x2*)(DQN + (size_t)r * 384 + 256 + 4 * lane) = w; }
                    { const int c = 128 + 4 * lane; const f32x4 g = *(const f32x4*)(INP(22) + c); const f32x4 y = v[2] * rkv * g; u32x2 w; w.x = pkbf(y[0], y[1]); w.y = pkbf(y[2], y[3]); *(u32x2*)(CKVN + (size_t)e * 256 + c) = w;
                      if (!sample) *(f32x4*)(st_b_ckv + (size_t)r * 256 + c) = y; }
                } else {
                    { const int c = 4 * (lane - 32); const f32x4 g = *(const f32x4*)(INP(22) + c); const f32x4 y = v[1] * rkv * g; u32x2 w; w.x = pkbf(y[0], y[1]); w.y = pkbf(y[2], y[3]); *(u32x2*)(CKVN + (size_t)e * 256 + c) = w;
                      if (!sample) *(f32x4*)(st_b_ckv + (size_t)r * 256 + c) = y; }
                }
                { f32x4 y = v[2]; const int l8 = lane - 32;
                  f32x4 oth; oth[0] = __shfl_xor(y[0], 2); oth[1] = __shfl_xor(y[1], 2); oth[2] = __shfl_xor(y[2], 2); oth[3] = __shfl_xor(y[3], 2);
                  if (lane >= 32 && lane < 40) {
                      if (sample) { const int pos = l8 < 4 ? (t >> 6) : (t & 63); const bool first = (l8 & 2) == 0;
#pragma unroll
                          for (int j = 0; j < 4; ++j) { float c, s; rope_cs(pos, 4 * (l8 & 1) + j, 1.0f / 8.0f, c, s); y[j] = first ? (y[j] * c - oth[j] * s) : (oth[j] * s + y[j] * c); } }
                      else *(f32x4*)(st_b_kr + (size_t)r * 32 + 4 * l8) = y;
                      u32x2 w; w.x = pkbf(y[0], y[1]); w.y = pkbf(y[2], y[3]); *(u32x2*)(KR + (size_t)e * 32 + 4 * l8) = w; } }
            }
            PH_END
            PH_BEGIN
            if constexpr (EN(4)) { EpiUQ E{QB}; run_gemm(ldsl, DQN, WT + WT_B_UQ, M_ROWS, 1536, 384, E); }
            if constexpr (EN(5)) { EpiUKV E{KB, VB}; run_gemm(ldsl, CKVN, WT + WT_B_UKV, EXT_ROWS, 2048, 256, E); }
            PH_END
        } else if (kind == 0) {
            PH_BEGIN
            if constexpr (EN(6)) { EpiQKV<false> E{QB, KB, VB, st_a_k + (size_t)jj * 65536, st_a_v + (size_t)jj * 65536, nullptr, nullptr, 2}; run_gemm(ldsl, HB, WT + WT_A_QKV + (size_t)jj * 1536 * 1024, M_ROWS, 1536, 1024, E); }
            PH_END
        } else {
            PH_BEGIN
            if constexpr (EN(7)) { EpiQKV<true> E{QB, KB, VB, st_c_k, st_c_v, INP(26), INP(27), 1}; run_gemm<EpiQKV<true>, QKV_SP2>(ldsl, HB, WT + WT_C_QKV, M_ROWS, 1536, 1024, E); }
            PH_END
        }
        PH_BEGIN
        for (int rep_ = 0; rep_ < REP_ATT; ++rep_)
        for (int i = 0; i < 5; ++i) {
            const int ui = i * G + vcu; if (ui >= 1280) break;
            att::Unit U; int b, h, qb; bool prompt = ui >= 1024;
            if (!prompt) { if (kind == 1) { qb = ui & 15; h = (ui >> 4) & 15; b = ui >> 8; } else { qb = ui & 15; const int g4 = (ui >> 4) & 3, kvh = (ui >> 6) & 3; b = ui >> 8; h = kvh * 4 + g4; } }
            else { const int u2 = ui - 1024; qb = 0; h = u2 & 15; b = u2 >> 4; if (kind != 1) { h = ((u2 >> 2) & 3) * 4 + (u2 & 3); } }
            const int r0 = prompt ? b * 256 : NP_ROWS + b * 4096 + qb * 256; const size_t ebase = prompt ? (size_t)b * 256 : NP_ROWS + (size_t)b * EXT_B;
            U.O = HB + (size_t)r0 * 1024 + h * 64; U.q0 = qb * 256; U.kstart = 0; U.sinkl2 = -1e30f;
            if (kind == 1) { U.Q = QB + (size_t)r0 * 1536 + h * 96; U.ldq = 1536; U.K = KB + ebase * 1024 + h * 64; U.V = VB + ebase * 1024 + h * 64; U.KR = KR + ebase * 32; U.ldk = 1024;
                U.NT = prompt ? 4 : 68; U.C = 0.10206207261596577f * 1.4426950408889634f; U.thr_raw = 8.0f / 0.10206207261596577f; }
            else { const int kvh = h >> 2; U.Q = QB + (size_t)r0 * 1024 + h * 64; U.ldq = 1024; U.K = KB + ebase * 256 + kvh * 64; U.V = VB + ebase * 256 + kvh * 64; U.KR = nullptr; U.ldk = 256;
                U.NT = prompt ? 4 : 68; U.C = 0.125f * 1.4426950408889634f; U.thr_raw = 64.0f;
                if (kind == 0) { U.sinkl2 = INP(16)[jj * 16 + h] * 1.4426950408889634f;
                    if (!prompt) { const int q0 = qb * 256; const int ks = q0 - 128 < 0 ? 0 : q0 - 128; const int ke = q0 + 384 > 4096 ? 4096 : q0 + 384; U.kstart = ks; U.NT = 4 + (ke - ks) / 64; } } }
            if (kind == 1) { if constexpr (EN(8)) att::attn_unit<96, false>(U, (char*)lds); }
            else if (kind == 0) { if constexpr (EN(9)) att::attn_unit<64, true>(U, (char*)lds); }
            else { if constexpr (EN(10)) att::attn_unit<64, false>(U, (char*)lds); }
        }
        PH_END
        PH_BEGIN
        if constexpr (EN(11)) { const bfu* wo = WT + (kind == 0 ? WT_A_O + (size_t)jj * 1024 * 1024 : kind == 1 ? WT_B_O : WT_C_O); EpiResid E{X, modl + 2048, (bfu*)(ws + WS_P)}; run_gemm<EpiResid, G_SP2, true>(ldsl, HB, wo, M_ROWS, 1024, 1024, E); }
        PH_END
        PH_BEGIN
        if constexpr (EN(1))
        { Row4 nv_ = ldrow(X + (size_t)(gw < M_ROWS ? gw : 0) * 1024, lane);
        for (int r = gw; r < M_ROWS; r += NGW) { const Row4 v_ = nv_; { const int rn_ = r + NGW < M_ROWS ? r + NGW : r; nv_ = ldrow(X + (size_t)rn_ * 1024, lane); }
            const float* mc = modl + cond_of_row(r) * 6144; const bfu* pr = (G == 256 && r < NP_ROWS) ? (const bfu*)(ws + WS_P) + (size_t)r * 1024 : nullptr; norm_row(v_, X + (size_t)r * 1024, pr, ng + 1024, mc + 3072, mc + 4096, HB + (size_t)r * 1024, lane); } }
        PH_END
        PH_BEGIN
        for (int rep_ = 0; rep_ < REP_UP; ++rep_)
        if constexpr (EN(12)) { EpiSqRelu E{HID, DFF}; run_gemm(ldsl, HB, WT + WT_MLP_IN + (size_t)layer * DM * DFF, M_ROWS, DFF, DM, E); }
        PH_END
        PH_BEGIN
        if constexpr (EN(11)) { EpiResid E{X, modl + 5120, (bfu*)(ws + WS_P)}; run_gemm<EpiResid, G_SP2, true>(ldsl, HID, WT + WT_MLP_OUT + (size_t)layer * DM * DFF, M_ROWS, DM, DFF, E); }
        PH_END
    }
    { const int layer = 0;
    PH_BEGIN
    if constexpr (EN(1))
    for (int r = gw; r < M_ROWS; r += NGW) {
        float* xr = X + (size_t)r * 1024; f32x4 v[4]; float s = 0.f;
#pragma unroll
        for (int j = 0; j < 4; ++j) { v[j] = *((const f32x4*)xr + lane + 64 * j);
            if (G == 256 && r < NP_ROWS) { const u32x2* pp = (const u32x2*)((const bfu*)(ws + WS_P) + (size_t)r * 1024) + lane + 64 * j;
#pragma unroll
                for (int q = 0; q < 4; ++q) { const u32x2 w = pp[(size_t)q * 1048576]; v[j][0] += __uint_as_float(w.x << 16); v[j][1] += __uint_as_float(w.x & 0xffff0000u); v[j][2] += __uint_as_float(w.y << 16); v[j][3] += __uint_as_float(w.y & 0xffff0000u); } }
            s += (v[j][0] * v[j][0] + v[j][1] * v[j][1]) + (v[j][2] * v[j][2] + v[j][3] * v[j][3]); }
        const float rstd = 1.0f / sqrtf(wave_sum(s) * (1.0f / 1024.0f) + EPS_);
#pragma unroll
        for (int j = 0; j < 4; ++j) { const f32x4 g = *(const f32x4*)(INP(29) + 4 * lane + 256 * j); *((f32x4*)xr + lane + 64 * j) = v[j] * rstd * g; }
    }
    PH_END
    }
#undef PH_BEGIN
#undef PH_END
}

#ifndef MK_MULTI
#define MK_MULTI 0
#endif
extern "C" void kernel_launch(void* const* d_in, const int* in_sizes, int n_in, void* d_out, int out_size, void* d_ws, size_t ws_size, hipStream_t stream) {
    static int grid = 0;
    if (grid == 0) {
        if (n_in != 30 || ws_size < WS_END) { fprintf(stderr, "kernel_launch: n_in %d ws %zu (need %zu)\n", n_in, ws_size, (size_t)WS_END); grid = -1; return; }
        int dev = 0, cus = 0, per_cu = 0;
        hipGetDevice(&dev); hipDeviceGetAttribute(&cus, hipDeviceAttributeMultiprocessorCount, dev);
        if (hipFuncSetAttribute((const void*)mega_fwd, hipFuncAttributeMaxDynamicSharedMemorySize, LDS_BYTES) != hipSuccess) { fprintf(stderr, "kernel_launch: hipFuncSetAttribute failed\n"); grid = -1; return; }
        hipOccupancyMaxActiveBlocksPerMultiprocessor(&per_cu, (const void*)mega_fwd, 512, LDS_BYTES);
        if (per_cu < 1) { fprintf(stderr, "kernel_launch: occupancy query says %d\n", per_cu); per_cu = 1; }
        (void)hipGetLastError();
        grid = cus * 1;
    }
    if (grid < 0) return;
    ArgsH a{};
    for (int i = 0; i < 30; ++i) a.in[i] = (const float*)d_in[i];
    a.out = (float*)d_out; a.ws = (unsigned char*)d_ws;
    if (hipMemsetAsync((char*)d_ws + WS_CTL, 0, 16384, stream) != hipSuccess) { fprintf(stderr, "memset failed\n"); return; }
#if MK_MULTI
    for (int p = 0; p < N_PHASES; ++p) { a.ph_lo = p; a.ph_hi = p + 1; void* kargs[] = {&a}; hipError_t e = hipLaunchKernel((const void*)mega_fwd, dim3(grid), dim3(512), kargs, LDS_BYTES, stream); if (e != hipSuccess) { fprintf(stderr, "launch %d failed: %s\n", p, hipGetErrorString(e)); break; } }
#else
    a.ph_lo = 0; a.ph_hi = N_PHASES;
    void* kargs[] = {&a};
    hipError_t e = hipLaunchCooperativeKernel((const void*)mega_fwd, dim3(grid), dim3(512), kargs, LDS_BYTES, stream);
    if (e != hipSuccess) fprintf(stderr, "cooperative launch failed: %s (grid %d)\n", hipGetErrorString(e), grid);
#endif
}
```

```cpp
#include <hip/hip_runtime.h>
#include <hip/hip_cooperative_groups.h>
#include <cstdio>
#include <cstdint>
namespace cg = cooperative_groups;
#define LAS __attribute__((address_space(3)))
__device__ __forceinline__ int opaque_tid() { int t = threadIdx.x; asm volatile("" : "+v"(t)); return t; }
namespace pg8 {
#define PG8_LAS __attribute__((address_space(3)))
typedef unsigned short bf16_t;
typedef short bf16x8 __attribute__((ext_vector_type(8)));
typedef float f32x4 __attribute__((ext_vector_type(4)));
typedef unsigned u32x4 __attribute__((ext_vector_type(4)));
constexpr int BM = 256, BK = 64, HALF = 128, HTB = HALF * BK * 2  , STAGE_BYTES = 8 * HTB, NXCD = 8, WGM = 8;

__host__ __device__ __forceinline__ int lds_byte(int r, int c) { const int st = (r >> 4) * 2 + (c >> 5), rr = r & 15, cc = c & 31, ob = rr * 64 + cc * 2; return st * 1024 + (ob ^ (((ob >> 9) & 1) << 5)); }
__host__ __device__ __forceinline__ void stage_rc(int b, int& R, int& C) { const int st = b / 1024, sb = b % 1024, swz = sb ^ (((sb >> 9) & 1) << 5); R = (st >> 1) * 16 + swz / 64; C = (st & 1) * 32 + (swz % 64) / 2; }
__host__ __device__ __forceinline__ int perm32(int rho) { const int n = rho >> 4, i = rho & 15; return 8 * (i >> 2) + 4 * n + (i & 3); }

struct Unit { int pm, pn, kt0, nt, split; };
struct Gemm { const bf16_t* A; const bf16_t* Bt; int M, N, K; };

struct StaticOrder {
    int nM, nN, nwg, G, c, ntk, rounds, rem, sp;
    __host__ __device__ void init(int M, int N, int G_, int c_, int ntk_ = 0, bool SPLIT = false) { nM = M / BM; nN = N / BM; nwg = nM * nN; G = G_; c = c_; ntk = ntk_;
        rounds = 0; rem = 0; sp = (SPLIT && G == 256 && nM == 80 && nN == 4 && (ntk & 7) == 0) ? 4 : 1; }
    __host__ __device__ Unit get(int i) const {
        Unit u; u.pm = 0; u.pn = 0; u.kt0 = 0; u.nt = 0; u.split = 0;
        if (sp == 4) {
            if (i == 0) { const int id = (c & 7) * 32 + (c >> 3); u.pm = 16 + (id >> 2); u.pn = id & 3; u.nt = ntk; }
            else if (i == 1) { const int t = c >> 2, part = c & 3; u.pm = t >> 2; u.pn = t & 3; u.nt = ntk >> 2; u.kt0 = part * u.nt; u.split = 1 + part; }
            return u; }
        const long LL = (long)i * G + c;
        if (LL < nwg) {
            int wgid = (int)LL; { const int q = nwg / NXCD, r = nwg % NXCD, xcd = wgid % NXCD, off = wgid / NXCD; wgid = (xcd < r ? xcd * (q + 1) : r * (q + 1) + (xcd - r) * q) + off; }
            const int nig = WGM * nN, gid = wgid / nig, fm = gid * WGM, gsz = (nM - fm) < WGM ? (nM - fm) : WGM;
            u.pm = fm + ((wgid % nig) % gsz); u.pn = (wgid % nig) / gsz; u.nt = ntk; }
        return u; }
    __host__ __device__ bool next(int i, Unit& u) const { u = get(i); return u.nt > 0; }
    __device__ __forceinline__ void a_ready(const Unit&) const {}
    __device__ __forceinline__ void done(const Unit&) const {}
};

__device__ __forceinline__ unsigned cvt_pk_bf16(float lo, float hi) { unsigned r; asm volatile("v_cvt_pk_bf16_f32 %0, %1, %2" : "=v"(r) : "v"(lo), "v"(hi)); return r; }
template <class Epi, class Sched, bool ALIGN_EPI = false, bool SP2 = false>
__device__ __forceinline__ void gemm_phase(PG8_LAS unsigned char* lds, const Gemm g, const Sched& S, const Epi& E) {
    const int tid = opaque_tid(), wid = __builtin_amdgcn_readfirstlane(tid >> 6), lane = tid & 63, wr = wid >> 2, wc = wid & 3, fr = lane & 15, fq = lane >> 4;
    const int K = g.K;
    unsigned voffA[2], voffB[2];
#pragma unroll
    for (int i = 0; i < 2; ++i) { int R, C; stage_rc(tid * 16 + i * 8192, R, C); const int Rb = Epi::PERM ? ((R & ~31) + perm32(R & 31)) : R;
        voffA[i] = (unsigned)(R * K + C) * 2u; voffB[i] = (unsigned)(Rb * K + C) * 2u; }
    const size_t kstep = (size_t)(BK * 2);
    const size_t hstep = (size_t)HALF * K * 2;
    const size_t tstep = 2 * hstep;
    const unsigned ldsw = (unsigned)wid * 1024u;
    const int aoff = lds_byte(wr * 64 + fr, fq * 8), boff = lds_byte(wc * 32 + fr, fq * 8);
#define PG8_SA(b, h) (((b) * 2 + (h)) * HTB)
#define PG8_SB(b, h) ((4 + (b) * 2 + (h)) * HTB)
#define PG8_STAGE(bufoff, gbase, voff) do { _Pragma("unroll") for (int _i = 0; _i < 2; ++_i) \
        __builtin_amdgcn_global_load_lds((const unsigned*)((const char*)(gbase) + (voff)[_i]), (PG8_LAS unsigned*)(lds + (bufoff) + ldsw + _i * 8192), 16, 0, 0); } while (0)
#define PG8_LDA(dst, b, h) do { _Pragma("unroll") for (int m = 0; m < 4; ++m) _Pragma("unroll") for (int k = 0; k < 2; ++k) dst[m][k] = *(const PG8_LAS bf16x8*)(lds + PG8_SA(b, h) + aoff + m * 2048 + k * 1024); } while (0)
#define PG8_LDB(dst, b, h) do { _Pragma("unroll") for (int n = 0; n < 2; ++n) _Pragma("unroll") for (int k = 0; k < 2; ++k) dst[n][k] = *(const PG8_LAS bf16x8*)(lds + PG8_SB(b, h) + boff + n * 2048 + k * 1024); } while (0)
#define PG8_MMA(ai, bj, At, Bt) do { __builtin_amdgcn_s_setprio(1); _Pragma("unroll") for (int m = 0; m < 4; ++m) _Pragma("unroll") for (int n = 0; n < 2; ++n) _Pragma("unroll") for (int k = 0; k < 2; ++k) \
        acc[ai][bj][m][n] = __builtin_amdgcn_mfma_f32_16x16x32_bf16(Bt[n][k], At[m][k], acc[ai][bj][m][n], 0, 0, 0); __builtin_amdgcn_s_setprio(0); } while (0)
#define PG8_WAIT_V(n) asm volatile("s_waitcnt vmcnt(" #n ")" ::: "memory")
#define PG8_WAIT_L(n) asm volatile("s_waitcnt lgkmcnt(" #n ")" ::: "memory")
#define PG8_BAR __builtin_amdgcn_s_barrier()
#define PG8_SCHED __builtin_amdgcn_sched_barrier(0)
    Unit cur, nxt; int ui = 0;
    if (!S.next(0, cur)) return;
    f32x4 acc[2][2][4][2];
#pragma unroll
    for (int a = 0; a < 2; ++a)
#pragma unroll
        for (int b = 0; b < 2; ++b)
#pragma unroll
            for (int m = 0; m < 4; ++m)
#pragma unroll
                for (int n = 0; n < 2; ++n) acc[a][b][m][n] = (f32x4){0.f, 0.f, 0.f, 0.f};
    bf16x8 At[4][2], B0[2][2], B1[2][2];
    const char* cA = (const char*)g.A + (size_t)cur.pm * tstep + (size_t)cur.kt0 * kstep; const char* cB = (const char*)g.Bt + (size_t)cur.pn * tstep + (size_t)cur.kt0 * kstep;
    S.a_ready(cur);
    if constexpr (SP2) {
        PG8_STAGE(PG8_SB(0, 0), cB, voffB); PG8_STAGE(PG8_SB(0, 1), cB + hstep, voffB); PG8_STAGE(PG8_SA(0, 0), cA, voffA); PG8_STAGE(PG8_SA(0, 1), cA + hstep, voffA);
        if (wr == 1) PG8_BAR;
        PG8_WAIT_V(2); PG8_BAR;
        PG8_STAGE(PG8_SB(1, 0), cB + kstep, voffB); PG8_STAGE(PG8_SA(1, 0), cA + kstep, voffA); PG8_STAGE(PG8_SB(1, 1), cB + hstep + kstep, voffB);
        PG8_WAIT_V(6); PG8_BAR;
    } else {
        PG8_STAGE(PG8_SB(0, 0), cB, voffB); PG8_STAGE(PG8_SA(0, 0), cA, voffA); PG8_STAGE(PG8_SB(0, 1), cB + hstep, voffB); PG8_STAGE(PG8_SA(0, 1), cA + hstep, voffA);
        if (wr == 1) PG8_BAR;
        PG8_WAIT_V(4); PG8_BAR;
        PG8_STAGE(PG8_SB(1, 0), cB + kstep, voffB); PG8_STAGE(PG8_SA(1, 0), cA + kstep, voffA); PG8_STAGE(PG8_SB(1, 1), cB + hstep + kstep, voffB);
        PG8_WAIT_V(6); PG8_BAR;
    }
    for (;;) {
        const bool has_next = S.next(ui + 1, nxt);
        const char* nA = has_next ? (const char*)g.A + (size_t)nxt.pm * tstep + (size_t)nxt.kt0 * kstep : cA; const char* nB = has_next ? (const char*)g.Bt + (size_t)nxt.pn * tstep + (size_t)nxt.kt0 * kstep : cB;
        const int nt = cur.nt;
        for (int t = 0; t < nt; t += 2) {
            asm volatile("" : "+v"(voffA[0]), "+v"(voffA[1]), "+v"(voffB[0]), "+v"(voffB[1]));
            const bool last = (t == nt - 2);
            const char* a1 = cA + (size_t)(t + 1) * kstep;
            const char* a2 = last ? nA : cA + (size_t)(t + 2) * kstep; const char* b2 = last ? nB : cB + (size_t)(t + 2) * kstep;
            const char* a3 = a2 + kstep; const char* b3 = b2 + kstep;
            if (last && has_next) S.a_ready(nxt);
            if constexpr (SP2) {
            PG8_LDB(B0, 0, 0); PG8_LDB(B1, 0, 1); PG8_SCHED; PG8_LDA(At, 0, 0); PG8_STAGE(PG8_SA(1, 1), a1 + hstep, voffA);
            PG8_WAIT_V(8); PG8_WAIT_L(0); PG8_BAR; PG8_MMA(0, 0, At, B0); PG8_MMA(0, 1, At, B1); PG8_BAR; PG8_SCHED;
            PG8_LDA(At, 0, 1); PG8_STAGE(PG8_SB(0, 0), b2, voffB); PG8_STAGE(PG8_SB(0, 1), b2 + hstep, voffB); PG8_STAGE(PG8_SA(0, 0), a2, voffA);
            PG8_WAIT_V(8); PG8_WAIT_L(0); PG8_BAR; PG8_MMA(1, 0, At, B0); PG8_MMA(1, 1, At, B1); PG8_BAR; PG8_SCHED;
            PG8_LDB(B0, 1, 0); PG8_LDB(B1, 1, 1); PG8_SCHED; PG8_LDA(At, 1, 0); PG8_STAGE(PG8_SA(0, 1), a2 + hstep, voffA);
            PG8_WAIT_V(8); PG8_WAIT_L(0); PG8_BAR; PG8_MMA(0, 0, At, B0); PG8_MMA(0, 1, At, B1); PG8_BAR; PG8_SCHED;
            PG8_LDA(At, 1, 1); PG8_STAGE(PG8_SB(1, 0), b3, voffB); PG8_STAGE(PG8_SB(1, 1), b3 + hstep, voffB); PG8_STAGE(PG8_SA(1, 0), a3, voffA);
            PG8_WAIT_V(8); PG8_WAIT_L(0); PG8_BAR; PG8_MMA(1, 0, At, B0); PG8_MMA(1, 1, At, B1); PG8_BAR; PG8_SCHED;
            } else {
            PG8_LDB(B0, 0, 0); PG8_SCHED; PG8_LDA(At, 0, 0); PG8_STAGE(PG8_SA(1, 1), a1 + hstep, voffA);
            PG8_WAIT_L(8); PG8_BAR; PG8_WAIT_L(0); PG8_MMA(0, 0, At, B0); PG8_BAR; PG8_SCHED;
            PG8_LDB(B1, 0, 1); PG8_STAGE(PG8_SB(0, 0), b2, voffB);
            PG8_BAR; PG8_WAIT_L(0); PG8_MMA(0, 1, At, B1); PG8_BAR;
            PG8_LDA(At, 0, 1); PG8_STAGE(PG8_SA(0, 0), a2, voffA);
            PG8_BAR; PG8_WAIT_L(0); PG8_MMA(1, 0, At, B0); PG8_BAR; PG8_SCHED;
            PG8_STAGE(PG8_SB(0, 1), b2 + hstep, voffB);
            PG8_WAIT_V(6); PG8_BAR; PG8_MMA(1, 1, At, B1); PG8_BAR;
            PG8_LDB(B0, 1, 0); PG8_SCHED; PG8_LDA(At, 1, 0); PG8_STAGE(PG8_SA(0, 1), a2 + hstep, voffA);
            PG8_WAIT_L(8); PG8_BAR; PG8_WAIT_L(0); PG8_MMA(0, 0, At, B0); PG8_BAR; PG8_SCHED;
            PG8_LDB(B1, 1, 1); PG8_STAGE(PG8_SB(1, 0), b3, voffB);
            PG8_BAR; PG8_WAIT_L(0); PG8_MMA(0, 1, At, B1); PG8_BAR;
            PG8_LDA(At, 1, 1); PG8_STAGE(PG8_SA(1, 0), a3, voffA);
            PG8_BAR; PG8_WAIT_L(0); PG8_MMA(1, 0, At, B0); PG8_BAR; PG8_SCHED;
            PG8_STAGE(PG8_SB(1, 1), b3 + hstep, voffB);
            PG8_WAIT_V(6); PG8_BAR; PG8_MMA(1, 1, At, B1); PG8_BAR;
            }
        }
        if constexpr (ALIGN_EPI) { if (wr == 0) PG8_BAR; }
        if constexpr (!Epi::AFTER_DRAIN) { E(acc, cur, wr, wc, fr, fq); S.done(cur); }
        if (!has_next) break;
#pragma unroll
        for (int a = 0; a < 2; ++a)
#pragma unroll
            for (int b = 0; b < 2; ++b)
#pragma unroll
                for (int m = 0; m < 4; ++m)
#pragma unroll
                    for (int n = 0; n < 2; ++n) acc[a][b][m][n] = (f32x4){0.f, 0.f, 0.f, 0.f};
        cur = nxt; cA = nA; cB = nB; ++ui;
        if constexpr (ALIGN_EPI) { if (wr == 1) PG8_BAR; }
    }
    PG8_WAIT_V(0);
    if constexpr (!ALIGN_EPI) { if (wr == 0) PG8_BAR; }
    PG8_BAR;
    if constexpr (Epi::AFTER_DRAIN) { E.fused(acc, cur, wr, wc, fr, fq, lds, wid, lane); S.done(cur); }
#undef PG8_SA
#undef PG8_SB
#undef PG8_STAGE
#undef PG8_LDA
#undef PG8_LDB
#undef PG8_MMA
#undef PG8_WAIT_V
#undef PG8_WAIT_L
#undef PG8_BAR
#undef PG8_SCHED
}
}
namespace att {
using bf16x8 = __attribute__((ext_vector_type(8))) short;
using s16x4  = __attribute__((ext_vector_type(4))) short;
using f32x16 = __attribute__((ext_vector_type(16))) float;
using u32x4  = __attribute__((ext_vector_type(4))) unsigned;
using u32x2  = __attribute__((ext_vector_type(2))) unsigned;
constexpr int NW = 8, QBLK = 32, KVBLK = 64;
constexpr int SHM_V = 16384, SHM_K = 16384, SHM_ATTN = 3 * SHM_V + 3 * SHM_K + NW * 64 * 4;
#define KSWZ(row, colB) ((row) * 256 + ((colB) ^ (((row) & 7) << 4)))
#define SBAR() __builtin_amdgcn_sched_barrier(0)
__device__ __forceinline__ int crow(int r, int hi) { return (r & 3) + 8 * (r >> 2) + 4 * hi; }
__device__ __forceinline__ unsigned cvtpk(float lo, float hi) { unsigned r; asm volatile("v_cvt_pk_bf16_f32 %0, %1, %2" : "=v"(r) : "v"(lo), "v"(hi)); return r; }

#define MX3(a, b, c) __builtin_fmaxf(__builtin_fmaxf((a), (b)), (c))
template <bool FIRST>
__device__ __forceinline__ void partialSM(f32x16& p0, f32x16& p1, float& m_reg, f32x16& negm, float& alpha, const float thr) {
  float a = MX3(p0[0], p0[1], p1[0]), b = MX3(p0[2], p0[3], p1[1]); a = MX3(a, p1[2], p1[3]);
#pragma unroll
  for (int r = 4; r < 16; r += 4) { a = MX3(a, p0[r], p0[r + 1]); b = MX3(b, p0[r + 2], p0[r + 3]); a = MX3(a, p1[r], p1[r + 1]); b = MX3(b, p1[r + 2], p1[r + 3]); }
  float pmax = fmaxf(a, b);
  { auto rr = __builtin_amdgcn_permlane32_swap(__float_as_uint(pmax), __float_as_uint(pmax), false, false);
    pmax = fmaxf(__uint_as_float(rr[0]), __uint_as_float(rr[1])); }
  alpha = 1.f;
  if (FIRST || !__builtin_expect(__all(pmax <= thr), 1)) {
    const float dl = FIRST ? pmax : fmaxf(pmax, 0.f);
    alpha = __builtin_amdgcn_exp2f(-dl); m_reg += dl;
#pragma unroll
    for (int r = 0; r < 16; ++r) { p0[r] -= dl; p1[r] -= dl; }
#pragma unroll
    for (int r = 0; r < 16; ++r) negm[r] = -m_reg;
  }
#pragma unroll
  for (int r = 0; r < 16; ++r) p0[r] = __builtin_amdgcn_exp2f(p0[r]);
}
__device__ __forceinline__ void finishSM(f32x16& p0, f32x16& p1, bf16x8& pa0, bf16x8& pa1, bf16x8& pa2, bf16x8& pa3) {
#pragma unroll
  for (int r = 0; r < 16; ++r) p1[r] = __builtin_amdgcn_exp2f(p1[r]);
#define PK4(P, BASE, OUT) do { unsigned a0 = cvtpk(P[BASE + 0], P[BASE + 1]), a1 = cvtpk(P[BASE + 2], P[BASE + 3]);   \
    unsigned b0 = cvtpk(P[BASE + 4], P[BASE + 5]), b1 = cvtpk(P[BASE + 6], P[BASE + 7]);                              \
    auto r0 = __builtin_amdgcn_permlane32_swap(a0, b0, false, false); auto r1 = __builtin_amdgcn_permlane32_swap(a1, b1, false, false); \
    u32x4 w = {r0[0], r1[0], r0[1], r1[1]}; OUT = *reinterpret_cast<bf16x8*>(&w); } while (0)
  PK4(p0, 0, pa0); PK4(p0, 8, pa1); PK4(p1, 0, pa2); PK4(p1, 8, pa3);
#undef PK4
}
template <int DQK>
__device__ __forceinline__ void qkt(f32x16& p0, f32x16& p1, const char* Ks, const bf16x8* qr, const f32x16& negm, int r32, int hi) {
  p0 = negm; p1 = negm;
  __builtin_amdgcn_iglp_opt(3);
  __builtin_amdgcn_s_setprio(1);
#pragma unroll
  for (int d0 = 0; d0 < DQK / 16; ++d0) { int cb = (d0 * 16 + hi * 8) * 2;
    bf16x8 b0 = *reinterpret_cast<const bf16x8*>(Ks + KSWZ(r32, cb));
    bf16x8 b1 = *reinterpret_cast<const bf16x8*>(Ks + KSWZ(32 + r32, cb));
    p0 = __builtin_amdgcn_mfma_f32_32x32x16_bf16(b0, qr[d0], p0, 0, 0, 0);
    p1 = __builtin_amdgcn_mfma_f32_32x32x16_bf16(b1, qr[d0], p1, 0, 0, 0); }
  __builtin_amdgcn_s_setprio(0);
}
__device__ __forceinline__ int v_st(int k, int c) { const int kk = (k & ~0xC) | ((k & 4) << 1) | ((k & 8) >> 1); return ((kk >> 3) * 4 + (c >> 5)) * 512 + ((kk & 7) * 32 + (c & 31)) * 2; }
__device__ __forceinline__ int v_rd_base(int lane) { return ((lane & 3) << 3) | (((lane >> 2) & 3) << 6) | (((lane >> 4) & 1) << 5) | (((lane >> 5) & 1) << 8); }
constexpr int v_rd_off(int d0, int ks, int half) { return d0 * 512 + ks * 4096 + half * 2048; }
template <int OFF> __device__ __forceinline__ s16x4 tr_read(int vb) {
  s16x4 r; asm volatile("ds_read_b64_tr_b16 %0, %1 offset:%2" : "=&v"(r) : "v"(vb), "i"(OFF) : "memory"); return r;
}
struct VFrag { s16x4 l[4], h[4]; };
template <int D0> __device__ __forceinline__ void v_reads(VFrag& f, int vb) {
  f.l[0] = tr_read<v_rd_off(D0, 0, 0)>(vb); f.h[0] = tr_read<v_rd_off(D0, 0, 1)>(vb); f.l[1] = tr_read<v_rd_off(D0, 1, 0)>(vb); f.h[1] = tr_read<v_rd_off(D0, 1, 1)>(vb);
  f.l[2] = tr_read<v_rd_off(D0, 2, 0)>(vb); f.h[2] = tr_read<v_rd_off(D0, 2, 1)>(vb); f.l[3] = tr_read<v_rd_off(D0, 3, 0)>(vb); f.h[3] = tr_read<v_rd_off(D0, 3, 1)>(vb);
}
__device__ __forceinline__ void pv_mma(f32x16* o, f32x16& lacc, VFrag& f, int vb, bf16x8 pa0, bf16x8 pa1, bf16x8 pa2, bf16x8 pa3) {
  const bf16x8 ones = {0x3F80, 0x3F80, 0x3F80, 0x3F80, 0x3F80, 0x3F80, 0x3F80, 0x3F80};
  asm volatile("s_waitcnt lgkmcnt(0)" ::: "memory"); SBAR();
#define PK(L, H) (bf16x8){L[0], L[1], L[2], L[3], H[0], H[1], H[2], H[3]}
  o[0] = __builtin_amdgcn_mfma_f32_32x32x16_bf16(pa0, PK(f.l[0], f.h[0]), o[0], 0, 0, 0);
  o[0] = __builtin_amdgcn_mfma_f32_32x32x16_bf16(pa1, PK(f.l[1], f.h[1]), o[0], 0, 0, 0);
  o[0] = __builtin_amdgcn_mfma_f32_32x32x16_bf16(pa2, PK(f.l[2], f.h[2]), o[0], 0, 0, 0);
  o[0] = __builtin_amdgcn_mfma_f32_32x32x16_bf16(pa3, PK(f.l[3], f.h[3]), o[0], 0, 0, 0);
  SBAR(); v_reads<1>(f, vb); SBAR();
  lacc = __builtin_amdgcn_mfma_f32_32x32x16_bf16(pa0, ones, lacc, 0, 0, 0);
  lacc = __builtin_amdgcn_mfma_f32_32x32x16_bf16(pa1, ones, lacc, 0, 0, 0);
  lacc = __builtin_amdgcn_mfma_f32_32x32x16_bf16(pa2, ones, lacc, 0, 0, 0);
  lacc = __builtin_amdgcn_mfma_f32_32x32x16_bf16(pa3, ones, lacc, 0, 0, 0);
  asm volatile("s_waitcnt lgkmcnt(0)" ::: "memory"); SBAR();
  o[1] = __builtin_amdgcn_mfma_f32_32x32x16_bf16(pa0, PK(f.l[0], f.h[0]), o[1], 0, 0, 0);
  o[1] = __builtin_amdgcn_mfma_f32_32x32x16_bf16(pa1, PK(f.l[1], f.h[1]), o[1], 0, 0, 0);
  o[1] = __builtin_amdgcn_mfma_f32_32x32x16_bf16(pa2, PK(f.l[2], f.h[2]), o[1], 0, 0, 0);
  o[1] = __builtin_amdgcn_mfma_f32_32x32x16_bf16(pa3, PK(f.l[3], f.h[3]), o[1], 0, 0, 0);
#undef PK
}
struct Unit {
  const unsigned short* Q; const unsigned short* K; const unsigned short* KR; const unsigned short* V; unsigned short* O;
  int ldq, ldk, NT, kstart, q0;
  float C, thr_raw, sinkl2;
};
__device__ __forceinline__ void wmask(f32x16& p0, f32x16& p1, int tilepos, int qpos, int hi) {
#pragma unroll
  for (int r = 0; r < 16; ++r) { const int k0 = tilepos + crow(r, hi); int d0 = qpos - k0; d0 = d0 < 0 ? -d0 : d0; int d1 = qpos - (k0 + 32); d1 = d1 < 0 ? -d1 : d1;
    if (d0 > 128) p0[r] = -1e30f; if (d1 > 128) p1[r] = -1e30f; }
}
template <int DQK, bool WINDOW>
__device__ __forceinline__ void attn_unit(const Unit& U, char* lds) {
  const int tid = opaque_tid(), wid = __builtin_amdgcn_readfirstlane(tid >> 6), lane = tid & 63, r32 = lane & 31, hi = lane >> 5;
  char* V_lds = lds; char* K_lds = lds + 3 * SHM_V;
  float* ws = (float*)(lds + 3 * SHM_V + 3 * SHM_K) + wid * 64; float* li_l = ws; float* al_l = ws + 32;
  const float thr = 11.5415603f;
  float m_reg = 0.f; f32x16 o[2] = {}; f32x16 lacc = {}; f32x16 negm = {}; bf16x8 qr[DQK / 16];
  const unsigned short* Qw = U.Q + (long)(wid * QBLK + r32) * U.ldq + hi * 8;
#pragma unroll
  for (int d0 = 0; d0 < DQK / 16; ++d0) qr[d0] = *reinterpret_cast<const bf16x8*>(Qw + d0 * 16);
  const int sr = tid >> 3, sc = (tid & 7) * 8, vst0 = v_st(sr, sc), kst0 = KSWZ(sr, sc * 2);
  const int srr = (tid >> 2) & 63, scr = (tid & 3) * 8, kst1 = KSWZ(srr, (64 + scr) * 2);
  const bool do_r = (DQK == 96) && (tid < 256);
  const int vb0 = (int)(uintptr_t)V_lds + v_rd_base(lane);
  const int ldk = U.ldk, kstart = U.kstart;
  const int qpos = U.q0 + wid * QBLK + r32; const int qlo = U.q0 + wid * QBLK;
  struct { bf16x8 vs, ks, rs; } sr_[3];
#define KROW(j) ((long)(64 * (j) + ((j) >= 4 ? kstart : 0)))
#define SLOAD(i, j) do { const long kr_ = KROW(j); sr_[i].vs = *reinterpret_cast<const bf16x8*>(U.V + (kr_ + sr) * ldk + sc); \
    sr_[i].ks = *reinterpret_cast<const bf16x8*>(U.K + (kr_ + sr) * ldk + sc); \
    if (DQK == 96) { if (do_r) sr_[i].rs = *reinterpret_cast<const bf16x8*>(U.KR + (kr_ + srr) * 32 + scr); } } while (0)
#define SWRITE(soff, i) do { *(bf16x8*)(V_lds + (soff) + vst0) = sr_[i].vs; *(bf16x8*)(K_lds + (soff) + kst0) = sr_[i].ks; \
    if (DQK == 96) { if (do_r) *(bf16x8*)(K_lds + (soff) + kst1) = sr_[i].rs; } } while (0)
#define RESC(a) do { if (__any((a) < 1.f)) { if (hi == 0) al_l[r32] = (a); asm volatile("s_waitcnt lgkmcnt(0)" ::: "memory"); \
    _Pragma("unroll") for (int r = 0; r < 16; ++r) { const float f_ = al_l[crow(r, hi)]; o[0][r] *= f_; o[1][r] *= f_; lacc[r] *= f_; } } } while (0)
#define WMASK(P0, P1, j) do { if (WINDOW) { if ((j) >= 4) wmask(P0, P1, kstart + 64 * ((j) - 4), qpos, hi); } } while (0)
#define QKM(P0, P1, KP, j) do { \
    if (WINDOW && (j) >= 4) { const int tp_ = kstart + 64 * ((j) - 4); \
      if (tp_ + 63 < qlo - 128 || tp_ > qlo + 31 + 128) { _Pragma("unroll") for (int r_ = 0; r_ < 16; ++r_) { P0[r_] = -1e30f; P1[r_] = -1e30f; } } \
      else { qkt<DQK>(P0, P1, KP, qr, negm, r32, hi); if (!(tp_ >= qlo + 31 - 128 && tp_ + 63 <= qlo + 128)) wmask(P0, P1, tp_, qpos, hi); } } \
    else qkt<DQK>(P0, P1, KP, qr, negm, r32, hi); } while (0)
#define ROT() do { const int t_ = s_prev; s_prev = s_cur; s_cur = s_next; s_next = t_; } while (0)
  static_assert(SHM_V == SHM_K, "one slot offset serves both rings");
  f32x16 pA0, pA1, pB0, pB1; float alA, alB; bf16x8 pa0, pa1, pa2, pa3; const int NT = U.NT; VFrag vf;
  int s_prev = 2 * SHM_V, s_cur = 0, s_next = SHM_V;
  SLOAD(1, 0); SLOAD(2, 1); if (2 < NT) SLOAD(0, 2);
  SWRITE(0, 1); SWRITE(SHM_V, 2);
  __syncthreads();
  qkt<DQK>(pA0, pA1, K_lds, qr, negm, r32, hi); partialSM<true>(pA0, pA1, m_reg, negm, alA, thr);
  ROT();
  for (int j = 1; j + 1 < NT; j += 2) {
    SWRITE(s_next, 0); if (j + 2 < NT) SLOAD(0, j + 2);
    SBAR(); QKM(pB0, pB1, K_lds + s_cur, j); v_reads<0>(vf, vb0 + s_prev);
    finishSM(pA0, pA1, pa0, pa1, pa2, pa3);
    pv_mma(o, lacc, vf, vb0 + s_prev, pa0, pa1, pa2, pa3); partialSM<false>(pB0, pB1, m_reg, negm, alB, thr);
    __syncthreads(); RESC(alB); ROT();
    if (j + 2 < NT) SWRITE(s_next, 0); if (j + 3 < NT) SLOAD(0, j + 3);
    SBAR(); QKM(pA0, pA1, K_lds + s_cur, j + 1); v_reads<0>(vf, vb0 + s_prev);
    finishSM(pB0, pB1, pa0, pa1, pa2, pa3);
    pv_mma(o, lacc, vf, vb0 + s_prev, pa0, pa1, pa2, pa3); partialSM<false>(pA0, pA1, m_reg, negm, alA, thr);
    __syncthreads(); RESC(alA); ROT();
  }
  SBAR(); QKM(pB0, pB1, K_lds + s_cur, NT - 1); v_reads<0>(vf, vb0 + s_prev);
  finishSM(pA0, pA1, pa0, pa1, pa2, pa3);
  pv_mma(o, lacc, vf, vb0 + s_prev, pa0, pa1, pa2, pa3); partialSM<false>(pB0, pB1, m_reg, negm, alB, thr);
  RESC(alB);
  SBAR(); v_reads<0>(vf, vb0 + s_cur); SBAR();
  finishSM(pB0, pB1, pa0, pa1, pa2, pa3);
  pv_mma(o, lacc, vf, vb0 + s_cur, pa0, pa1, pa2, pa3);
  if (hi == 0) li_l[r32] = __builtin_amdgcn_exp2f(fmaxf(U.sinkl2 - m_reg, -126.f));
  asm volatile("s_waitcnt lgkmcnt(0)" ::: "memory");
  float rli[16];
#pragma unroll
  for (int r = 0; r < 16; ++r) rli[r] = __builtin_amdgcn_rcpf(lacc[r] + li_l[crow(r, hi)]);
  unsigned short* Ow = U.O + (long)(wid * QBLK) * 1024;
#pragma unroll
  for (int r = 0; r < 16; ++r) { const int orow = crow(r, hi);
#pragma unroll
    for (int d0 = 0; d0 < 2; ++d0) { const float lo = o[d0][r] * rli[r]; const unsigned pk = cvtpk(lo, lo); Ow[(long)orow * 1024 + d0 * 32 + r32] = (unsigned short)(pk & 0xffffu); } }
  __syncthreads();
#undef KROW
#undef SLOAD
#undef SWRITE
#undef RESC
#undef WMASK
#undef QKM
#undef ROT
}
#undef SBAR
}
constexpr int DM = 1024, NP_ROWS = 4096, NS_ROWS = 16384, M_ROWS = 20480, EXT_ROWS = 21504, EXT_B = 4352, DFF = 4096;
constexpr float EPS_ = 1e-6f;
constexpr float LOG2_THETA = 13.287712379549449f;
constexpr float INV_2PI = 0.15915494309189535f;
typedef unsigned short bfu;
typedef float f32x4 __attribute__((ext_vector_type(4)));
typedef unsigned u32x4 __attribute__((ext_vector_type(4)));
typedef unsigned u32x2 __attribute__((ext_vector_type(2)));
__device__ __forceinline__ unsigned pkbf(float lo, float hi) { return pg8::cvt_pk_bf16(lo, hi); }
__device__ __forceinline__ void rope_cs(int pos, int i, float inv_den, float& c, float& s) {
    const float f = __builtin_amdgcn_exp2f(-(float)i * (LOG2_THETA * inv_den));
    const float rev = (float)pos * f * INV_2PI;
    c = __builtin_amdgcn_cosf(rev); s = __builtin_amdgcn_sinf(rev);
}
__device__ __forceinline__ int cond_of_row(int row) { return row < NP_ROWS ? 4 : ((row - NP_ROWS) >> 12); }
__device__ __forceinline__ int ext_of_row(int row) { return row < NP_ROWS ? row : (NP_ROWS + ((row - NP_ROWS) >> 12) * EXT_B + 256 + ((row - NP_ROWS) & 4095)); }

#define EPI_FENCE() asm volatile("" ::: "memory")
template <bool NORMC> struct EpiQKV {
    static constexpr bool PERM = false, AFTER_DRAIN = false;
    bfu* Q; bfu* Kb; bfu* Vb; float* stK; float* stV; const float* gq; const float* gk; int nstate;
    __device__ __forceinline__ void operator()(const f32x4 (&acc)[2][2][4][2], const pg8::Unit& u, int wr, int wc, int fr, int fq) const {
        asm volatile("" : "+v"(fr), "+v"(fq));
        const int pn = u.pn; const bool isQ = pn < 4, isK = pn == 4; const bool sample = u.pm >= 16;
        const bool dorope = sample && pn < 5;
        float frq[4];
#pragma unroll
        for (int j = 0; j < 4; ++j) frq[j] = __builtin_amdgcn_exp2f(-(float)(4 * fq + j) * (LOG2_THETA / 16.0f)) * INV_2PI;
        const unsigned cq = 64 * wc + 4 * fq;
#pragma unroll
        for (int ai = 0; ai < 2; ++ai)
#pragma unroll
            for (int m = 0; m < 4; ++m) {
                unsigned row = u.pm * 256 + ai * 128 + wr * 64 + m * 16 + fr; asm volatile("" : "+v"(row));
                f32x4 v[2][2];
#pragma unroll
                for (int bj = 0; bj < 2; ++bj)
#pragma unroll
                    for (int n = 0; n < 2; ++n) v[bj][n] = acc[ai][bj][m][n];
                if (NORMC && pn < 5) {
                    float ss = 0.f;
#pragma unroll
                    for (int bj = 0; bj < 2; ++bj)
#pragma unroll
                        for (int n = 0; n < 2; ++n) ss += (v[bj][n][0] * v[bj][n][0] + v[bj][n][1] * v[bj][n][1]) + (v[bj][n][2] * v[bj][n][2] + v[bj][n][3] * v[bj][n][3]);
                    ss += __shfl_xor(ss, 16); ss += __shfl_xor(ss, 32);
                    const float rstd = 1.0f / sqrtf(ss * (1.0f / 64.0f) + EPS_);
                    const float* g = (isQ ? gq : gk) + 4 * fq;
#pragma unroll
                    for (int bj = 0; bj < 2; ++bj)
#pragma unroll
                        for (int n = 0; n < 2; ++n) { const f32x4 gv = *(const f32x4*)(g + 32 * bj + 16 * n); v[bj][n] = v[bj][n] * rstd * gv; }
                }
                const unsigned t = (row - NP_ROWS) & 4095u;
                if (dorope) {
#pragma unroll
                    for (int bj = 0; bj < 2; ++bj) { const float pos = (float)(bj == 0 ? (t >> 6) : (t & 63u));
#pragma unroll
                        for (int j = 0; j < 4; ++j) { const float rev = pos * frq[j]; const float c = __builtin_amdgcn_cosf(rev), s = __builtin_amdgcn_sinf(rev); const float x1 = v[bj][0][j], x2 = v[bj][1][j];
                            v[bj][0][j] = x1 * c - x2 * s; v[bj][1][j] = x1 * s + x2 * c; } }
                }
                if (isQ) { bfu* p = Q + (row * 1024u + 256u * pn + cq);
#pragma unroll
                    for (int bj = 0; bj < 2; ++bj)
#pragma unroll
                        for (int n = 0; n < 2; ++n) { const f32x4 x = v[bj][n] * (0.125f * 1.4426950408889634f);     u32x2 w; w.x = pkbf(x[0], x[1]); w.y = pkbf(x[2], x[3]); *(u32x2*)(p + 32 * bj + 16 * n) = w; }
                } else {
                    const unsigned e = sample ? (NP_ROWS + ((row - NP_ROWS) >> 12) * EXT_B + 256u + t) : row;
                    bfu* p = (isK ? Kb : Vb) + (e * 256u + cq);
#pragma unroll
                    for (int bj = 0; bj < 2; ++bj)
#pragma unroll
                        for (int n = 0; n < 2; ++n) { const f32x4 x = v[bj][n]; u32x2 w; w.x = pkbf(x[0], x[1]); w.y = pkbf(x[2], x[3]); *(u32x2*)(p + 32 * bj + 16 * n) = w; }
                    if (!sample) { float* st = (isK ? stK : stV) + ((((row >> 8) * nstate) * 256u + (row & 255u)) * 256u + cq);
#pragma unroll
                        for (int bj = 0; bj < 2; ++bj)
#pragma unroll
                            for (int n = 0; n < 2; ++n) *(f32x4*)(st + 32 * bj + 16 * n) = v[bj][n]; }
                }
                EPI_FENCE();
            }
    }
};
struct EpiResid {
    static constexpr bool PERM = true, AFTER_DRAIN = false;
    float* x; const float* gate; bfu* P;
    __device__ __forceinline__ void operator()(const f32x4 (&acc)[2][2][4][2], const pg8::Unit& u, int wr, int wc, int fr, int fq) const {
        asm volatile("" : "+v"(fr), "+v"(fq));
        const int cond = cond_of_row(u.pm * 256); const unsigned c0 = u.pn * 256 + wc * 32 + 8 * fq; const float* g = gate + cond * 6144 + c0;
#pragma unroll
        for (int ai = 0; ai < 2; ++ai)
#pragma unroll
            for (int m = 0; m < 4; ++m) { const unsigned row = u.pm * 256 + ai * 128 + wr * 64 + m * 16 + fr; const unsigned off = row * 1024u + c0;
#pragma unroll
                for (int bj = 0; bj < 2; ++bj) { const f32x4 g0 = *(const f32x4*)(g + bj * 128), g1 = *(const f32x4*)(g + bj * 128 + 4);
                    const f32x4 y0 = g0 * acc[ai][bj][m][0], y1 = g1 * acc[ai][bj][m][1]; const unsigned o2 = off + bj * 128;
                    if (u.split) { u32x4 w; w.x = pkbf(y0[0], y0[1]); w.y = pkbf(y0[2], y0[3]); w.z = pkbf(y1[0], y1[1]); w.w = pkbf(y1[2], y1[3]); *(u32x4*)(P + ((size_t)(u.split - 1) * 4096 * 1024 + o2)) = w; }
                    else { const f32x4 b0 = *(const f32x4*)(x + o2), b1 = *(const f32x4*)(x + o2 + 4); *(f32x4*)(x + o2) = b0 + y0; *(f32x4*)(x + o2 + 4) = b1 + y1; } }
                EPI_FENCE(); }
    }
};
struct EpiSqRelu {
    static constexpr bool PERM = true, AFTER_DRAIN = false;
    bfu* O; int ldc;
    __device__ __forceinline__ void operator()(const f32x4 (&acc)[2][2][4][2], const pg8::Unit& u, int wr, int wc, int fr, int fq) const {
        asm volatile("" : "+v"(fr), "+v"(fq));
#pragma unroll
        for (int ai = 0; ai < 2; ++ai)
#pragma unroll
            for (int m = 0; m < 4; ++m) { const unsigned row = u.pm * 256 + ai * 128 + wr * 64 + m * 16 + fr; bfu* p = O + ((size_t)row * ldc + u.pn * 256 + wc * 32 + 8 * fq);
#pragma unroll
                for (int bj = 0; bj < 2; ++bj) { f32x4 v0 = acc[ai][bj][m][0], v1 = acc[ai][bj][m][1];
#pragma unroll
                    for (int j = 0; j < 4; ++j) { const float a = fmaxf(v0[j], 0.f), b = fmaxf(v1[j], 0.f); v0[j] = a * a; v1[j] = b * b; }
                    u32x4 w; w.x = pkbf(v0[0], v0[1]); w.y = pkbf(v0[2], v0[3]); w.z = pkbf(v1[0], v1[1]); w.w = pkbf(v1[2], v1[3]);
                    *(u32x4*)(p + bj * 128) = w; }
                EPI_FENCE(); }
    }
};
struct EpiUKV {
    static constexpr bool PERM = true, AFTER_DRAIN = false;
    bfu* Kn; bfu* Vb;
    __device__ __forceinline__ void operator()(const f32x4 (&acc)[2][2][4][2], const pg8::Unit& u, int wr, int wc, int fr, int fq) const {
        asm volatile("" : "+v"(fr), "+v"(fq));
        bfu* base = (wc < 2 ? Kn : Vb) + (2 * u.pn * 64 + 32 * (wc & 1) + 8 * fq);
#pragma unroll
        for (int ai = 0; ai < 2; ++ai)
#pragma unroll
            for (int m = 0; m < 4; ++m) { const unsigned row = u.pm * 256 + ai * 128 + wr * 64 + m * 16 + fr; bfu* p = base + row * 1024u;
#pragma unroll
                for (int bj = 0; bj < 2; ++bj) { const f32x4 v0 = acc[ai][bj][m][0], v1 = acc[ai][bj][m][1];
                    u32x4 w; w.x = pkbf(v0[0], v0[1]); w.y = pkbf(v0[2], v0[3]); w.z = pkbf(v1[0], v1[1]); w.w = pkbf(v1[2], v1[3]);
                    *(u32x4*)(p + bj * 64) = w; }
                EPI_FENCE(); }
    }
};
struct EpiF32 {
    static constexpr bool PERM = false, AFTER_DRAIN = false;
    float* T; int ldc;
    __device__ __forceinline__ void operator()(const f32x4 (&acc)[2][2][4][2], const pg8::Unit& u, int wr, int wc, int fr, int fq) const {
        asm volatile("" : "+v"(fr), "+v"(fq));
#pragma unroll
        for (int ai = 0; ai < 2; ++ai)
#pragma unroll
            for (int m = 0; m < 4; ++m) { const unsigned row = u.pm * 256 + ai * 128 + wr * 64 + m * 16 + fr; float* p = T + ((size_t)row * ldc + u.pn * 256 + wc * 32 + 4 * fq);
#pragma unroll
                for (int bj = 0; bj < 2; ++bj)
#pragma unroll
                    for (int n = 0; n < 2; ++n) *(f32x4*)(p + bj * 128 + n * 16) = acc[ai][bj][m][n];
                EPI_FENCE(); }
    }
};
struct EpiUQ {
    static constexpr bool PERM = false, AFTER_DRAIN = false;
    bfu* Q;
    __device__ __forceinline__ void operator()(const f32x4 (&acc)[2][2][4][2], const pg8::Unit& u, int wr, int wc, int fr, int fq) const {
        asm volatile("" : "+v"(fr), "+v"(fq));
        const bool sample = u.pm >= 16;
        float frq[4];
#pragma unroll
        for (int j = 0; j < 4; ++j) frq[j] = __builtin_amdgcn_exp2f(-(float)(4 * (fq & 1) + j) * (LOG2_THETA / 8.0f)) * INV_2PI;
        const bool lowhalf = fq < 2;
#pragma unroll
        for (int ai = 0; ai < 2; ++ai)
#pragma unroll
            for (int m = 0; m < 4; ++m) { unsigned row = u.pm * 256 + ai * 128 + wr * 64 + m * 16 + fr; asm volatile("" : "+v"(row)); const unsigned t = (row - NP_ROWS) & 4095u;
                bfu* p = Q + (row * 1536u + u.pn * 256 + wc * 32 + 4 * fq);
#pragma unroll
                for (int bj = 0; bj < 2; ++bj) {
                    const int g32 = (u.pn * 256 + bj * 128 + wc * 32) >> 5; const bool ropeg = (g32 % 3) == 2;
#pragma unroll
                    for (int n = 0; n < 2; ++n) { f32x4 v = acc[ai][bj][m][n];
                        if (sample && ropeg) { const float pos = (float)(n == 0 ? (t >> 6) : (t & 63u));
#pragma unroll
                            for (int j = 0; j < 4; ++j) { const float other = __shfl_xor(v[j], 32); const float rev = pos * frq[j]; const float c = __builtin_amdgcn_cosf(rev), s = __builtin_amdgcn_sinf(rev);
                                v[j] = lowhalf ? (v[j] * c - other * s) : (other * s + v[j] * c); } }
                        v = v * (0.10206207261596577f * 1.4426950408889634f);
                        u32x2 w; w.x = pkbf(v[0], v[1]); w.y = pkbf(v[2], v[3]);
                        *(u32x2*)(p + bj * 128 + n * 16) = w; } }
                EPI_FENCE(); }
    }
};
#define XB_TMO      128
#define XB_XCNT(j)  (256  + 64 * (j))
#define XB_XSUB(j)  (1280 + 64 * (j))
#define XB_XGEN(j)  (2304 + 64 * (j))
#define XB_TOP      3328
#define XB_TOPGEN   3392
#define XCD_BAR_WORDS 3456
#define XB_SPIN_CAP (1u << 18)

__device__ __forceinline__ unsigned xb_ld(unsigned* p)              { return __hip_atomic_load(p, __ATOMIC_RELAXED, __HIP_MEMORY_SCOPE_AGENT); }
__device__ __forceinline__ unsigned xb_add(unsigned* p, unsigned v) { return __hip_atomic_fetch_add(p, v, __ATOMIC_RELAXED, __HIP_MEMORY_SCOPE_AGENT); }
__device__ __forceinline__ unsigned xb_xcc_id() { return (unsigned)__builtin_amdgcn_s_getreg((3 << 11) | 20) & 0xFu; }
#define XB_SPIN(cond, bar) do { unsigned _sp = 0; while (cond) { __builtin_amdgcn_s_sleep(1); \
    if ((++_sp & 255u) == 0u) { if (xb_ld(&(bar)[XB_TMO])) break; if (_sp > XB_SPIN_CAP) { atomicAdd(&(bar)[XB_TMO], 1u); break; } } } } while (0)

struct XcdBarrier {
    unsigned* bar; unsigned x;
    volatile LAS unsigned* st;
};

__device__ __forceinline__ XcdBarrier xcd_barrier_post(unsigned* bar, volatile LAS unsigned* st) {
    XcdBarrier b; b.bar = bar; b.x = xb_xcc_id(); b.st = st;
    if (threadIdx.x == 0) (void)xb_add(&bar[XB_XCNT(b.x)], 1u);
    return b;
}
__device__ __forceinline__ void xcd_barrier_complete(unsigned* bar, unsigned x, unsigned& nloc, unsigned& nx) {
    const unsigned G = gridDim.x * gridDim.y * gridDim.z;
    unsigned sum, cnt, mine, sp = 0u;
    for (;;) {
        sum = 0u; cnt = 0u; mine = 0u;
#pragma unroll
        for (unsigned j = 0; j < 16; ++j) { const unsigned c = xb_ld(&bar[XB_XCNT(j)]); sum += c; cnt += (c > 0u) ? 1u : 0u; mine = (j == x) ? c : mine; }
        if (sum == G) break;
        __builtin_amdgcn_s_sleep(1);
        if ((++sp & 255u) == 0u) { if (xb_ld(&bar[XB_TMO])) break; if (sp > XB_SPIN_CAP) { atomicAdd(&bar[XB_TMO], 1u); break; } }
    }
    nloc = mine > 0u ? mine : 1u; nx = cnt > 0u ? cnt : 1u;
}

__device__ __forceinline__ void xcd_barrier(const XcdBarrier& b) {
    asm volatile("s_waitcnt vmcnt(0)" ::: "memory");
    __syncthreads();
    if (threadIdx.x == 0) {
        unsigned* bar = b.bar;
        __builtin_amdgcn_s_waitcnt(0);
        unsigned nloc = b.st[0], nx = b.st[1];
        if (nloc == 0u) { xcd_barrier_complete(bar, b.x, nloc, nx); b.st[0] = nloc; b.st[1] = nx; }
        const unsigned old = xb_add(&bar[XB_XSUB(b.x)], 1u);
        const unsigned gen = old / nloc;
        if (old + 1u == (gen + 1u) * nloc) {
            __builtin_amdgcn_fence(__ATOMIC_RELEASE, "agent");
            asm volatile("s_waitcnt vmcnt(0)" ::: "memory");
            const unsigned og = xb_add(&bar[XB_TOP], 1u);
            const unsigned tg = og / nx;
            if (og + 1u == (tg + 1u) * nx) xb_add(&bar[XB_TOPGEN], 1u);
            else XB_SPIN(xb_ld(&bar[XB_TOPGEN]) == tg, bar);
            __builtin_amdgcn_fence(__ATOMIC_ACQUIRE, "agent");
            xb_add(&bar[XB_XGEN(b.x)], 1u);
            asm volatile("s_waitcnt vmcnt(0)" ::: "memory");
        } else {
            XB_SPIN(xb_ld(&bar[XB_XGEN(b.x)]) == gen, bar);
            __builtin_amdgcn_fence(__ATOMIC_ACQUIRE, "agent");
            asm volatile("s_waitcnt vmcnt(0)" ::: "memory");
        }
    }
    __syncthreads();
}

constexpr size_t MiB = 1u << 20;
constexpr size_t WT_MLP_IN = 0;
constexpr size_t WT_MLP_OUT = 4 * (size_t)DM * DFF;
constexpr size_t WT_A_QKV = 8 * (size_t)DM * DFF;
constexpr size_t WT_A_O = WT_A_QKV + 2 * 1536 * 1024;
constexpr size_t WT_C_QKV = WT_A_O + 2 * 1024 * 1024;
constexpr size_t WT_C_O = WT_C_QKV + 1536 * 1024;
constexpr size_t WT_B_DQKV = WT_C_O + 1024 * 1024;
constexpr size_t WT_B_UQ = WT_B_DQKV + 768 * 1024;
constexpr size_t WT_B_UKV = WT_B_UQ + 1536 * 384;
constexpr size_t WT_B_O = WT_B_UKV + 2048 * 256;
constexpr size_t WT_END = WT_B_O + 1024 * 1024;
static_assert(WT_END * 2 <= 88 * MiB, "WT region");
constexpr size_t WS_WT = 0, WS_MODS = 88 * MiB, WS_KR = 89 * MiB, WS_CKVN = 91 * MiB, WS_DQN = 102 * MiB, WS_H = 117 * MiB, WS_R1 = 157 * MiB;
constexpr size_t WS_Q = WS_R1, WS_K = WS_R1 + 60 * MiB, WS_V = WS_K + 42 * MiB, WS_T = WS_R1, WS_HID = WS_R1, WS_CTL = WS_R1 + 160 * MiB, WS_P = WS_CTL + 1 * MiB, WS_END = WS_P + 64 * MiB;

#define GAS1 __attribute__((address_space(1)))
struct Args { const GAS1 float* in[30]; GAS1 float* out; GAS1 unsigned char* ws; int ph_lo, ph_hi; };
struct ArgsH { const float* in[30]; float* out; unsigned char* ws; int ph_lo, ph_hi; };
static_assert(sizeof(Args) == sizeof(ArgsH), "Args layout");

__device__ __forceinline__ float wave_sum(float v) {
#pragma unroll
    for (int o = 1; o < 64; o <<= 1) v += __shfl_xor(v, o);
    return v;
}
template <int MAP>
__device__ __forceinline__ void transpose_item(const float* W, int K, int N, bfu* WT, int row_off, LAS float* scr, int item, int lane) {
    const int nblk = N / 32, kb = item / nblk, nb = item % nblk, k0 = 64 * kb, n0 = 32 * nb;
#pragma unroll 8
    for (int i = 0; i < 32; ++i) { const int kk = 2 * i + (lane >> 5); scr[kk * 33 + (lane & 31)] = W[(size_t)(k0 + kk) * N + n0 + (lane & 31)]; }
    asm volatile("s_waitcnt lgkmcnt(0)" ::: "memory");
    const int c = lane & 7;
#pragma unroll
    for (int j = 0; j < 4; ++j) { const int n = (lane >> 3) + 8 * j; const LAS float* s = scr + (8 * c) * 33 + n;
        u32x4 o; o.x = pkbf(s[0 * 33], s[1 * 33]); o.y = pkbf(s[2 * 33], s[3 * 33]); o.z = pkbf(s[4 * 33], s[5 * 33]); o.w = pkbf(s[6 * 33], s[7 * 33]);
        int src = n0 + n, dst;
        if (MAP == 1) { const int tile = src >> 8, loc = src & 255, hl = loc >> 6, d = loc & 63; dst = tile * 256 + (d >> 5) * 128 + hl * 32 + (d & 31); } else dst = row_off + src;
        *(u32x4*)(WT + (size_t)dst * K + k0 + 8 * c) = o; }
    asm volatile("s_waitcnt lgkmcnt(0)" ::: "memory");
}
__device__ __forceinline__ void norm_row(float* xrow, const bfu* prow, const float* g, const float* shift, const float* scale, bfu* orow, int lane) {
    f32x4 v[4]; float s = 0.f;
#pragma unroll
    for (int j = 0; j < 4; ++j) { v[j] = *((const f32x4*)xrow + lane + 64 * j);
        if (prow) { const u32x2* pp = (const u32x2*)prow + lane + 64 * j;
#pragma unroll
            for (int q = 0; q < 4; ++q) { const u32x2 w = pp[(size_t)q * 1048576]; v[j][0] += __uint_as_float(w.x << 16); v[j][1] += __uint_as_float(w.x & 0xffff0000u); v[j][2] += __uint_as_float(w.y << 16); v[j][3] += __uint_as_float(w.y & 0xffff0000u); }
            *((f32x4*)xrow + lane + 64 * j) = v[j]; } s += (v[j][0] * v[j][0] + v[j][1] * v[j][1]) + (v[j][2] * v[j][2] + v[j][3] * v[j][3]); }
    const float rstd = 1.0f / sqrtf(wave_sum(s) * (1.0f / 1024.0f) + EPS_);
#pragma unroll
    for (int j = 0; j < 4; ++j) { const int c = 4 * lane + 256 * j; const f32x4 gv = *(const f32x4*)(g + c), sh = *(const f32x4*)(shift + c), sc = *(const f32x4*)(scale + c);
        const f32x4 y = v[j] * rstd * gv * (sc + 1.0f) + sh; u32x2 w; w.x = pkbf(y[0], y[1]); w.y = pkbf(y[2], y[3]); *((u32x2*)orow + lane + 64 * j) = w; }
}
__device__ __forceinline__ void cvt_rows(const float* src, size_t src_stride, bfu* dst, size_t dst_stride, int nrows, int ncols, int gtid, int gthreads) {
    const int cpr = ncols / 8;
    for (long i = gtid; i < (long)nrows * cpr; i += gthreads) { const int r = (int)(i / cpr), c = (int)(i % cpr) * 8;
        const f32x4 a = *(const f32x4*)(src + (size_t)r * src_stride + c), b = *(const f32x4*)(src + (size_t)r * src_stride + c + 4);
        u32x4 w; w.x = pkbf(a[0], a[1]); w.y = pkbf(a[2], a[3]); w.z = pkbf(b[0], b[1]); w.w = pkbf(b[2], b[3]); *(u32x4*)(dst + (size_t)r * dst_stride + c) = w; }
}

#ifndef G_ALIGN
#define G_ALIGN true
#endif
#ifndef G_SP2
#define G_SP2 true
#endif
#ifndef QKV_SP2
#define QKV_SP2 true
#endif
struct LdsOrder {
    const LAS int* ul;
    __device__ __forceinline__ bool next(int i, pg8::Unit& u) const {
        if (i >= 16) return false;
        const LAS int* p = ul + i * 8;
        const int ok = __builtin_amdgcn_readfirstlane(p[0]); if (!ok) return false;
        u.pm = __builtin_amdgcn_readfirstlane(p[1]); u.pn = __builtin_amdgcn_readfirstlane(p[2]); u.kt0 = __builtin_amdgcn_readfirstlane(p[3]);
        u.nt = __builtin_amdgcn_readfirstlane(p[4]); u.split = __builtin_amdgcn_readfirstlane(p[5]); return true;
    }
    __device__ __forceinline__ void a_ready(const pg8::Unit&) const {}
    __device__ __forceinline__ void done(const pg8::Unit&) const {}
};
constexpr int LDS_UNITS = 131072;
template <class Epi, bool SP2 = G_SP2, bool SPLIT = false>
__device__ __forceinline__ void run_gemm(LAS unsigned char* lds, const bfu* A, const bfu* Bt, int M, int N, int K, const Epi& E) {
    int Kv = K; asm volatile("" : "+s"(Kv));
    LAS int* ul = (LAS int*)(lds + LDS_UNITS);
    { const int t = opaque_tid();
      if (t < 16) { int G_ = gridDim.x, bx_ = blockIdx.x; pg8::StaticOrder S; S.init(M, N, G_, bx_, Kv / 64, SPLIT); const pg8::Unit u = S.get(t);
          ul[t * 8 + 0] = u.nt > 0 ? 1 : 0; ul[t * 8 + 1] = u.pm; ul[t * 8 + 2] = u.pn; ul[t * 8 + 3] = u.kt0; ul[t * 8 + 4] = u.nt; ul[t * 8 + 5] = u.split; }
      __syncthreads(); }
    pg8::Gemm g{A, Bt, M, N, Kv}; LdsOrder S{ul};
    pg8::gemm_phase<Epi, LdsOrder, G_ALIGN, SP2>(lds, g, S, E);
    __syncthreads();
}

constexpr int LDS_BYTES = 147456, LDS_MISC = 147456 - 64;
constexpr int N_PHASES = 32;
#ifndef REP_ATT
#define REP_ATT 1
#endif
#ifndef REP_UP
#define REP_UP 1
#endif
#ifndef REP_RES
#define REP_RES 1
#endif
#ifndef REP_NORM
#define REP_NORM 1
#endif
#ifndef REP_P0
#define REP_P0 1
#endif
#ifndef PH_MASK
#define PH_MASK 0xffff
#endif
#define EN(k) (((PH_MASK) >> (k)) & 1)

typedef const __attribute__((address_space(4))) Args* KArgsP;
__device__ __forceinline__ KArgsP ka() { KArgsP p = (KArgsP)__builtin_amdgcn_kernarg_segment_ptr(); asm volatile("" : "+s"(p)); return p; }
__global__ void __launch_bounds__(512, 2) mega_fwd(Args args) {
    extern __shared__ __attribute__((aligned(16))) unsigned char lds[];
    cg::grid_group grid = cg::this_grid();
    const int lo = args.ph_lo, hi = args.ph_hi; int ph = 0;
    XcdBarrier xbar; xbar.bar = nullptr; xbar.x = 0; xbar.st = nullptr;
    if (hi - lo > 1) {
        volatile LAS unsigned* misc = (volatile LAS unsigned*)((LAS unsigned char*)lds + LDS_MISC);
        if (threadIdx.x < 16) misc[threadIdx.x] = 0u;
        __syncthreads();
        xbar = xcd_barrier_post((unsigned*)((unsigned char*)args.ws + WS_CTL), misc + 8);
    }
#define INP(i) ((const float*)A->in[i])
#define PHASE_LOCALS KArgsP A = ka(); const int tid = opaque_tid(), lane = tid & 63, wave = __builtin_amdgcn_readfirstlane(tid >> 6); \
    int G = gridDim.x, bx = blockIdx.x; asm volatile("" : "+s"(G), "+s"(bx)); const int vcu = (G % 8 == 0) ? (bx % 8) * (G / 8) + bx / 8 : bx; \
    const int gw = bx * 8 + wave, NGW = G * 8, gtid = bx * 512 + tid, GT = G * 512; (void)lane; (void)vcu; (void)gw; (void)NGW; (void)gtid; (void)GT; \
    LAS unsigned char* const ldsl = (LAS unsigned char*)lds; (void)ldsl; unsigned char* const ws = (unsigned char*)A->ws; float* const X = (float*)A->out; \
    bfu* const WT = (bfu*)(ws + WS_WT); float* const mods = (float*)(ws + WS_MODS); bfu* const KR = (bfu*)(ws + WS_KR); bfu* const CKVN = (bfu*)(ws + WS_CKVN); bfu* const DQN = (bfu*)(ws + WS_DQN); \
    bfu* const HB = (bfu*)(ws + WS_H); bfu* const QB = (bfu*)(ws + WS_Q); bfu* const KB = (bfu*)(ws + WS_K); bfu* const VB = (bfu*)(ws + WS_V); float* const TB = (float*)(ws + WS_T); bfu* const HID = (bfu*)(ws + WS_HID); \
    float* const st_a_k = X + 20971520; float* const st_a_v = X + 23068672; float* const st_b_ckv = X + 25165824; float* const st_b_kr = X + 26214400; float* const st_c_k = X + 26345472; float* const st_c_v = X + 27394048; \
    const float* const modl = mods + (size_t)layer * 5 * 6144; const float* const ng = INP(12) + (size_t)layer * 2 * 1024; \
    (void)WT; (void)KR; (void)CKVN; (void)DQN; (void)HB; (void)QB; (void)KB; (void)VB; (void)TB; (void)HID; (void)st_a_k; (void)st_a_v; (void)st_b_ckv; (void)st_b_kr; (void)st_c_k; (void)st_c_v; (void)modl; (void)ng;
#define PH_BEGIN if (ph >= lo && ph < hi) { PHASE_LOCALS
#ifndef REP_SYNC
#define REP_SYNC 1
#endif
#define PH_END if (ph + 1 < hi) { for (int rs_ = 0; rs_ < REP_SYNC; ++rs_) { if (ph == 0) grid.sync(); else xcd_barrier(xbar); } } } ++ph;

    { const int layer = 0;
    PH_BEGIN
    if constexpr (EN(0)) for (int rep_ = 0; rep_ < REP_P0; ++rep_) {
        if (rep_) __syncthreads();
        LAS float* scr = (LAS float*)(ldsl + wave * 16384);
        for (int seg = 0; seg < 20; ++seg) {
            const float* W; int K, N, map = 0, roff = 0; size_t dsto;
            if (seg < 4)       { W = INP(13) + (size_t)seg * DM * DFF; K = DM; N = DFF; dsto = WT_MLP_IN + (size_t)seg * DM * DFF; }
            else if (seg < 8)  { W = INP(14) + (size_t)(seg - 4) * DM * DFF; K = DFF; N = DM; dsto = WT_MLP_OUT + (size_t)(seg - 4) * DM * DFF; }
            else if (seg < 10) { W = INP(15) + (size_t)(seg - 8) * 1024 * 1536; K = 1024; N = 1536; dsto = WT_A_QKV + (size_t)(seg - 8) * 1536 * 1024; map = 1; }
            else if (seg < 12) { W = INP(17) + (size_t)(seg - 10) * 1024 * 1024; K = 1024; N = 1024; dsto = WT_A_O + (size_t)(seg - 10) * 1024 * 1024; }
            else if (seg == 12) { W = INP(25); K = 1024; N = 1536; dsto = WT_C_QKV; map = 1; }
            else if (seg == 13) { W = INP(28); K = 1024; N = 1024; dsto = WT_C_O; }
            else if (seg == 14) { W = INP(18); K = 1024; N = 384; dsto = WT_B_DQKV; }
            else if (seg == 15) { W = INP(21); K = 1024; N = 288; dsto = WT_B_DQKV; roff = 384; }
            else if (seg == 16) { W = INP(20); K = 384; N = 1536; dsto = WT_B_UQ; }
            else if (seg == 17) { W = INP(23); K = 256; N = 2048; dsto = WT_B_UKV; }
            else if (seg == 18) { W = INP(24); K = 1024; N = 1024; dsto = WT_B_O; }
            else break;
            const int nitems = (K / 64) * (N / 32);
            if (map == 1) { for (int it = gw; it < nitems; it += NGW) transpose_item<1>(W, K, N, WT + dsto, 0, scr, it, lane); }
            else          { for (int it = gw; it < nitems; it += NGW) transpose_item<0>(W, K, N, WT + dsto, roff, scr, it, lane); }
        }
        for (int i = gtid; i < 96 * 1024 / 8; i += GT) *(u32x4*)(WT + WT_B_DQKV + (size_t)672 * 1024 + (size_t)i * 8) = (u32x4){0u, 0u, 0u, 0u};
        { const f32x4* s0 = (const f32x4*)INP(0); const f32x4* s1 = (const f32x4*)INP(1); f32x4* d = (f32x4*)X;
          for (long i = gtid; i < (long)M_ROWS * 256; i += GT) d[i] = i < (long)NP_ROWS * 256 ? s0[i] : s1[i - (long)NP_ROWS * 256]; }
        __syncthreads();
        LAS float* sc = (LAS float*)ldsl;
        LAS float* part = (LAS float*)(ldsl + 20480);
        for (int i = tid; i < 5 * 1024; i += 512) { const int cnd = i >> 10, k = i & 1023; const float v = cnd < 4 ? INP(2)[cnd * 1024 + k] : INP(9)[k]; sc[i] = v / (1.0f + __expf(-v)); }
        __syncthreads();
        for (int item = bx; item < 4 * 96; item += G) {
            const int l = item / 96, cb = item % 96, col = cb * 64 + lane; const float* Wl = INP(10) + (size_t)l * 1024 * 6144;
            float a0 = 0.f, a1 = 0.f, a2 = 0.f, a3 = 0.f, a4 = 0.f;
#pragma unroll 8
            for (int kk = 0; kk < 128; ++kk) { const int k = wave * 128 + kk; const float w = Wl[(size_t)k * 6144 + col];
                a0 += sc[k] * w; a1 += sc[1024 + k] * w; a2 += sc[2048 + k] * w; a3 += sc[3072 + k] * w; a4 += sc[4096 + k] * w; }
            part[(wave * 5 + 0) * 64 + lane] = a0; part[(wave * 5 + 1) * 64 + lane] = a1; part[(wave * 5 + 2) * 64 + lane] = a2; part[(wave * 5 + 3) * 64 + lane] = a3; part[(wave * 5 + 4) * 64 + lane] = a4;
            __syncthreads();
            if (tid < 320) { const int cnd = tid >> 6, ln = tid & 63; float s = INP(11)[l * 6144 + cb * 64 + ln];
#pragma unroll
                for (int w8 = 0; w8 < 8; ++w8) s += part[(w8 * 5 + cnd) * 64 + ln];
                mods[((size_t)l * 5 + cnd) * 6144 + cb * 64 + ln] = s; }
            __syncthreads();
        }
    }
    PH_END
    }

    for (int layer = 0; layer < 4; ++layer) {
        const int kind = layer % 3, jj = layer / 3;
        PH_BEGIN
        if constexpr (EN(1))
        for (int rep_ = 0; rep_ < REP_NORM; ++rep_)
        for (int r = gw; r < M_ROWS; r += NGW) { const float* mc = modl + cond_of_row(r) * 6144; const bfu* pr = (G == 256 && layer > 0 && r < NP_ROWS) ? (const bfu*)(ws + WS_P) + (size_t)r * 1024 : nullptr; norm_row(X + (size_t)r * 1024, pr, ng, mc, mc + 1024, HB + (size_t)r * 1024, lane); }
        if constexpr (EN(1))
        for (int b = 0; b < 4; ++b) {
            const size_t e0 = NP_ROWS + (size_t)b * EXT_B;
            if (kind == 0)      { cvt_rows(INP(3) + (size_t)(b * 2 + jj) * 65536, 256, KB + e0 * 256, 256, 256, 256, gtid, GT); cvt_rows(INP(4) + (size_t)(b * 2 + jj) * 65536, 256, VB + e0 * 256, 256, 256, 256, gtid, GT); }
            else if (kind == 2) { cvt_rows(INP(7) + (size_t)b * 65536, 256, KB + e0 * 256, 256, 256, 256, gtid, GT); cvt_rows(INP(8) + (size_t)b * 65536, 256, VB + e0 * 256, 256, 256, 256, gtid, GT); }
            else                { cvt_rows(INP(5) + (size_t)b * 65536, 256, CKVN + e0 * 256, 256, 256, 256, gtid, GT); cvt_rows(INP(6) + (size_t)b * 8192, 32, KR + e0 * 32, 32, 256, 32, gtid, GT); }
        }
        PH_END
        if (kind == 1) {
            PH_BEGIN
            if constexpr (EN(2)) { EpiF32 E{TB, 1024}; run_gemm(ldsl, HB, WT + WT_B_DQKV, M_ROWS, 768, 1024, E); }
            PH_END
            PH_BEGIN
            if constexpr (EN(3))
            for (int r = gw; r < M_ROWS; r += NGW) {
                const float* tr = TB + (size_t)r * 1024; f32x4 v[3];
#pragma unroll
                for (int k = 0; k < 3; ++k) v[k] = *(const f32x4*)(tr + 4 * lane + 256 * k);
                float sq = (v[0][0] * v[0][0] + v[0][1] * v[0][1]) + (v[0][2] * v[0][2] + v[0][3] * v[0][3]);
                const float s1 = (v[1][0] * v[1][0] + v[1][1] * v[1][1]) + (v[1][2] * v[1][2] + v[1][3] * v[1][3]);
                const float s2 = (v[2][0] * v[2][0] + v[2][1] * v[2][1]) + (v[2][2] * v[2][2] + v[2][3] * v[2][3]);
                float skv = 0.f;
                if (lane < 32) { sq += s1; skv = s2; } else { skv = s1; }
                sq = wave_sum(sq); skv = wave_sum(skv);
                const float rq = 1.0f / sqrtf(sq * (1.0f / 384.0f) + EPS_), rkv = 1.0f / sqrtf(skv * (1.0f / 256.0f) + EPS_);
                const bool sample = r >= NP_ROWS; const int e = ext_of_row(r); const int t = (r - NP_ROWS) & 4095;
                { const f32x4 g = *(const f32x4*)(INP(19) + 4 * lane); const f32x4 y = v[0] * rq * g; u32x2 w; w.x = pkbf(y[0], y[1]); w.y = pkbf(y[2], y[3]); *(u32x2*)(DQN + (size_t)r * 384 + 4 * lane) = w; }
                if (lane < 32) {
                    { const f32x4 g = *(const f32x4*)(INP(19) + 256 + 4 * lane); const f32x4 y = v[1] * rq * g; u32x2 w; w.x = pkbf(y[0], y[1]); w.y = pkbf(y[2], y[3]); *(u32x2*)(DQN + (size_t)r * 384 + 256 + 4 * lane) = w; }
                    { const int c = 128 + 4 * lane; const f32x4 g = *(const f32x4*)(INP(22) + c); const f32x4 y = v[2] * rkv * g; u32x2 w; w.x = pkbf(y[0], y[1]); w.y = pkbf(y[2], y[3]); *(u32x2*)(CKVN + (size_t)e * 256 + c) = w;
                      if (!sample) *(f32x4*)(st_b_ckv + (size_t)r * 256 + c) = y; }
                } else {
                    { const int c = 4 * (lane - 32); const f32x4 g = *(const f32x4*)(INP(22) + c); const f32x4 y = v[1] * rkv * g; u32x2 w; w.x = pkbf(y[0], y[1]); w.y = pkbf(y[2], y[3]); *(u32x2*)(CKVN + (size_t)e * 256 + c) = w;
                      if (!sample) *(f32x4*)(st_b_ckv + (size_t)r * 256 + c) = y; }
                }
                { f32x4 y = v[2]; const int l8 = lane - 32;
                  f32x4 oth; oth[0] = __shfl_xor(y[0], 2); oth[1] = __shfl_xor(y[1], 2); oth[2] = __shfl_xor(y[2], 2); oth[3] = __shfl_xor(y[3], 2);
                  if (lane >= 32 && lane < 40) {
                      if (sample) { const int pos = l8 < 4 ? (t >> 6) : (t & 63); const bool first = (l8 & 2) == 0;
#pragma unroll
                          for (int j = 0; j < 4; ++j) { float c, s; rope_cs(pos, 4 * (l8 & 1) + j, 1.0f / 8.0f, c, s); y[j] = first ? (y[j] * c - oth[j] * s) : (oth[j] * s + y[j] * c); } }
                      else *(f32x4*)(st_b_kr + (size_t)r * 32 + 4 * l8) = y;
                      u32x2 w; w.x = pkbf(y[0], y[1]); w.y = pkbf(y[2], y[3]); *(u32x2*)(KR + (size_t)e * 32 + 4 * l8) = w; } }
            }
            PH_END
            PH_BEGIN
            if constexpr (EN(4)) { EpiUQ E{QB}; run_gemm(ldsl, DQN, WT + WT_B_UQ, M_ROWS, 1536, 384, E); }
            if constexpr (EN(5)) { EpiUKV E{KB, VB}; run_gemm(ldsl, CKVN, WT + WT_B_UKV, EXT_ROWS, 2048, 256, E); }
            PH_END
        } else if (kind == 0) {
            PH_BEGIN
            if constexpr (EN(6)) { EpiQKV<false> E{QB, KB, VB, st_a_k + (size_t)jj * 65536, st_a_v + (size_t)jj * 65536, nullptr, nullptr, 2}; run_gemm(ldsl, HB, WT + WT_A_QKV + (size_t)jj * 1536 * 1024, M_ROWS, 1536, 1024, E); }
            PH_END
        } else {
            PH_BEGIN
            if constexpr (EN(7)) { EpiQKV<true> E{QB, KB, VB, st_c_k, st_c_v, INP(26), INP(27), 1}; run_gemm<EpiQKV<true>, QKV_SP2>(ldsl, HB, WT + WT_C_QKV, M_ROWS, 1536, 1024, E); }
            PH_END
        }
        PH_BEGIN
        for (int rep_ = 0; rep_ < REP_ATT; ++rep_)
        for (int i = 0; i < 5; ++i) {
            const int ui = i * G + vcu; if (ui >= 1280) break;
            att::Unit U; int b, h, qb; bool prompt = ui >= 1024;
            if (!prompt) { if (kind == 1) { qb = ui & 15; h = (ui >> 4) & 15; b = ui >> 8; } else { qb = ui & 15; const int g4 = (ui >> 4) & 3, kvh = (ui >> 6) & 3; b = ui >> 8; h = kvh * 4 + g4; } }
            else { const int u2 = ui - 1024; qb = 0; h = u2 & 15; b = u2 >> 4; if (kind != 1) { h = ((u2 >> 2) & 3) * 4 + (u2 & 3); } }
            const int r0 = prompt ? b * 256 : NP_ROWS + b * 4096 + qb * 256; const size_t ebase = prompt ? (size_t)b * 256 : NP_ROWS + (size_t)b * EXT_B;
            U.O = HB + (size_t)r0 * 1024 + h * 64; U.q0 = qb * 256; U.kstart = 0; U.sinkl2 = -1e30f;
            if (kind == 1) { U.Q = QB + (size_t)r0 * 1536 + h * 96; U.ldq = 1536; U.K = KB + ebase * 1024 + h * 64; U.V = VB + ebase * 1024 + h * 64; U.KR = KR + ebase * 32; U.ldk = 1024;
                U.NT = prompt ? 4 : 68; U.C = 0.10206207261596577f * 1.4426950408889634f; U.thr_raw = 8.0f / 0.10206207261596577f; }
            else { const int kvh = h >> 2; U.Q = QB + (size_t)r0 * 1024 + h * 64; U.ldq = 1024; U.K = KB + ebase * 256 + kvh * 64; U.V = VB + ebase * 256 + kvh * 64; U.KR = nullptr; U.ldk = 256;
                U.NT = prompt ? 4 : 68; U.C = 0.125f * 1.4426950408889634f; U.thr_raw = 64.0f;
                if (kind == 0) { U.sinkl2 = INP(16)[jj * 16 + h] * 1.4426950408889634f;
                    if (!prompt) { const int q0 = qb * 256; const int ks = q0 - 128 < 0 ? 0 : q0 - 128; const int ke = q0 + 384 > 4096 ? 4096 : q0 + 384; U.kstart = ks; U.NT = 4 + (ke - ks) / 64; } } }
            if (kind == 1) { if constexpr (EN(8)) att::attn_unit<96, false>(U, (char*)lds); }
            else if (kind == 0) { if constexpr (EN(9)) att::attn_unit<64, true>(U, (char*)lds); }
            else { if constexpr (EN(10)) att::attn_unit<64, false>(U, (char*)lds); }
        }
        PH_END
        PH_BEGIN
        if constexpr (EN(11)) { const bfu* wo = WT + (kind == 0 ? WT_A_O + (size_t)jj * 1024 * 1024 : kind == 1 ? WT_B_O : WT_C_O); EpiResid E{X, modl + 2048, (bfu*)(ws + WS_P)}; run_gemm<EpiResid, G_SP2, true>(ldsl, HB, wo, M_ROWS, 1024, 1024, E); }
        PH_END
        PH_BEGIN
        if constexpr (EN(1))
        for (int rep_ = 0; rep_ < REP_NORM; ++rep_)
        for (int r = gw; r < M_ROWS; r += NGW) { const float* mc = modl + cond_of_row(r) * 6144; const bfu* pr = (G == 256 && r < NP_ROWS) ? (const bfu*)(ws + WS_P) + (size_t)r * 1024 : nullptr; norm_row(X + (size_t)r * 1024, pr, ng + 1024, mc + 3072, mc + 4096, HB + (size_t)r * 1024, lane); }
        PH_END
        PH_BEGIN
        for (int rep_ = 0; rep_ < REP_UP; ++rep_)
        if constexpr (EN(12)) { EpiSqRelu E{HID, DFF}; run_gemm(ldsl, HB, WT + WT_MLP_IN + (size_t)layer * DM * DFF, M_ROWS, DFF, DM, E); }
        PH_END
        PH_BEGIN
        if constexpr (EN(11)) { EpiResid E{X, modl + 5120, (bfu*)(ws + WS_P)}; run_gemm<EpiResid, G_SP2, true>(ldsl, HID, WT + WT_MLP_OUT + (size_t)layer * DM * DFF, M_ROWS, DM, DFF, E); }
        PH_END
    }
    { const int layer = 0;
    PH_BEGIN
    if constexpr (EN(1))
    for (int r = gw; r < M_ROWS; r += NGW) {
        float* xr = X + (size_t)r * 1024; f32x4 v[4]; float s = 0.f;
#pragma unroll
        for (int j = 0; j < 4; ++j) { v[j] = *((const f32x4*)xr + lane + 64 * j);
            if (G == 256 && r < NP_ROWS) { const u32x2* pp = (const u32x2*)((const bfu*)(ws + WS_P) + (size_t)r * 1024) + lane + 64 * j;
#pragma unroll
                for (int q = 0; q < 4; ++q) { const u32x2 w = pp[(size_t)q * 1048576]; v[j][0] += __uint_as_float(w.x << 16); v[j][1] += __uint_as_float(w.x & 0xffff0000u); v[j][2] += __uint_as_float(w.y << 16); v[j][3] += __uint_as_float(w.y & 0xffff0000u); } }
            s += (v[j][0] * v[j][0] + v[j][1] * v[j][1]) + (v[j][2] * v[j][2] + v[j][3] * v[j][3]); }
        const float rstd = 1.0f / sqrtf(wave_sum(s) * (1.0f / 1024.0f) + EPS_);
#pragma unroll
        for (int j = 0; j < 4; ++j) { const f32x4 g = *(const f32x4*)(INP(29) + 4 * lane + 256 * j); *((f32x4*)xr + lane + 64 * j) = v[j] * rstd * g; }
    }
    PH_END
    }
#undef PH_BEGIN
#undef PH_END
}

#ifndef MK_MULTI
#define MK_MULTI 0
#endif
extern "C" void kernel_launch(void* const* d_in, const int* in_sizes, int n_in, void* d_out, int out_size, void* d_ws, size_t ws_size, hipStream_t stream) {
    static int grid = 0;
    if (grid == 0) {
        if (n_in != 30 || ws_size < WS_END) { fprintf(stderr, "kernel_launch: n_in %d ws %zu (need %zu)\n", n_in, ws_size, (size_t)WS_END); grid = -1; return; }
        int dev = 0, cus = 0, per_cu = 0;
        hipGetDevice(&dev); hipDeviceGetAttribute(&cus, hipDeviceAttributeMultiprocessorCount, dev);
        if (hipFuncSetAttribute((const void*)mega_fwd, hipFuncAttributeMaxDynamicSharedMemorySize, LDS_BYTES) != hipSuccess) { fprintf(stderr, "kernel_launch: hipFuncSetAttribute failed\n"); grid = -1; return; }
        hipOccupancyMaxActiveBlocksPerMultiprocessor(&per_cu, (const void*)mega_fwd, 512, LDS_BYTES);
        if (per_cu < 1) { fprintf(stderr, "kernel_launch: occupancy query says %d\n", per_cu); per_cu = 1; }
        (void)hipGetLastError();
        grid = cus * 1;
    }
    if (grid < 0) return;
    ArgsH a{};
    for (int i = 0; i < 30; ++i) a.in[i] = (const float*)d_in[i];
    a.out = (float*)d_out; a.ws = (unsigned char*)d_ws;
    if (hipMemsetAsync((char*)d_ws + WS_CTL, 0, 16384, stream) != hipSuccess) { fprintf(stderr, "memset failed\n"); return; }
#if MK_MULTI
    for (int p = 0; p < N_PHASES; ++p) { a.ph_lo = p; a.ph_hi = p + 1; void* kargs[] = {&a}; hipError_t e = hipLaunchKernel((const void*)mega_fwd, dim3(grid), dim3(512), kargs, LDS_BYTES, stream); if (e != hipSuccess) { fprintf(stderr, "launch %d failed: %s\n", p, hipGetErrorString(e)); break; } }
#else
    a.ph_lo = 0; a.ph_hi = N_PHASES;
    void* kargs[] = {&a};
    hipError_t e = hipLaunchCooperativeKernel((const void*)mega_fwd, dim3(grid), dim3(512), kargs, LDS_BYTES, stream);
    if (e != hipSuccess) fprintf(stderr, "cooperative launch failed: %s (grid %d)\n", hipGetErrorString(e), grid);
#endif
}
```

```cpp
#include <hip/hip_runtime.h>
#include <hip/hip_cooperative_groups.h>
#include <cstdio>
#include <cstdint>
namespace cg = cooperative_groups;
#define LAS __attribute__((address_space(3)))
__device__ __forceinline__ int opaque_tid() { int t = threadIdx.x; asm volatile("" : "+v"(t)); return t; }
namespace pg8 {
#define PG8_LAS __attribute__((address_space(3)))
typedef unsigned short bf16_t;
typedef short bf16x8 __attribute__((ext_vector_type(8)));
typedef float f32x4 __attribute__((ext_vector_type(4)));
typedef unsigned u32x4 __attribute__((ext_vector_type(4)));
constexpr int BM = 256, BK = 64, HALF = 128, HTB = HALF * BK * 2  , STAGE_BYTES = 8 * HTB, NXCD = 8, WGM = 8;

__host__ __device__ __forceinline__ int lds_byte(int r, int c) { const int st = (r >> 4) * 2 + (c >> 5), rr = r & 15, cc = c & 31, ob = rr * 64 + cc * 2; return st * 1024 + (ob ^ (((ob >> 9) & 1) << 5)); }
__host__ __device__ __forceinline__ void stage_rc(int b, int& R, int& C) { const int st = b / 1024, sb = b % 1024, swz = sb ^ (((sb >> 9) & 1) << 5); R = (st >> 1) * 16 + swz / 64; C = (st & 1) * 32 + (swz % 64) / 2; }
__host__ __device__ __forceinline__ int perm32(int rho) { const int n = rho >> 4, i = rho & 15; return 8 * (i >> 2) + 4 * n + (i & 3); }

struct Unit { int pm, pn, kt0, nt, split; };
struct Gemm { const bf16_t* A; const bf16_t* Bt; int M, N, K; };

struct StaticOrder {
    int nM, nN, nwg, G, c, ntk, rounds, rem, sp;
    __host__ __device__ void init(int M, int N, int G_, int c_, int ntk_ = 0, bool SPLIT = false) { nM = M / BM; nN = N / BM; nwg = nM * nN; G = G_; c = c_; ntk = ntk_;
        rounds = 0; rem = 0; sp = (SPLIT && G == 256 && nM == 80 && nN == 4 && (ntk & 7) == 0) ? 4 : 1; }
    __host__ __device__ Unit get(int i) const {
        Unit u; u.pm = 0; u.pn = 0; u.kt0 = 0; u.nt = 0; u.split = 0;
        if (sp == 4) {
            if (i == 0) { const int id = (c & 7) * 32 + (c >> 3); u.pm = 16 + (id >> 2); u.pn = id & 3; u.nt = ntk; }
            else if (i == 1) { const int t = c >> 2, part = c & 3; u.pm = t >> 2; u.pn = t & 3; u.nt = ntk >> 2; u.kt0 = part * u.nt; u.split = 1 + part; }
            return u; }
        const long LL = (long)i * G + c;
        if (LL < nwg) {
            int wgid = (int)LL; { const int q = nwg / NXCD, r = nwg % NXCD, xcd = wgid % NXCD, off = wgid / NXCD; wgid = (xcd < r ? xcd * (q + 1) : r * (q + 1) + (xcd - r) * q) + off; }
            const int nig = WGM * nN, gid = wgid / nig, fm = gid * WGM, gsz = (nM - fm) < WGM ? (nM - fm) : WGM;
            u.pm = fm + ((wgid % nig) % gsz); u.pn = (wgid % nig) / gsz; u.nt = ntk; }
        return u; }
    __host__ __device__ bool next(int i, Unit& u) const { u = get(i); return u.nt > 0; }
    __device__ __forceinline__ void a_ready(const Unit&) const {}
    __device__ __forceinline__ void done(const Unit&) const {}
};

__device__ __forceinline__ unsigned cvt_pk_bf16(float lo, float hi) { unsigned r; asm volatile("v_cvt_pk_bf16_f32 %0, %1, %2" : "=v"(r) : "v"(lo), "v"(hi)); return r; }
template <class Epi, class Sched, bool ALIGN_EPI = false, bool SP2 = false>
__device__ __forceinline__ void gemm_phase(PG8_LAS unsigned char* lds, const Gemm g, const Sched& S, const Epi& E) {
    const int tid = opaque_tid(), wid = __builtin_amdgcn_readfirstlane(tid >> 6), lane = tid & 63, wr = wid >> 2, wc = wid & 3, fr = lane & 15, fq = lane >> 4;
    const int K = g.K;
    unsigned voffA[2], voffB[2];
#pragma unroll
    for (int i = 0; i < 2; ++i) { int R, C; stage_rc(tid * 16 + i * 8192, R, C); const int Rb = Epi::PERM ? ((R & ~31) + perm32(R & 31)) : R;
        voffA[i] = (unsigned)(R * K + C) * 2u; voffB[i] = (unsigned)(Rb * K + C) * 2u; }
    const size_t kstep = (size_t)(BK * 2);
    const size_t hstep = (size_t)HALF * K * 2;
    const size_t tstep = 2 * hstep;
    const unsigned ldsw = (unsigned)wid * 1024u;
    const int aoff = lds_byte(wr * 64 + fr, fq * 8), boff = lds_byte(wc * 32 + fr, fq * 8);
#define PG8_SA(b, h) (((b) * 2 + (h)) * HTB)
#define PG8_SB(b, h) ((4 + (b) * 2 + (h)) * HTB)
#define PG8_STAGE(bufoff, gbase, voff) do { _Pragma("unroll") for (int _i = 0; _i < 2; ++_i) \
        __builtin_amdgcn_global_load_lds((const unsigned*)((const char*)(gbase) + (voff)[_i]), (PG8_LAS unsigned*)(lds + (bufoff) + ldsw + _i * 8192), 16, 0, 0); } while (0)
#define PG8_LDA(dst, b, h) do { _Pragma("unroll") for (int m = 0; m < 4; ++m) _Pragma("unroll") for (int k = 0; k < 2; ++k) dst[m][k] = *(const PG8_LAS bf16x8*)(lds + PG8_SA(b, h) + aoff + m * 2048 + k * 1024); } while (0)
#define PG8_LDB(dst, b, h) do { _Pragma("unroll") for (int n = 0; n < 2; ++n) _Pragma("unroll") for (int k = 0; k < 2; ++k) dst[n][k] = *(const PG8_LAS bf16x8*)(lds + PG8_SB(b, h) + boff + n * 2048 + k * 1024); } while (0)
#define PG8_MMA(ai, bj, At, Bt) do { __builtin_amdgcn_s_setprio(1); _Pragma("unroll") for (int m = 0; m < 4; ++m) _Pragma("unroll") for (int n = 0; n < 2; ++n) _Pragma("unroll") for (int k = 0; k < 2; ++k) \
        acc[ai][bj][m][n] = __builtin_amdgcn_mfma_f32_16x16x32_bf16(Bt[n][k], At[m][k], acc[ai][bj][m][n], 0, 0, 0); __builtin_amdgcn_s_setprio(0); } while (0)
#define PG8_WAIT_V(n) asm volatile("s_waitcnt vmcnt(" #n ")" ::: "memory")
#define PG8_WAIT_L(n) asm volatile("s_waitcnt lgkmcnt(" #n ")" ::: "memory")
#define PG8_BAR __builtin_amdgcn_s_barrier()
#define PG8_SCHED __builtin_amdgcn_sched_barrier(0)
    Unit cur, nxt; int ui = 0;
    if (!S.next(0, cur)) return;
    f32x4 acc[2][2][4][2];
#pragma unroll
    for (int a = 0; a < 2; ++a)
#pragma unroll
        for (int b = 0; b < 2; ++b)
#pragma unroll
            for (int m = 0; m < 4; ++m)
#pragma unroll
                for (int n = 0; n < 2; ++n) acc[a][b][m][n] = (f32x4){0.f, 0.f, 0.f, 0.f};
    bf16x8 At[4][2], B0[2][2], B1[2][2];
    const char* cA = (const char*)g.A + (size_t)cur.pm * tstep + (size_t)cur.kt0 * kstep; const char* cB = (const char*)g.Bt + (size_t)cur.pn * tstep + (size_t)cur.kt0 * kstep;
    S.a_ready(cur);
    if constexpr (SP2) {
        PG8_STAGE(PG8_SB(0, 0), cB, voffB); PG8_STAGE(PG8_SB(0, 1), cB + hstep, voffB); PG8_STAGE(PG8_SA(0, 0), cA, voffA); PG8_STAGE(PG8_SA(0, 1), cA + hstep, voffA);
        if (wr == 1) PG8_BAR;
        PG8_WAIT_V(2); PG8_BAR;
        PG8_STAGE(PG8_SB(1, 0), cB + kstep, voffB); PG8_STAGE(PG8_SA(1, 0), cA + kstep, voffA); PG8_STAGE(PG8_SB(1, 1), cB + hstep + kstep, voffB);
        PG8_WAIT_V(6); PG8_BAR;
    } else {
        PG8_STAGE(PG8_SB(0, 0), cB, voffB); PG8_STAGE(PG8_SA(0, 0), cA, voffA); PG8_STAGE(PG8_SB(0, 1), cB + hstep, voffB); PG8_STAGE(PG8_SA(0, 1), cA + hstep, voffA);
        if (wr == 1) PG8_BAR;
        PG8_WAIT_V(4); PG8_BAR;
        PG8_STAGE(PG8_SB(1, 0), cB + kstep, voffB); PG8_STAGE(PG8_SA(1, 0), cA + kstep, voffA); PG8_STAGE(PG8_SB(1, 1), cB + hstep + kstep, voffB);
        PG8_WAIT_V(6); PG8_BAR;
    }
    for (;;) {
        const bool has_next = S.next(ui + 1, nxt);
        const char* nA = has_next ? (const char*)g.A + (size_t)nxt.pm * tstep + (size_t)nxt.kt0 * kstep : cA; const char* nB = has_next ? (const char*)g.Bt + (size_t)nxt.pn * tstep + (size_t)nxt.kt0 * kstep : cB;
        const int nt = cur.nt;
        for (int t = 0; t < nt; t += 2) {
            asm volatile("" : "+v"(voffA[0]), "+v"(voffA[1]), "+v"(voffB[0]), "+v"(voffB[1]));
            const bool last = (t == nt - 2);
            const char* a1 = cA + (size_t)(t + 1) * kstep;
            const char* a2 = last ? nA : cA + (size_t)(t + 2) * kstep; const char* b2 = last ? nB : cB + (size_t)(t + 2) * kstep;
            const char* a3 = a2 + kstep; const char* b3 = b2 + kstep;
            if (last && has_next) S.a_ready(nxt);
            if constexpr (SP2) {
            PG8_LDB(B0, 0, 0); PG8_LDB(B1, 0, 1); PG8_SCHED; PG8_LDA(At, 0, 0); PG8_STAGE(PG8_SA(1, 1), a1 + hstep, voffA);
            PG8_WAIT_V(8); PG8_WAIT_L(0); PG8_BAR; PG8_MMA(0, 0, At, B0); PG8_MMA(0, 1, At, B1); PG8_BAR; PG8_SCHED;
            PG8_LDA(At, 0, 1); PG8_STAGE(PG8_SB(0, 0), b2, voffB); PG8_STAGE(PG8_SB(0, 1), b2 + hstep, voffB); PG8_STAGE(PG8_SA(0, 0), a2, voffA);
            PG8_WAIT_V(8); PG8_WAIT_L(0); PG8_BAR; PG8_MMA(1, 0, At, B0); PG8_MMA(1, 1, At, B1); PG8_BAR; PG8_SCHED;
            PG8_LDB(B0, 1, 0); PG8_LDB(B1, 1, 1); PG8_SCHED; PG8_LDA(At, 1, 0); PG8_STAGE(PG8_SA(0, 1), a2 + hstep, voffA);
            PG8_WAIT_V(8); PG8_WAIT_L(0); PG8_BAR; PG8_MMA(0, 0, At, B0); PG8_MMA(0, 1, At, B1); PG8_BAR; PG8_SCHED;
            PG8_LDA(At, 1, 1); PG8_STAGE(PG8_SB(1, 0), b3, voffB); PG8_STAGE(PG8_SB(1, 1), b3 + hstep, voffB); PG8_STAGE(PG8_SA(1, 0), a3, voffA);
            PG8_WAIT_V(8); PG8_WAIT_L(0); PG8_BAR; PG8_MMA(1, 0, At, B0); PG8_MMA(1, 1, At, B1); PG8_BAR; PG8_SCHED;
            } else {
            PG8_LDB(B0, 0, 0); PG8_SCHED; PG8_LDA(At, 0, 0); PG8_STAGE(PG8_SA(1, 1), a1 + hstep, voffA);
            PG8_WAIT_L(8); PG8_BAR; PG8_WAIT_L(0); PG8_MMA(0, 0, At, B0); PG8_BAR; PG8_SCHED;
            PG8_LDB(B1, 0, 1); PG8_STAGE(PG8_SB(0, 0), b2, voffB);
            PG8_BAR; PG8_WAIT_L(0); PG8_MMA(0, 1, At, B1); PG8_BAR;
            PG8_LDA(At, 0, 1); PG8_STAGE(PG8_SA(0, 0), a2, voffA);
            PG8_BAR; PG8_WAIT_L(0); PG8_MMA(1, 0, At, B0); PG8_BAR; PG8_SCHED;
            PG8_STAGE(PG8_SB(0, 1), b2 + hstep, voffB);
            PG8_WAIT_V(6); PG8_BAR; PG8_MMA(1, 1, At, B1); PG8_BAR;
            PG8_LDB(B0, 1, 0); PG8_SCHED; PG8_LDA(At, 1, 0); PG8_STAGE(PG8_SA(0, 1), a2 + hstep, voffA);
            PG8_WAIT_L(8); PG8_BAR; PG8_WAIT_L(0); PG8_MMA(0, 0, At, B0); PG8_BAR; PG8_SCHED;
            PG8_LDB(B1, 1, 1); PG8_STAGE(PG8_SB(1, 0), b3, voffB);
            PG8_BAR; PG8_WAIT_L(0); PG8_MMA(0, 1, At, B1); PG8_BAR;
            PG8_LDA(At, 1, 1); PG8_STAGE(PG8_SA(1, 0), a3, voffA);
            PG8_BAR; PG8_WAIT_L(0); PG8_MMA(1, 0, At, B0); PG8_BAR; PG8_SCHED;
            PG8_STAGE(PG8_SB(1, 1), b3 + hstep, voffB);
            PG8_WAIT_V(6); PG8_BAR; PG8_MMA(1, 1, At, B1); PG8_BAR;
            }
        }
        if constexpr (ALIGN_EPI) { if (wr == 0) PG8_BAR; }
        if constexpr (!Epi::AFTER_DRAIN) { E(acc, cur, wr, wc, fr, fq); S.done(cur); }
        if (!has_next) break;
#pragma unroll
        for (int a = 0; a < 2; ++a)
#pragma unroll
            for (int b = 0; b < 2; ++b)
#pragma unroll
                for (int m = 0; m < 4; ++m)
#pragma unroll
                    for (int n = 0; n < 2; ++n) acc[a][b][m][n] = (f32x4){0.f, 0.f, 0.f, 0.f};
        cur = nxt; cA = nA; cB = nB; ++ui;
        if constexpr (ALIGN_EPI) { if (wr == 1) PG8_BAR; }
    }
    PG8_WAIT_V(0);
    if constexpr (!ALIGN_EPI) { if (wr == 0) PG8_BAR; }
    PG8_BAR;
    if constexpr (Epi::AFTER_DRAIN) { E.fused(acc, cur, wr, wc, fr, fq, lds, wid, lane); S.done(cur); }
#undef PG8_SA
#undef PG8_SB
#undef PG8_STAGE
#undef PG8_LDA
#undef PG8_LDB
#undef PG8_MMA
#undef PG8_WAIT_V
#undef PG8_WAIT_L
#undef PG8_BAR
#undef PG8_SCHED
}
}
namespace att {
using bf16x8 = __attribute__((ext_vector_type(8))) short;
using s16x4  = __attribute__((ext_vector_type(4))) short;
using f32x16 = __attribute__((ext_vector_type(16))) float;
using u32x4  = __attribute__((ext_vector_type(4))) unsigned;
using u32x2  = __attribute__((ext_vector_type(2))) unsigned;
constexpr int NW = 8, QBLK = 32, KVBLK = 64;
constexpr int SHM_V = 16384, SHM_K = 16384, SHM_ATTN = 3 * SHM_V + 3 * SHM_K + NW * 64 * 4;
#define KSWZ(row, colB) ((row) * 256 + ((colB) ^ (((row) & 7) << 4)))
#define SBAR() __builtin_amdgcn_sched_barrier(0)
__device__ __forceinline__ int crow(int r, int hi) { return (r & 3) + 8 * (r >> 2) + 4 * hi; }
__device__ __forceinline__ unsigned cvtpk(float lo, float hi) { unsigned r; asm volatile("v_cvt_pk_bf16_f32 %0, %1, %2" : "=v"(r) : "v"(lo), "v"(hi)); return r; }

#define MX3(a, b, c) __builtin_fmaxf(__builtin_fmaxf((a), (b)), (c))
template <bool FIRST>
__device__ __forceinline__ void partialSM(f32x16& p0, f32x16& p1, float& m_reg, f32x16& negm, float& alpha, const float thr) {
  float a = MX3(p0[0], p0[1], p1[0]), b = MX3(p0[2], p0[3], p1[1]); a = MX3(a, p1[2], p1[3]);
#pragma unroll
  for (int r = 4; r < 16; r += 4) { a = MX3(a, p0[r], p0[r + 1]); b = MX3(b, p0[r + 2], p0[r + 3]); a = MX3(a, p1[r], p1[r + 1]); b = MX3(b, p1[r + 2], p1[r + 3]); }
  float pmax = fmaxf(a, b);
  { auto rr = __builtin_amdgcn_permlane32_swap(__float_as_uint(pmax), __float_as_uint(pmax), false, false);
    pmax = fmaxf(__uint_as_float(rr[0]), __uint_as_float(rr[1])); }
  alpha = 1.f;
  if (FIRST || !__builtin_expect(__all(pmax <= thr), 1)) {
    const float dl = FIRST ? pmax : fmaxf(pmax, 0.f);
    alpha = __builtin_amdgcn_exp2f(-dl); m_reg += dl;
#pragma unroll
    for (int r = 0; r < 16; ++r) { p0[r] -= dl; p1[r] -= dl; }
#pragma unroll
    for (int r = 0; r < 16; ++r) negm[r] = -m_reg;
  }
#pragma unroll
  for (int r = 0; r < 16; ++r) p0[r] = __builtin_amdgcn_exp2f(p0[r]);
}
__device__ __forceinline__ void finishSM(f32x16& p0, f32x16& p1, bf16x8& pa0, bf16x8& pa1, bf16x8& pa2, bf16x8& pa3) {
#pragma unroll
  for (int r = 0; r < 16; ++r) p1[r] = __builtin_amdgcn_exp2f(p1[r]);
#define PK4(P, BASE, OUT) do { unsigned a0 = cvtpk(P[BASE + 0], P[BASE + 1]), a1 = cvtpk(P[BASE + 2], P[BASE + 3]);   \
    unsigned b0 = cvtpk(P[BASE + 4], P[BASE + 5]), b1 = cvtpk(P[BASE + 6], P[BASE + 7]);                              \
    auto r0 = __builtin_amdgcn_permlane32_swap(a0, b0, false, false); auto r1 = __builtin_amdgcn_permlane32_swap(a1, b1, false, false); \
    u32x4 w = {r0[0], r1[0], r0[1], r1[1]}; OUT = *reinterpret_cast<bf16x8*>(&w); } while (0)
  PK4(p0, 0, pa0); PK4(p0, 8, pa1); PK4(p1, 0, pa2); PK4(p1, 8, pa3);
#undef PK4
}
template <int DQK>
__device__ __forceinline__ void qkt(f32x16& p0, f32x16& p1, const char* Ks, const bf16x8* qr, const f32x16& negm, int r32, int hi) {
  p0 = negm; p1 = negm;
  __builtin_amdgcn_s_setprio(1);
#pragma unroll
  for (int d0 = 0; d0 < DQK / 16; ++d0) { int cb = (d0 * 16 + hi * 8) * 2;
    bf16x8 b0 = *reinterpret_cast<const bf16x8*>(Ks + KSWZ(r32, cb));
    bf16x8 b1 = *reinterpret_cast<const bf16x8*>(Ks + KSWZ(32 + r32, cb));
    p0 = __builtin_amdgcn_mfma_f32_32x32x16_bf16(b0, qr[d0], p0, 0, 0, 0);
    p1 = __builtin_amdgcn_mfma_f32_32x32x16_bf16(b1, qr[d0], p1, 0, 0, 0); }
  __builtin_amdgcn_s_setprio(0);
}
__device__ __forceinline__ int v_st(int k, int c) { const int kk = (k & ~0xC) | ((k & 4) << 1) | ((k & 8) >> 1); return ((kk >> 3) * 4 + (c >> 5)) * 512 + ((kk & 7) * 32 + (c & 31)) * 2; }
__device__ __forceinline__ int v_rd_base(int lane) { return ((lane & 3) << 3) | (((lane >> 2) & 3) << 6) | (((lane >> 4) & 1) << 5) | (((lane >> 5) & 1) << 8); }
constexpr int v_rd_off(int d0, int ks, int half) { return d0 * 512 + ks * 4096 + half * 2048; }
template <int OFF> __device__ __forceinline__ s16x4 tr_read(int vb) {
  s16x4 r; asm volatile("ds_read_b64_tr_b16 %0, %1 offset:%2" : "=&v"(r) : "v"(vb), "i"(OFF) : "memory"); return r;
}
struct VFrag { s16x4 l[4], h[4]; };
template <int D0> __device__ __forceinline__ void v_reads(VFrag& f, int vb) {
  f.l[0] = tr_read<v_rd_off(D0, 0, 0)>(vb); f.h[0] = tr_read<v_rd_off(D0, 0, 1)>(vb); f.l[1] = tr_read<v_rd_off(D0, 1, 0)>(vb); f.h[1] = tr_read<v_rd_off(D0, 1, 1)>(vb);
  f.l[2] = tr_read<v_rd_off(D0, 2, 0)>(vb); f.h[2] = tr_read<v_rd_off(D0, 2, 1)>(vb); f.l[3] = tr_read<v_rd_off(D0, 3, 0)>(vb); f.h[3] = tr_read<v_rd_off(D0, 3, 1)>(vb);
}
__device__ __forceinline__ void pv_mma(f32x16* o, f32x16& lacc, VFrag& f, int vb, bf16x8 pa0, bf16x8 pa1, bf16x8 pa2, bf16x8 pa3) {
  const bf16x8 ones = {0x3F80, 0x3F80, 0x3F80, 0x3F80, 0x3F80, 0x3F80, 0x3F80, 0x3F80};
  asm volatile("s_waitcnt lgkmcnt(0)" ::: "memory"); SBAR();
#define PK(L, H) (bf16x8){L[0], L[1], L[2], L[3], H[0], H[1], H[2], H[3]}
  o[0] = __builtin_amdgcn_mfma_f32_32x32x16_bf16(pa0, PK(f.l[0], f.h[0]), o[0], 0, 0, 0);
  o[0] = __builtin_amdgcn_mfma_f32_32x32x16_bf16(pa1, PK(f.l[1], f.h[1]), o[0], 0, 0, 0);
  o[0] = __builtin_amdgcn_mfma_f32_32x32x16_bf16(pa2, PK(f.l[2], f.h[2]), o[0], 0, 0, 0);
  o[0] = __builtin_amdgcn_mfma_f32_32x32x16_bf16(pa3, PK(f.l[3], f.h[3]), o[0], 0, 0, 0);
  SBAR(); v_reads<1>(f, vb); SBAR();
  lacc = __builtin_amdgcn_mfma_f32_32x32x16_bf16(pa0, ones, lacc, 0, 0, 0);
  lacc = __builtin_amdgcn_mfma_f32_32x32x16_bf16(pa1, ones, lacc, 0, 0, 0);
  lacc = __builtin_amdgcn_mfma_f32_32x32x16_bf16(pa2, ones, lacc, 0, 0, 0);
  lacc = __builtin_amdgcn_mfma_f32_32x32x16_bf16(pa3, ones, lacc, 0, 0, 0);
  asm volatile("s_waitcnt lgkmcnt(0)" ::: "memory"); SBAR();
  o[1] = __builtin_amdgcn_mfma_f32_32x32x16_bf16(pa0, PK(f.l[0], f.h[0]), o[1], 0, 0, 0);
  o[1] = __builtin_amdgcn_mfma_f32_32x32x16_bf16(pa1, PK(f.l[1], f.h[1]), o[1], 0, 0, 0);
  o[1] = __builtin_amdgcn_mfma_f32_32x32x16_bf16(pa2, PK(f.l[2], f.h[2]), o[1], 0, 0, 0);
  o[1] = __builtin_amdgcn_mfma_f32_32x32x16_bf16(pa3, PK(f.l[3], f.h[3]), o[1], 0, 0, 0);
#undef PK
}
struct Unit {
  const unsigned short* Q; const unsigned short* K; const unsigned short* KR; const unsigned short* V; unsigned short* O;
  int ldq, ldk, NT, kstart, q0;
  float C, thr_raw, sinkl2;
};
__device__ __forceinline__ void wmask(f32x16& p0, f32x16& p1, int tilepos, int qpos, int hi) {
#pragma unroll
  for (int r = 0; r < 16; ++r) { const int k0 = tilepos + crow(r, hi); int d0 = qpos - k0; d0 = d0 < 0 ? -d0 : d0; int d1 = qpos - (k0 + 32); d1 = d1 < 0 ? -d1 : d1;
    if (d0 > 128) p0[r] = -1e30f; if (d1 > 128) p1[r] = -1e30f; }
}
template <int DQK, bool WINDOW>
__device__ __forceinline__ void attn_unit(const Unit& U, char* lds) {
  const int tid = opaque_tid(), wid = __builtin_amdgcn_readfirstlane(tid >> 6), lane = tid & 63, r32 = lane & 31, hi = lane >> 5;
  char* V_lds = lds; char* K_lds = lds + 3 * SHM_V;
  float* ws = (float*)(lds + 3 * SHM_V + 3 * SHM_K) + wid * 64; float* li_l = ws; float* al_l = ws + 32;
  const float thr = 11.5415603f;
  float m_reg = 0.f; f32x16 o[2] = {}; f32x16 lacc = {}; f32x16 negm = {}; bf16x8 qr[DQK / 16];
  const unsigned short* Qw = U.Q + (long)(wid * QBLK + r32) * U.ldq + hi * 8;
#pragma unroll
  for (int d0 = 0; d0 < DQK / 16; ++d0) qr[d0] = *reinterpret_cast<const bf16x8*>(Qw + d0 * 16);
  const int sr = tid >> 3, sc = (tid & 7) * 8, vst0 = v_st(sr, sc), kst0 = KSWZ(sr, sc * 2);
  const int srr = (tid >> 2) & 63, scr = (tid & 3) * 8, kst1 = KSWZ(srr, (64 + scr) * 2);
  const bool do_r = (DQK == 96) && (tid < 256);
  const int vb0 = (int)(uintptr_t)V_lds + v_rd_base(lane);
  const int ldk = U.ldk, kstart = U.kstart;
  const int qpos = U.q0 + wid * QBLK + r32; const int qlo = U.q0 + wid * QBLK;
  struct { bf16x8 vs, ks, rs; } sr_[3];
#define KROW(j) ((long)(64 * (j) + ((j) >= 4 ? kstart : 0)))
#define SLOAD(i, j) do { const long kr_ = KROW(j); sr_[i].vs = *reinterpret_cast<const bf16x8*>(U.V + (kr_ + sr) * ldk + sc); \
    sr_[i].ks = *reinterpret_cast<const bf16x8*>(U.K + (kr_ + sr) * ldk + sc); \
    if (DQK == 96) { if (do_r) sr_[i].rs = *reinterpret_cast<const bf16x8*>(U.KR + (kr_ + srr) * 32 + scr); } } while (0)
#define SWRITE(soff, i) do { *(bf16x8*)(V_lds + (soff) + vst0) = sr_[i].vs; *(bf16x8*)(K_lds + (soff) + kst0) = sr_[i].ks; \
    if (DQK == 96) { if (do_r) *(bf16x8*)(K_lds + (soff) + kst1) = sr_[i].rs; } } while (0)
#define RESC(a) do { if (__any((a) < 1.f)) { if (hi == 0) al_l[r32] = (a); asm volatile("s_waitcnt lgkmcnt(0)" ::: "memory"); \
    _Pragma("unroll") for (int r = 0; r < 16; ++r) { const float f_ = al_l[crow(r, hi)]; o[0][r] *= f_; o[1][r] *= f_; lacc[r] *= f_; } } } while (0)
#define WMASK(P0, P1, j) do { if (WINDOW) { if ((j) >= 4) wmask(P0, P1, kstart + 64 * ((j) - 4), qpos, hi); } } while (0)
#define QKM(P0, P1, KP, j, SK) do { SK = false; \
    if (WINDOW && (j) >= 4) { const int tp_ = kstart + 64 * ((j) - 4); \
      if (tp_ + 63 < qlo - 128 || tp_ > qlo + 31 + 128) { SK = true; _Pragma("unroll") for (int r_ = 0; r_ < 16; ++r_) { P0[r_] = 0.f; P1[r_] = 0.f; } } \
      else { qkt<DQK>(P0, P1, KP, qr, negm, r32, hi); if (!(tp_ >= qlo + 31 - 128 && tp_ + 63 <= qlo + 128)) wmask(P0, P1, tp_, qpos, hi); } } \
    else qkt<DQK>(P0, P1, KP, qr, negm, r32, hi); } while (0)
#define LIVE(SK) (!(WINDOW && (SK)))
#define ROT() do { const int t_ = s_prev; s_prev = s_cur; s_cur = s_next; s_next = t_; } while (0)
  static_assert(SHM_V == SHM_K, "one slot offset serves both rings");
  f32x16 pA0, pA1, pB0, pB1; float alA, alB; bool skA = false, skB = false; bf16x8 pa0, pa1, pa2, pa3; const int NT = U.NT; VFrag vf;
  int s_prev = 2 * SHM_V, s_cur = 0, s_next = SHM_V;
  SLOAD(1, 0); SLOAD(2, 1); if (2 < NT) SLOAD(0, 2);
  SWRITE(0, 1); SWRITE(SHM_V, 2);
  __syncthreads();
  qkt<DQK>(pA0, pA1, K_lds, qr, negm, r32, hi); partialSM<true>(pA0, pA1, m_reg, negm, alA, thr);
  ROT();
  for (int j = 1; j + 1 < NT; j += 2) {
    SWRITE(s_next, 0); if (j + 2 < NT) SLOAD(0, j + 2);
    SBAR(); QKM(pB0, pB1, K_lds + s_cur, j, skB);
    if (LIVE(skA)) { v_reads<0>(vf, vb0 + s_prev); finishSM(pA0, pA1, pa0, pa1, pa2, pa3); pv_mma(o, lacc, vf, vb0 + s_prev, pa0, pa1, pa2, pa3); }
    if (LIVE(skB)) partialSM<false>(pB0, pB1, m_reg, negm, alB, thr); else alB = 1.f;
    __syncthreads(); RESC(alB); ROT();
    if (j + 2 < NT) SWRITE(s_next, 0); if (j + 3 < NT) SLOAD(0, j + 3);
    SBAR(); QKM(pA0, pA1, K_lds + s_cur, j + 1, skA);
    if (LIVE(skB)) { v_reads<0>(vf, vb0 + s_prev); finishSM(pB0, pB1, pa0, pa1, pa2, pa3); pv_mma(o, lacc, vf, vb0 + s_prev, pa0, pa1, pa2, pa3); }
    if (LIVE(skA)) partialSM<false>(pA0, pA1, m_reg, negm, alA, thr); else alA = 1.f;
    __syncthreads(); RESC(alA); ROT();
  }
  SBAR(); QKM(pB0, pB1, K_lds + s_cur, NT - 1, skB);
  if (LIVE(skA)) { v_reads<0>(vf, vb0 + s_prev); finishSM(pA0, pA1, pa0, pa1, pa2, pa3); pv_mma(o, lacc, vf, vb0 + s_prev, pa0, pa1, pa2, pa3); }
  if (LIVE(skB)) {
    partialSM<false>(pB0, pB1, m_reg, negm, alB, thr);
    RESC(alB);
    SBAR(); v_reads<0>(vf, vb0 + s_cur); SBAR();
    finishSM(pB0, pB1, pa0, pa1, pa2, pa3);
    pv_mma(o, lacc, vf, vb0 + s_cur, pa0, pa1, pa2, pa3);
  }
  if (hi == 0) li_l[r32] = __builtin_amdgcn_exp2f(fmaxf(U.sinkl2 - m_reg, -126.f));
  asm volatile("s_waitcnt lgkmcnt(0)" ::: "memory");
  float rli[16];
#pragma unroll
  for (int r = 0; r < 16; ++r) rli[r] = __builtin_amdgcn_rcpf(lacc[r] + li_l[crow(r, hi)]);
  unsigned short* Ow = U.O + (long)(wid * QBLK) * 1024;
#pragma unroll
  for (int r = 0; r < 16; ++r) { const int orow = crow(r, hi);
#pragma unroll
    for (int d0 = 0; d0 < 2; ++d0) { const float lo = o[d0][r] * rli[r]; const unsigned pk = cvtpk(lo, lo); Ow[(long)orow * 1024 + d0 * 32 + r32] = (unsigned short)(pk & 0xffffu); } }
  __syncthreads();
#undef KROW
#undef SLOAD
#undef SWRITE
#undef RESC
#undef WMASK
#undef QKM
#undef LIVE
#undef ROT
}
#undef SBAR
}
constexpr int DM = 1024, NP_ROWS = 4096, NS_ROWS = 16384, M_ROWS = 20480, EXT_ROWS = 21504, EXT_B = 4352, DFF = 4096;
constexpr float EPS_ = 1e-6f;
constexpr float LOG2_THETA = 13.287712379549449f;
constexpr float INV_2PI = 0.15915494309189535f;
typedef unsigned short bfu;
typedef float f32x4 __attribute__((ext_vector_type(4)));
typedef unsigned u32x4 __attribute__((ext_vector_type(4)));
typedef unsigned u32x2 __attribute__((ext_vector_type(2)));
__device__ __forceinline__ unsigned pkbf(float lo, float hi) { return pg8::cvt_pk_bf16(lo, hi); }
__device__ __forceinline__ void rope_cs(int pos, int i, float inv_den, float& c, float& s) {
    const float f = __builtin_amdgcn_exp2f(-(float)i * (LOG2_THETA * inv_den));
    const float rev = (float)pos * f * INV_2PI;
    c = __builtin_amdgcn_cosf(rev); s = __builtin_amdgcn_sinf(rev);
}
__device__ __forceinline__ int cond_of_row(int row) { return row < NP_ROWS ? 4 : ((row - NP_ROWS) >> 12); }
__device__ __forceinline__ int ext_of_row(int row) { return row < NP_ROWS ? row : (NP_ROWS + ((row - NP_ROWS) >> 12) * EXT_B + 256 + ((row - NP_ROWS) & 4095)); }

#define EPI_FENCE() asm volatile("" ::: "memory")
template <bool NORMC> struct EpiQKV {
    static constexpr bool PERM = false, AFTER_DRAIN = false;
    bfu* Q; bfu* Kb; bfu* Vb; float* stK; float* stV; const float* gq; const float* gk; int nstate;
    __device__ __forceinline__ void operator()(const f32x4 (&acc)[2][2][4][2], const pg8::Unit& u, int wr, int wc, int fr, int fq) const {
        asm volatile("" : "+v"(fr), "+v"(fq));
        const int pn = u.pn; const bool isQ = pn < 4, isK = pn == 4; const bool sample = u.pm >= 16;
        const bool dorope = sample && pn < 5;
        float frq[4];
#pragma unroll
        for (int j = 0; j < 4; ++j) frq[j] = __builtin_amdgcn_exp2f(-(float)(4 * fq + j) * (LOG2_THETA / 16.0f)) * INV_2PI;
        const unsigned cq = 64 * wc + 4 * fq;
#pragma unroll
        for (int ai = 0; ai < 2; ++ai)
#pragma unroll
            for (int m = 0; m < 4; ++m) {
                unsigned row = u.pm * 256 + ai * 128 + wr * 64 + m * 16 + fr; asm volatile("" : "+v"(row));
                f32x4 v[2][2];
#pragma unroll
                for (int bj = 0; bj < 2; ++bj)
#pragma unroll
                    for (int n = 0; n < 2; ++n) v[bj][n] = acc[ai][bj][m][n];
                if (NORMC && pn < 5) {
                    float ss = 0.f;
#pragma unroll
                    for (int bj = 0; bj < 2; ++bj)
#pragma unroll
                        for (int n = 0; n < 2; ++n) ss += (v[bj][n][0] * v[bj][n][0] + v[bj][n][1] * v[bj][n][1]) + (v[bj][n][2] * v[bj][n][2] + v[bj][n][3] * v[bj][n][3]);
                    ss += __shfl_xor(ss, 16); ss += __shfl_xor(ss, 32);
                    const float rstd = 1.0f / sqrtf(ss * (1.0f / 64.0f) + EPS_);
                    const float* g = (isQ ? gq : gk) + 4 * fq;
#pragma unroll
                    for (int bj = 0; bj < 2; ++bj)
#pragma unroll
                        for (int n = 0; n < 2; ++n) { const f32x4 gv = *(const f32x4*)(g + 32 * bj + 16 * n); v[bj][n] = v[bj][n] * rstd * gv; }
                }
                const unsigned t = (row - NP_ROWS) & 4095u;
                if (dorope) {
#pragma unroll
                    for (int bj = 0; bj < 2; ++bj) { const float pos = (float)(bj == 0 ? (t >> 6) : (t & 63u));
#pragma unroll
                        for (int j = 0; j < 4; ++j) { const float rev = pos * frq[j]; const float c = __builtin_amdgcn_cosf(rev), s = __builtin_amdgcn_sinf(rev); const float x1 = v[bj][0][j], x2 = v[bj][1][j];
                            v[bj][0][j] = x1 * c - x2 * s; v[bj][1][j] = x1 * s + x2 * c; } }
                }
                if (isQ) { bfu* p = Q + (row * 1024u + 256u * pn + cq);
#pragma unroll
                    for (int bj = 0; bj < 2; ++bj)
#pragma unroll
                        for (int n = 0; n < 2; ++n) { const f32x4 x = v[bj][n] * (0.125f * 1.4426950408889634f);     u32x2 w; w.x = pkbf(x[0], x[1]); w.y = pkbf(x[2], x[3]); *(u32x2*)(p + 32 * bj + 16 * n) = w; }
                } else {
                    const unsigned e = sample ? (NP_ROWS + ((row - NP_ROWS) >> 12) * EXT_B + 256u + t) : row;
                    bfu* p = (isK ? Kb : Vb) + (e * 256u + cq);
#pragma unroll
                    for (int bj = 0; bj < 2; ++bj)
#pragma unroll
                        for (int n = 0; n < 2; ++n) { const f32x4 x = v[bj][n]; u32x2 w; w.x = pkbf(x[0], x[1]); w.y = pkbf(x[2], x[3]); *(u32x2*)(p + 32 * bj + 16 * n) = w; }
                    if (!sample) { float* st = (isK ? stK : stV) + ((((row >> 8) * nstate) * 256u + (row & 255u)) * 256u + cq);
#pragma unroll
                        for (int bj = 0; bj < 2; ++bj)
#pragma unroll
                            for (int n = 0; n < 2; ++n) *(f32x4*)(st + 32 * bj + 16 * n) = v[bj][n]; }
                }
                EPI_FENCE();
            }
    }
};
struct EpiResid {
    static constexpr bool PERM = true, AFTER_DRAIN = false;
    float* x; const float* gate; bfu* P;
    __device__ __forceinline__ void operator()(const f32x4 (&acc)[2][2][4][2], const pg8::Unit& u, int wr, int wc, int fr, int fq) const {
        asm volatile("" : "+v"(fr), "+v"(fq));
        const int cond = cond_of_row(u.pm * 256); const unsigned c0 = u.pn * 256 + wc * 32 + 8 * fq; const float* g = gate + cond * 6144 + c0;
#pragma unroll
        for (int ai = 0; ai < 2; ++ai)
#pragma unroll
            for (int m = 0; m < 4; ++m) { const unsigned row = u.pm * 256 + ai * 128 + wr * 64 + m * 16 + fr; const unsigned off = row * 1024u + c0;
#pragma unroll
                for (int bj = 0; bj < 2; ++bj) { const f32x4 g0 = *(const f32x4*)(g + bj * 128), g1 = *(const f32x4*)(g + bj * 128 + 4);
                    const f32x4 y0 = g0 * acc[ai][bj][m][0], y1 = g1 * acc[ai][bj][m][1]; const unsigned o2 = off + bj * 128;
                    if (u.split) { u32x4 w; w.x = pkbf(y0[0], y0[1]); w.y = pkbf(y0[2], y0[3]); w.z = pkbf(y1[0], y1[1]); w.w = pkbf(y1[2], y1[3]); *(u32x4*)(P + ((size_t)(u.split - 1) * 4096 * 1024 + o2)) = w; }
                    else { const f32x4 b0 = *(const f32x4*)(x + o2), b1 = *(const f32x4*)(x + o2 + 4); *(f32x4*)(x + o2) = b0 + y0; *(f32x4*)(x + o2 + 4) = b1 + y1; } }
                EPI_FENCE(); }
    }
};
struct EpiSqRelu {
    static constexpr bool PERM = true, AFTER_DRAIN = false;
    bfu* O; int ldc;
    __device__ __forceinline__ void operator()(const f32x4 (&acc)[2][2][4][2], const pg8::Unit& u, int wr, int wc, int fr, int fq) const {
        asm volatile("" : "+v"(fr), "+v"(fq));
#pragma unroll
        for (int ai = 0; ai < 2; ++ai)
#pragma unroll
            for (int m = 0; m < 4; ++m) { const unsigned row = u.pm * 256 + ai * 128 + wr * 64 + m * 16 + fr; bfu* p = O + ((size_t)row * ldc + u.pn * 256 + wc * 32 + 8 * fq);
#pragma unroll
                for (int bj = 0; bj < 2; ++bj) { f32x4 v0 = acc[ai][bj][m][0], v1 = acc[ai][bj][m][1];
#pragma unroll
                    for (int j = 0; j < 4; ++j) { const float a = fmaxf(v0[j], 0.f), b = fmaxf(v1[j], 0.f); v0[j] = a * a; v1[j] = b * b; }
                    u32x4 w; w.x = pkbf(v0[0], v0[1]); w.y = pkbf(v0[2], v0[3]); w.z = pkbf(v1[0], v1[1]); w.w = pkbf(v1[2], v1[3]);
                    *(u32x4*)(p + bj * 128) = w; }
                EPI_FENCE(); }
    }
};
struct EpiUKV {
    static constexpr bool PERM = true, AFTER_DRAIN = false;
    bfu* Kn; bfu* Vb;
    __device__ __forceinline__ void operator()(const f32x4 (&acc)[2][2][4][2], const pg8::Unit& u, int wr, int wc, int fr, int fq) const {
        asm volatile("" : "+v"(fr), "+v"(fq));
        bfu* base = (wc < 2 ? Kn : Vb) + (2 * u.pn * 64 + 32 * (wc & 1) + 8 * fq);
#pragma unroll
        for (int ai = 0; ai < 2; ++ai)
#pragma unroll
            for (int m = 0; m < 4; ++m) { const unsigned row = u.pm * 256 + ai * 128 + wr * 64 + m * 16 + fr; bfu* p = base + row * 1024u;
#pragma unroll
                for (int bj = 0; bj < 2; ++bj) { const f32x4 v0 = acc[ai][bj][m][0], v1 = acc[ai][bj][m][1];
                    u32x4 w; w.x = pkbf(v0[0], v0[1]); w.y = pkbf(v0[2], v0[3]); w.z = pkbf(v1[0], v1[1]); w.w = pkbf(v1[2], v1[3]);
                    *(u32x4*)(p + bj * 64) = w; }
                EPI_FENCE(); }
    }
};
struct EpiF32 {
    static constexpr bool PERM = false, AFTER_DRAIN = false;
    float* T; int ldc;
    __device__ __forceinline__ void operator()(const f32x4 (&acc)[2][2][4][2], const pg8::Unit& u, int wr, int wc, int fr, int fq) const {
        asm volatile("" : "+v"(fr), "+v"(fq));
#pragma unroll
        for (int ai = 0; ai < 2; ++ai)
#pragma unroll
            for (int m = 0; m < 4; ++m) { const unsigned row = u.pm * 256 + ai * 128 + wr * 64 + m * 16 + fr; float* p = T + ((size_t)row * ldc + u.pn * 256 + wc * 32 + 4 * fq);
#pragma unroll
                for (int bj = 0; bj < 2; ++bj)
#pragma unroll
                    for (int n = 0; n < 2; ++n) *(f32x4*)(p + bj * 128 + n * 16) = acc[ai][bj][m][n];
                EPI_FENCE(); }
    }
};
struct EpiUQ {
    static constexpr bool PERM = false, AFTER_DRAIN = false;
    bfu* Q;
    __device__ __forceinline__ void operator()(const f32x4 (&acc)[2][2][4][2], const pg8::Unit& u, int wr, int wc, int fr, int fq) const {
        asm volatile("" : "+v"(fr), "+v"(fq));
        const bool sample = u.pm >= 16;
        float frq[4];
#pragma unroll
        for (int j = 0; j < 4; ++j) frq[j] = __builtin_amdgcn_exp2f(-(float)(4 * (fq & 1) + j) * (LOG2_THETA / 8.0f)) * INV_2PI;
        const bool lowhalf = fq < 2;
#pragma unroll
        for (int ai = 0; ai < 2; ++ai)
#pragma unroll
            for (int m = 0; m < 4; ++m) { unsigned row = u.pm * 256 + ai * 128 + wr * 64 + m * 16 + fr; asm volatile("" : "+v"(row)); const unsigned t = (row - NP_ROWS) & 4095u;
                bfu* p = Q + (row * 1536u + u.pn * 256 + wc * 32 + 4 * fq);
#pragma unroll
                for (int bj = 0; bj < 2; ++bj) {
                    const int g32 = (u.pn * 256 + bj * 128 + wc * 32) >> 5; const bool ropeg = (g32 % 3) == 2;
#pragma unroll
                    for (int n = 0; n < 2; ++n) { f32x4 v = acc[ai][bj][m][n];
                        if (sample && ropeg) { const float pos = (float)(n == 0 ? (t >> 6) : (t & 63u));
#pragma unroll
                            for (int j = 0; j < 4; ++j) { const float other = __shfl_xor(v[j], 32); const float rev = pos * frq[j]; const float c = __builtin_amdgcn_cosf(rev), s = __builtin_amdgcn_sinf(rev);
                                v[j] = lowhalf ? (v[j] * c - other * s) : (other * s + v[j] * c); } }
                        v = v * (0.10206207261596577f * 1.4426950408889634f);
                        u32x2 w; w.x = pkbf(v[0], v[1]); w.y = pkbf(v[2], v[3]);
                        *(u32x2*)(p + bj * 128 + n * 16) = w; } }
                EPI_FENCE(); }
    }
};
#define XB_TMO      128
#define XB_XCNT(j)  (256  + 64 * (j))
#define XB_XSUB(j)  (1280 + 64 * (j))
#define XB_XGEN(j)  (2304 + 64 * (j))
#define XB_TOP      3328
#define XB_TOPGEN   3392
#define XCD_BAR_WORDS 3456
#define XB_SPIN_CAP (1u << 18)

__device__ __forceinline__ unsigned xb_ld(unsigned* p)              { return __hip_atomic_load(p, __ATOMIC_RELAXED, __HIP_MEMORY_SCOPE_AGENT); }
__device__ __forceinline__ unsigned xb_add(unsigned* p, unsigned v) { return __hip_atomic_fetch_add(p, v, __ATOMIC_RELAXED, __HIP_MEMORY_SCOPE_AGENT); }
__device__ __forceinline__ unsigned xb_xcc_id() { return (unsigned)__builtin_amdgcn_s_getreg((3 << 11) | 20) & 0xFu; }
#define XB_SPIN(cond, bar) do { unsigned _sp = 0; while (cond) { __builtin_amdgcn_s_sleep(1); \
    if ((++_sp & 255u) == 0u) { if (xb_ld(&(bar)[XB_TMO])) break; if (_sp > XB_SPIN_CAP) { atomicAdd(&(bar)[XB_TMO], 1u); break; } } } } while (0)

struct XcdBarrier {
    unsigned* bar; unsigned x;
    volatile LAS unsigned* st;
};

__device__ __forceinline__ XcdBarrier xcd_barrier_post(unsigned* bar, volatile LAS unsigned* st) {
    XcdBarrier b; b.bar = bar; b.x = xb_xcc_id(); b.st = st;
    if (threadIdx.x == 0) (void)xb_add(&bar[XB_XCNT(b.x)], 1u);
    return b;
}
__device__ __forceinline__ void xcd_barrier_complete(unsigned* bar, unsigned x, unsigned& nloc, unsigned& nx) {
    const unsigned G = gridDim.x * gridDim.y * gridDim.z;
    unsigned sum, cnt, mine, sp = 0u;
    for (;;) {
        sum = 0u; cnt = 0u; mine = 0u;
#pragma unroll
        for (unsigned j = 0; j < 16; ++j) { const unsigned c = xb_ld(&bar[XB_XCNT(j)]); sum += c; cnt += (c > 0u) ? 1u : 0u; mine = (j == x) ? c : mine; }
        if (sum == G) break;
        __builtin_amdgcn_s_sleep(1);
        if ((++sp & 255u) == 0u) { if (xb_ld(&bar[XB_TMO])) break; if (sp > XB_SPIN_CAP) { atomicAdd(&bar[XB_TMO], 1u); break; } }
    }
    nloc = mine > 0u ? mine : 1u; nx = cnt > 0u ? cnt : 1u;
}

__device__ __forceinline__ void xcd_barrier(const XcdBarrier& b) {
    asm volatile("s_waitcnt vmcnt(0)" ::: "memory");
    __syncthreads();
    if (threadIdx.x == 0) {
        unsigned* bar = b.bar;
        __builtin_amdgcn_s_waitcnt(0);
        unsigned nloc = b.st[0], nx = b.st[1];
        if (nloc == 0u) { xcd_barrier_complete(bar, b.x, nloc, nx); b.st[0] = nloc; b.st[1] = nx; }
        const unsigned old = xb_add(&bar[XB_XSUB(b.x)], 1u);
        const unsigned gen = old / nloc;
        if (old + 1u == (gen + 1u) * nloc) {
            __builtin_amdgcn_fence(__ATOMIC_RELEASE, "agent");
            asm volatile("s_waitcnt vmcnt(0)" ::: "memory");
            const unsigned og = xb_add(&bar[XB_TOP], 1u);
            const unsigned tg = og / nx;
            if (og + 1u == (tg + 1u) * nx) xb_add(&bar[XB_TOPGEN], 1u);
            else XB_SPIN(xb_ld(&bar[XB_TOPGEN]) == tg, bar);
            __builtin_amdgcn_fence(__ATOMIC_ACQUIRE, "agent");
            xb_add(&bar[XB_XGEN(b.x)], 1u);
            asm volatile("s_waitcnt vmcnt(0)" ::: "memory");
        } else {
            XB_SPIN(xb_ld(&bar[XB_XGEN(b.x)]) == gen, bar);
            __builtin_amdgcn_fence(__ATOMIC_ACQUIRE, "agent");
            asm volatile("s_waitcnt vmcnt(0)" ::: "memory");
        }
    }
    __syncthreads();
}

constexpr size_t MiB = 1u << 20;
constexpr size_t WT_MLP_IN = 0;
constexpr size_t WT_MLP_OUT = 4 * (size_t)DM * DFF;
constexpr size_t WT_A_QKV = 8 * (size_t)DM * DFF;
constexpr size_t WT_A_O = WT_A_QKV + 2 * 1536 * 1024;
constexpr size_t WT_C_QKV = WT_A_O + 2 * 1024 * 1024;
constexpr size_t WT_C_O = WT_C_QKV + 1536 * 1024;
constexpr size_t WT_B_DQKV = WT_C_O + 1024 * 1024;
constexpr size_t WT_B_UQ = WT_B_DQKV + 768 * 1024;
constexpr size_t WT_B_UKV = WT_B_UQ + 1536 * 384;
constexpr size_t WT_B_O = WT_B_UKV + 2048 * 256;
constexpr size_t WT_END = WT_B_O + 1024 * 1024;
static_assert(WT_END * 2 <= 88 * MiB, "WT region");
constexpr size_t WS_WT = 0, WS_MODS = 88 * MiB, WS_KR = 89 * MiB, WS_CKVN = 91 * MiB, WS_DQN = 102 * MiB, WS_H = 117 * MiB, WS_R1 = 157 * MiB;
constexpr size_t WS_Q = WS_R1, WS_K = WS_R1 + 60 * MiB, WS_V = WS_K + 42 * MiB, WS_T = WS_R1, WS_HID = WS_R1, WS_CTL = WS_R1 + 160 * MiB, WS_P = WS_CTL + 1 * MiB, WS_END = WS_P + 64 * MiB;

#define GAS1 __attribute__((address_space(1)))
struct Args { const GAS1 float* in[30]; GAS1 float* out; GAS1 unsigned char* ws; int ph_lo, ph_hi; };
struct ArgsH { const float* in[30]; float* out; unsigned char* ws; int ph_lo, ph_hi; };
static_assert(sizeof(Args) == sizeof(ArgsH), "Args layout");

__device__ __forceinline__ float wave_sum(float v) {
#pragma unroll
    for (int o = 1; o < 64; o <<= 1) v += __shfl_xor(v, o);
    return v;
}
template <int MAP>
__device__ __forceinline__ void transpose_item(const float* W, int K, int N, bfu* WT, int row_off, LAS float* scr, int item, int lane) {
    const int nblk = N / 32, kb = item / nblk, nb = item % nblk, k0 = 64 * kb, n0 = 32 * nb;
#pragma unroll 8
    for (int i = 0; i < 32; ++i) { const int kk = 2 * i + (lane >> 5); scr[kk * 33 + (lane & 31)] = W[(size_t)(k0 + kk) * N + n0 + (lane & 31)]; }
    asm volatile("s_waitcnt lgkmcnt(0)" ::: "memory");
    const int c = lane & 7;
#pragma unroll
    for (int j = 0; j < 4; ++j) { const int n = (lane >> 3) + 8 * j; const LAS float* s = scr + (8 * c) * 33 + n;
        u32x4 o; o.x = pkbf(s[0 * 33], s[1 * 33]); o.y = pkbf(s[2 * 33], s[3 * 33]); o.z = pkbf(s[4 * 33], s[5 * 33]); o.w = pkbf(s[6 * 33], s[7 * 33]);
        int src = n0 + n, dst;
        if (MAP == 1) { const int tile = src >> 8, loc = src & 255, hl = loc >> 6, d = loc & 63; dst = tile * 256 + (d >> 5) * 128 + hl * 32 + (d & 31); } else dst = row_off + src;
        *(u32x4*)(WT + (size_t)dst * K + k0 + 8 * c) = o; }
    asm volatile("s_waitcnt lgkmcnt(0)" ::: "memory");
}
__device__ __forceinline__ void norm_row(float* xrow, const bfu* prow, const float* g, const float* shift, const float* scale, bfu* orow, int lane) {
    f32x4 v[4]; float s = 0.f;
#pragma unroll
    for (int j = 0; j < 4; ++j) { v[j] = *((const f32x4*)xrow + lane + 64 * j);
        if (prow) { const u32x2* pp = (const u32x2*)prow + lane + 64 * j;
#pragma unroll
            for (int q = 0; q < 4; ++q) { const u32x2 w = pp[(size_t)q * 1048576]; v[j][0] += __uint_as_float(w.x << 16); v[j][1] += __uint_as_float(w.x & 0xffff0000u); v[j][2] += __uint_as_float(w.y << 16); v[j][3] += __uint_as_float(w.y & 0xffff0000u); }
            *((f32x4*)xrow + lane + 64 * j) = v[j]; } s += (v[j][0] * v[j][0] + v[j][1] * v[j][1]) + (v[j][2] * v[j][2] + v[j][3] * v[j][3]); }
    const float rstd = 1.0f / sqrtf(wave_sum(s) * (1.0f / 1024.0f) + EPS_);
#pragma unroll
    for (int j = 0; j < 4; ++j) { const int c = 4 * lane + 256 * j; const f32x4 gv = *(const f32x4*)(g + c), sh = *(const f32x4*)(shift + c), sc = *(const f32x4*)(scale + c);
        const f32x4 y = v[j] * rstd * gv * (sc + 1.0f) + sh; u32x2 w; w.x = pkbf(y[0], y[1]); w.y = pkbf(y[2], y[3]); *((u32x2*)orow + lane + 64 * j) = w; }
}
__device__ __forceinline__ void cvt_rows(const float* src, size_t src_stride, bfu* dst, size_t dst_stride, int nrows, int ncols, int gtid, int gthreads) {
    const int cpr = ncols / 8;
    for (long i = gtid; i < (long)nrows * cpr; i += gthreads) { const int r = (int)(i / cpr), c = (int)(i % cpr) * 8;
        const f32x4 a = *(const f32x4*)(src + (size_t)r * src_stride + c), b = *(const f32x4*)(src + (size_t)r * src_stride + c + 4);
        u32x4 w; w.x = pkbf(a[0], a[1]); w.y = pkbf(a[2], a[3]); w.z = pkbf(b[0], b[1]); w.w = pkbf(b[2], b[3]); *(u32x4*)(dst + (size_t)r * dst_stride + c) = w; }
}

#ifndef G_ALIGN
#define G_ALIGN true
#endif
#ifndef G_SP2
#define G_SP2 true
#endif
#ifndef QKV_SP2
#define QKV_SP2 true
#endif
struct LdsOrder {
    const LAS int* ul;
    __device__ __forceinline__ bool next(int i, pg8::Unit& u) const {
        if (i >= 16) return false;
        const LAS int* p = ul + i * 8;
        const int ok = __builtin_amdgcn_readfirstlane(p[0]); if (!ok) return false;
        u.pm = __builtin_amdgcn_readfirstlane(p[1]); u.pn = __builtin_amdgcn_readfirstlane(p[2]); u.kt0 = __builtin_amdgcn_readfirstlane(p[3]);
        u.nt = __builtin_amdgcn_readfirstlane(p[4]); u.split = __builtin_amdgcn_readfirstlane(p[5]); return true;
    }
    __device__ __forceinline__ void a_ready(const pg8::Unit&) const {}
    __device__ __forceinline__ void done(const pg8::Unit&) const {}
};
constexpr int LDS_UNITS = 131072;
template <class Epi, bool SP2 = G_SP2, bool SPLIT = false>
__device__ __forceinline__ void run_gemm(LAS unsigned char* lds, const bfu* A, const bfu* Bt, int M, int N, int K, const Epi& E) {
    int Kv = K; asm volatile("" : "+s"(Kv));
    LAS int* ul = (LAS int*)(lds + LDS_UNITS);
    { const int t = opaque_tid();
      if (t < 16) { int G_ = gridDim.x, bx_ = blockIdx.x; pg8::StaticOrder S; S.init(M, N, G_, bx_, Kv / 64, SPLIT); const pg8::Unit u = S.get(t);
          ul[t * 8 + 0] = u.nt > 0 ? 1 : 0; ul[t * 8 + 1] = u.pm; ul[t * 8 + 2] = u.pn; ul[t * 8 + 3] = u.kt0; ul[t * 8 + 4] = u.nt; ul[t * 8 + 5] = u.split; }
      __syncthreads(); }
    pg8::Gemm g{A, Bt, M, N, Kv}; LdsOrder S{ul};
    pg8::gemm_phase<Epi, LdsOrder, G_ALIGN, SP2>(lds, g, S, E);
    __syncthreads();
}

constexpr int LDS_BYTES = 147456, LDS_MISC = 147456 - 64;
constexpr int N_PHASES = 32;
#ifndef REP_ATT
#define REP_ATT 1
#endif
#ifndef REP_UP
#define REP_UP 1
#endif
#ifndef REP_RES
#define REP_RES 1
#endif
#ifndef REP_NORM
#define REP_NORM 1
#endif
#ifndef REP_P0
#define REP_P0 1
#endif
#ifndef PH_MASK
#define PH_MASK 0xffff
#endif
#define EN(k) (((PH_MASK) >> (k)) & 1)

typedef const __attribute__((address_space(4))) Args* KArgsP;
__device__ __forceinline__ KArgsP ka() { KArgsP p = (KArgsP)__builtin_amdgcn_kernarg_segment_ptr(); asm volatile("" : "+s"(p)); return p; }
__global__ void __launch_bounds__(512, 2) mega_fwd(Args args) {
    extern __shared__ __attribute__((aligned(16))) unsigned char lds[];
    cg::grid_group grid = cg::this_grid();
    const int lo = args.ph_lo, hi = args.ph_hi; int ph = 0;
    XcdBarrier xbar; xbar.bar = nullptr; xbar.x = 0; xbar.st = nullptr;
    if (hi - lo > 1) {
        volatile LAS unsigned* misc = (volatile LAS unsigned*)((LAS unsigned char*)lds + LDS_MISC);
        if (threadIdx.x < 16) misc[threadIdx.x] = 0u;
        __syncthreads();
        xbar = xcd_barrier_post((unsigned*)((unsigned char*)args.ws + WS_CTL), misc + 8);
    }
#define INP(i) ((const float*)A->in[i])
#define PHASE_LOCALS KArgsP A = ka(); const int tid = opaque_tid(), lane = tid & 63, wave = __builtin_amdgcn_readfirstlane(tid >> 6); \
    int G = gridDim.x, bx = blockIdx.x; asm volatile("" : "+s"(G), "+s"(bx)); const int vcu = (G % 8 == 0) ? (bx % 8) * (G / 8) + bx / 8 : bx; \
    const int gw = bx * 8 + wave, NGW = G * 8, gtid = bx * 512 + tid, GT = G * 512; (void)lane; (void)vcu; (void)gw; (void)NGW; (void)gtid; (void)GT; \
    LAS unsigned char* const ldsl = (LAS unsigned char*)lds; (void)ldsl; unsigned char* const ws = (unsigned char*)A->ws; float* const X = (float*)A->out; \
    bfu* const WT = (bfu*)(ws + WS_WT); float* const mods = (float*)(ws + WS_MODS); bfu* const KR = (bfu*)(ws + WS_KR); bfu* const CKVN = (bfu*)(ws + WS_CKVN); bfu* const DQN = (bfu*)(ws + WS_DQN); \
    bfu* const HB = (bfu*)(ws + WS_H); bfu* const QB = (bfu*)(ws + WS_Q); bfu* const KB = (bfu*)(ws + WS_K); bfu* const VB = (bfu*)(ws + WS_V); float* const TB = (float*)(ws + WS_T); bfu* const HID = (bfu*)(ws + WS_HID); \
    float* const st_a_k = X + 20971520; float* const st_a_v = X + 23068672; float* const st_b_ckv = X + 25165824; float* const st_b_kr = X + 26214400; float* const st_c_k = X + 26345472; float* const st_c_v = X + 27394048; \
    const float* const modl = mods + (size_t)layer * 5 * 6144; const float* const ng = INP(12) + (size_t)layer * 2 * 1024; \
    (void)WT; (void)KR; (void)CKVN; (void)DQN; (void)HB; (void)QB; (void)KB; (void)VB; (void)TB; (void)HID; (void)st_a_k; (void)st_a_v; (void)st_b_ckv; (void)st_b_kr; (void)st_c_k; (void)st_c_v; (void)modl; (void)ng;
#define PH_BEGIN if (ph >= lo && ph < hi) { PHASE_LOCALS
#ifndef REP_SYNC
#define REP_SYNC 1
#endif
#define PH_END if (ph + 1 < hi) { for (int rs_ = 0; rs_ < REP_SYNC; ++rs_) { if (ph == 0) grid.sync(); else xcd_barrier(xbar); } } } ++ph;

    { const int layer = 0;
    PH_BEGIN
    if constexpr (EN(0)) for (int rep_ = 0; rep_ < REP_P0; ++rep_) {
        if (rep_) __syncthreads();
        LAS float* scr = (LAS float*)(ldsl + wave * 16384);
        for (int seg = 0; seg < 20; ++seg) {
            const float* W; int K, N, map = 0, roff = 0; size_t dsto;
            if (seg < 4)       { W = INP(13) + (size_t)seg * DM * DFF; K = DM; N = DFF; dsto = WT_MLP_IN + (size_t)seg * DM * DFF; }
            else if (seg < 8)  { W = INP(14) + (size_t)(seg - 4) * DM * DFF; K = DFF; N = DM; dsto = WT_MLP_OUT + (size_t)(seg - 4) * DM * DFF; }
            else if (seg < 10) { W = INP(15) + (size_t)(seg - 8) * 1024 * 1536; K = 1024; N = 1536; dsto = WT_A_QKV + (size_t)(seg - 8) * 1536 * 1024; map = 1; }
            else if (seg < 12) { W = INP(17) + (size_t)(seg - 10) * 1024 * 1024; K = 1024; N = 1024; dsto = WT_A_O + (size_t)(seg - 10) * 1024 * 1024; }
            else if (seg == 12) { W = INP(25); K = 1024; N = 1536; dsto = WT_C_QKV; map = 1; }
            else if (seg == 13) { W = INP(28); K = 1024; N = 1024; dsto = WT_C_O; }
            else if (seg == 14) { W = INP(18); K = 1024; N = 384; dsto = WT_B_DQKV; }
            else if (seg == 15) { W = INP(21); K = 1024; N = 288; dsto = WT_B_DQKV; roff = 384; }
            else if (seg == 16) { W = INP(20); K = 384; N = 1536; dsto = WT_B_UQ; }
            else if (seg == 17) { W = INP(23); K = 256; N = 2048; dsto = WT_B_UKV; }
            else if (seg == 18) { W = INP(24); K = 1024; N = 1024; dsto = WT_B_O; }
            else break;
            const int nitems = (K / 64) * (N / 32);
            if (map == 1) { for (int it = gw; it < nitems; it += NGW) transpose_item<1>(W, K, N, WT + dsto, 0, scr, it, lane); }
            else          { for (int it = gw; it < nitems; it += NGW) transpose_item<0>(W, K, N, WT + dsto, roff, scr, it, lane); }
        }
        for (int i = gtid; i < 96 * 1024 / 8; i += GT) *(u32x4*)(WT + WT_B_DQKV + (size_t)672 * 1024 + (size_t)i * 8) = (u32x4){0u, 0u, 0u, 0u};
        { const f32x4* s0 = (const f32x4*)INP(0); const f32x4* s1 = (const f32x4*)INP(1); f32x4* d = (f32x4*)X;
          for (long i = gtid; i < (long)M_ROWS * 256; i += GT) d[i] = i < (long)NP_ROWS * 256 ? s0[i] : s1[i - (long)NP_ROWS * 256]; }
        __syncthreads();
        LAS float* sc = (LAS float*)ldsl;
        LAS float* part = (LAS float*)(ldsl + 20480);
        for (int i = tid; i < 5 * 1024; i += 512) { const int cnd = i >> 10, k = i & 1023; const float v = cnd < 4 ? INP(2)[cnd * 1024 + k] : INP(9)[k]; sc[i] = v / (1.0f + __expf(-v)); }
        __syncthreads();
        for (int item = bx; item < 4 * 96; item += G) {
            const int l = item / 96, cb = item % 96, col = cb * 64 + lane; const float* Wl = INP(10) + (size_t)l * 1024 * 6144;
            float a0 = 0.f, a1 = 0.f, a2 = 0.f, a3 = 0.f, a4 = 0.f;
#pragma unroll 8
            for (int kk = 0; kk < 128; ++kk) { const int k = wave * 128 + kk; const float w = Wl[(size_t)k * 6144 + col];
                a0 += sc[k] * w; a1 += sc[1024 + k] * w; a2 += sc[2048 + k] * w; a3 += sc[3072 + k] * w; a4 += sc[4096 + k] * w; }
            part[(wave * 5 + 0) * 64 + lane] = a0; part[(wave * 5 + 1) * 64 + lane] = a1; part[(wave * 5 + 2) * 64 + lane] = a2; part[(wave * 5 + 3) * 64 + lane] = a3; part[(wave * 5 + 4) * 64 + lane] = a4;
            __syncthreads();
            if (tid < 320) { const int cnd = tid >> 6, ln = tid & 63; float s = INP(11)[l * 6144 + cb * 64 + ln];
#pragma unroll
                for (int w8 = 0; w8 < 8; ++w8) s += part[(w8 * 5 + cnd) * 64 + ln];
                mods[((size_t)l * 5 + cnd) * 6144 + cb * 64 + ln] = s; }
            __syncthreads();
        }
    }
    PH_END
    }

    for (int layer = 0; layer < 4; ++layer) {
        const int kind = layer % 3, jj = layer / 3;
        PH_BEGIN
        if constexpr (EN(1))
        for (int rep_ = 0; rep_ < REP_NORM; ++rep_)
        for (int r = gw; r < M_ROWS; r += NGW) { const float* mc = modl + cond_of_row(r) * 6144; const bfu* pr = (G == 256 && layer > 0 && r < NP_ROWS) ? (const bfu*)(ws + WS_P) + (size_t)r * 1024 : nullptr; norm_row(X + (size_t)r * 1024, pr, ng, mc, mc + 1024, HB + (size_t)r * 1024, lane); }
        if constexpr (EN(1))
        for (int b = 0; b < 4; ++b) {
            const size_t e0 = NP_ROWS + (size_t)b * EXT_B;
            if (kind == 0)      { cvt_rows(INP(3) + (size_t)(b * 2 + jj) * 65536, 256, KB + e0 * 256, 256, 256, 256, gtid, GT); cvt_rows(INP(4) + (size_t)(b * 2 + jj) * 65536, 256, VB + e0 * 256, 256, 256, 256, gtid, GT); }
            else if (kind == 2) { cvt_rows(INP(7) + (size_t)b * 65536, 256, KB + e0 * 256, 256, 256, 256, gtid, GT); cvt_rows(INP(8) + (size_t)b * 65536, 256, VB + e0 * 256, 256, 256, 256, gtid, GT); }
            else                { cvt_rows(INP(5) + (size_t)b * 65536, 256, CKVN + e0 * 256, 256, 256, 256, gtid, GT); cvt_rows(INP(6) + (size_t)b * 8192, 32, KR + e0 * 32, 32, 256, 32, gtid, GT); }
        }
        PH_END
        if (kind == 1) {
            PH_BEGIN
            if constexpr (EN(2)) { EpiF32 E{TB, 1024}; run_gemm(ldsl, HB, WT + WT_B_DQKV, M_ROWS, 768, 1024, E); }
            PH_END
            PH_BEGIN
            if constexpr (EN(3))
            for (int r = gw; r < M_ROWS; r += NGW) {
                const float* tr = TB + (size_t)r * 1024; f32x4 v[3];
#pragma unroll
                for (int k = 0; k < 3; ++k) v[k] = *(const f32x4*)(tr + 4 * lane + 256 * k);
                float sq = (v[0][0] * v[0][0] + v[0][1] * v[0][1]) + (v[0][2] * v[0][2] + v[0][3] * v[0][3]);
                const float s1 = (v[1][0] * v[1][0] + v[1][1] * v[1][1]) + (v[1][2] * v[1][2] + v[1][3] * v[1][3]);
                const float s2 = (v[2][0] * v[2][0] + v[2][1] * v[2][1]) + (v[2][2] * v[2][2] + v[2][3] * v[2][3]);
                float skv = 0.f;
                if (lane < 32) { sq += s1; skv = s2; } else { skv = s1; }
                sq = wave_sum(sq); skv = wave_sum(skv);
                const float rq = 1.0f / sqrtf(sq * (1.0f / 384.0f) + EPS_), rkv = 1.0f / sqrtf(skv * (1.0f / 256.0f) + EPS_);
                const bool sample = r >= NP_ROWS; const int e = ext_of_row(r); const int t = (r - NP_ROWS) & 4095;
                { const f32x4 g = *(const f32x4*)(INP(19) + 4 * lane); const f32x4 y = v[0] * rq * g; u32x2 w; w.x = pkbf(y[0], y[1]); w.y = pkbf(y[2], y[3]); *(u32x2*)(DQN + (size_t)r * 384 + 4 * lane) = w; }
                if (lane < 32) {
                    { const f32x4 g = *(const f32x4*)(INP(19) + 256 + 4 * lane); const f32x4 y = v[1] * rq * g; u32x2 w; w.x = pkbf(y[0], y[1]); w.y = pkbf(y[2], y[3]); *(u32x2*)(DQN + (size_t)r * 384 + 256 + 4 * lane) = w; }
                    { const int c = 128 + 4 * lane; const f32x4 g = *(const f32x4*)(INP(22) + c); const f32x4 y = v[2] * rkv * g; u32x2 w; w.x = pkbf(y[0], y[1]); w.y = pkbf(y[2], y[3]); *(u32x2*)(CKVN + (size_t)e * 256 + c) = w;
                      if (!sample) *(f32x4*)(st_b_ckv + (size_t)r * 256 + c) = y; }
                } else {
                    { const int c = 4 * (lane - 32); const f32x4 g = *(const f32x4*)(INP(22) + c); const f32x4 y = v[1] * rkv * g; u32x2 w; w.x = pkbf(y[0], y[1]); w.y = pkbf(y[2], y[3]); *(u32x2*)(CKVN + (size_t)e * 256 + c) = w;
                      if (!sample) *(f32x4*)(st_b_ckv + (size_t)r * 256 + c) = y; }
                }
                { f32x4 y = v[2]; const int l8 = lane - 32;
                  f32x4 oth; oth[0] = __shfl_xor(y[0], 2); oth[1] = __shfl_xor(y[1], 2); oth[2] = __shfl_xor(y[2], 2); oth[3] = __shfl_xor(y[3], 2);
                  if (lane >= 32 && lane < 40) {
                      if (sample) { const int pos = l8 < 4 ? (t >> 6) : (t & 63); const bool first = (l8 & 2) == 0;
#pragma unroll
                          for (int j = 0; j < 4; ++j) { float c, s; rope_cs(pos, 4 * (l8 & 1) + j, 1.0f / 8.0f, c, s); y[j] = first ? (y[j] * c - oth[j] * s) : (oth[j] * s + y[j] * c); } }
                      else *(f32x4*)(st_b_kr + (size_t)r * 32 + 4 * l8) = y;
                      u32x2 w; w.x = pkbf(y[0], y[1]); w.y = pkbf(y[2], y[3]); *(u32x2*)(KR + (size_t)e * 32 + 4 * l8) = w; } }
            }
            PH_END
            PH_BEGIN
            if constexpr (EN(4)) { EpiUQ E{QB}; run_gemm(ldsl, DQN, WT + WT_B_UQ, M_ROWS, 1536, 384, E); }
            if constexpr (EN(5)) { EpiUKV E{KB, VB}; run_gemm(ldsl, CKVN, WT + WT_B_UKV, EXT_ROWS, 2048, 256, E); }
            PH_END
        } else if (kind == 0) {
            PH_BEGIN
            if constexpr (EN(6)) { EpiQKV<false> E{QB, KB, VB, st_a_k + (size_t)jj * 65536, st_a_v + (size_t)jj * 65536, nullptr, nullptr, 2}; run_gemm(ldsl, HB, WT + WT_A_QKV + (size_t)jj * 1536 * 1024, M_ROWS, 1536, 1024, E); }
            PH_END
        } else {
            PH_BEGIN
            if constexpr (EN(7)) { EpiQKV<true> E{QB, KB, VB, st_c_k, st_c_v, INP(26), INP(27), 1}; run_gemm<EpiQKV<true>, QKV_SP2>(ldsl, HB, WT + WT_C_QKV, M_ROWS, 1536, 1024, E); }
            PH_END
        }
        PH_BEGIN
        for (int rep_ = 0; rep_ < REP_ATT; ++rep_)
        for (int i = 0; i < 5; ++i) {
            const int ui = i * G + vcu; if (ui >= 1280) break;
            att::Unit U; int b, h, qb; bool prompt = ui >= 1024;
            if (!prompt) { if (kind == 1) { qb = ui & 15; h = (ui >> 4) & 15; b = ui >> 8; } else { qb = ui & 15; const int g4 = (ui >> 4) & 3, kvh = (ui >> 6) & 3; b = ui >> 8; h = kvh * 4 + g4; } }
            else { const int u2 = ui - 1024; qb = 0; h = u2 & 15; b = u2 >> 4; if (kind != 1) { h = ((u2 >> 2) & 3) * 4 + (u2 & 3); } }
            const int r0 = prompt ? b * 256 : NP_ROWS + b * 4096 + qb * 256; const size_t ebase = prompt ? (size_t)b * 256 : NP_ROWS + (size_t)b * EXT_B;
            U.O = HB + (size_t)r0 * 1024 + h * 64; U.q0 = qb * 256; U.kstart = 0; U.sinkl2 = -1e30f;
            if (kind == 1) { U.Q = QB + (size_t)r0 * 1536 + h * 96; U.ldq = 1536; U.K = KB + ebase * 1024 + h * 64; U.V = VB + ebase * 1024 + h * 64; U.KR = KR + ebase * 32; U.ldk = 1024;
                U.NT = prompt ? 4 : 68; U.C = 0.10206207261596577f * 1.4426950408889634f; U.thr_raw = 8.0f / 0.10206207261596577f; }
            else { const int kvh = h >> 2; U.Q = QB + (size_t)r0 * 1024 + h * 64; U.ldq = 1024; U.K = KB + ebase * 256 + kvh * 64; U.V = VB + ebase * 256 + kvh * 64; U.KR = nullptr; U.ldk = 256;
                U.NT = prompt ? 4 : 68; U.C = 0.125f * 1.4426950408889634f; U.thr_raw = 64.0f;
                if (kind == 0) { U.sinkl2 = INP(16)[jj * 16 + h] * 1.4426950408889634f;
                    if (!prompt) { const int q0 = qb * 256; const int ks = q0 - 128 < 0 ? 0 : q0 - 128; const int ke = q0 + 384 > 4096 ? 4096 : q0 + 384; U.kstart = ks; U.NT = 4 + (ke - ks) / 64; } } }
            if (kind == 1) { if constexpr (EN(8)) att::attn_unit<96, false>(U, (char*)lds); }
            else if (kind == 0) { if constexpr (EN(9)) att::attn_unit<64, true>(U, (char*)lds); }
            else { if constexpr (EN(10)) att::attn_unit<64, false>(U, (char*)lds); }
        }
        PH_END
        PH_BEGIN
        if constexpr (EN(11)) { const bfu* wo = WT + (kind == 0 ? WT_A_O + (size_t)jj * 1024 * 1024 : kind == 1 ? WT_B_O : WT_C_O); EpiResid E{X, modl + 2048, (bfu*)(ws + WS_P)}; run_gemm<EpiResid, G_SP2, true>(ldsl, HB, wo, M_ROWS, 1024, 1024, E); }
        PH_END
        PH_BEGIN
        if constexpr (EN(1))
        for (int rep_ = 0; rep_ < REP_NORM; ++rep_)
        for (int r = gw; r < M_ROWS; r += NGW) { const float* mc = modl + cond_of_row(r) * 6144; const bfu* pr = (G == 256 && r < NP_ROWS) ? (const bfu*)(ws + WS_P) + (size_t)r * 1024 : nullptr; norm_row(X + (size_t)r * 1024, pr, ng + 1024, mc + 3072, mc + 4096, HB + (size_t)r * 1024, lane); }
        PH_END
        PH_BEGIN
        for (int rep_ = 0; rep_ < REP_UP; ++rep_)
        if constexpr (EN(12)) { EpiSqRelu E{HID, DFF}; run_gemm(ldsl, HB, WT + WT_MLP_IN + (size_t)layer * DM * DFF, M_ROWS, DFF, DM, E); }
        PH_END
        PH_BEGIN
        if constexpr (EN(11)) { EpiResid E{X, modl + 5120, (bfu*)(ws + WS_P)}; run_gemm<EpiResid, G_SP2, true>(ldsl, HID, WT + WT_MLP_OUT + (size_t)layer * DM * DFF, M_ROWS, DM, DFF, E); }
        PH_END
    }
    { const int layer = 0;
    PH_BEGIN
    if constexpr (EN(1))
    for (int r = gw; r < M_ROWS; r += NGW) {
        float* xr = X + (size_t)r * 1024; f32x4 v[4]; float s = 0.f;
#pragma unroll
        for (int j = 0; j < 4; ++j) { v[j] = *((const f32x4*)xr + lane + 64 * j);
            if (G == 256 && r < NP_ROWS) { const u32x2* pp = (const u32x2*)((const bfu*)(ws + WS_P) + (size_t)r * 1024) + lane + 64 * j;
#pragma unroll
                for (int q = 0; q < 4; ++q) { const u32x2 w = pp[(size_t)q * 1048576]; v[j][0] += __uint_as_float(w.x << 16); v[j][1] += __uint_as_float(w.x & 0xffff0000u); v[j][2] += __uint_as_float(w.y << 16); v[j][3] += __uint_as_float(w.y & 0xffff0000u); } }
            s += (v[j][0] * v[j][0] + v[j][1] * v[j][1]) + (v[j][2] * v[j][2] + v[j][3] * v[j][3]); }
        const float rstd = 1.0f / sqrtf(wave_sum(s) * (1.0f / 1024.0f) + EPS_);
#pragma unroll
        for (int j = 0; j < 4; ++j) { const f32x4 g = *(const f32x4*)(INP(29) + 4 * lane + 256 * j); *((f32x4*)xr + lane + 64 * j) = v[j] * rstd * g; }
    }
    PH_END
    }
#undef PH_BEGIN
#undef PH_END
}

#ifndef MK_MULTI
#define MK_MULTI 0
#endif
extern "C" void kernel_launch(void* const* d_in, const int* in_sizes, int n_in, void* d_out, int out_size, void* d_ws, size_t ws_size, hipStream_t stream) {
    static int grid = 0;
    if (grid == 0) {
        if (n_in != 30 || ws_size < WS_END) { fprintf(stderr, "kernel_launch: n_in %d ws %zu (need %zu)\n", n_in, ws_size, (size_t)WS_END); grid = -1; return; }
        int dev = 0, cus = 0, per_cu = 0;
        hipGetDevice(&dev); hipDeviceGetAttribute(&cus, hipDeviceAttributeMultiprocessorCount, dev);
        if (hipFuncSetAttribute((const void*)mega_fwd, hipFuncAttributeMaxDynamicSharedMemorySize, LDS_BYTES) != hipSuccess) { fprintf(stderr, "kernel_launch: hipFuncSetAttribute failed\n"); grid = -1; return; }
        hipOccupancyMaxActiveBlocksPerMultiprocessor(&per_cu, (const void*)mega_fwd, 512, LDS_BYTES);
        if (per_cu < 1) { fprintf(stderr, "kernel_launch: occupancy query says %d\n", per_cu); per_cu = 1; }
        (void)hipGetLastError();
        grid = cus * 1;
    }
    if (grid < 0) return;
    ArgsH a{};
    for (int i = 0; i < 30; ++i) a.in[i] = (const float*)d_in[i];
    a.out = (float*)d_out; a.ws = (unsigned char*)d_ws;
    if (hipMemsetAsync((char*)d_ws + WS_CTL, 0, 16384, stream) != hipSuccess) { fprintf(stderr, "memset failed\n"); return; }
#if MK_MULTI
    for (int p = 0; p < N_PHASES; ++p) { a.ph_lo = p; a.ph_hi = p + 1; void* kargs[] = {&a}; hipError_t e = hipLaunchKernel((const void*)mega_fwd, dim3(grid), dim3(512), kargs, LDS_BYTES, stream); if (e != hipSuccess) { fprintf(stderr, "launch %d failed: %s\n", p, hipGetErrorString(e)); break; } }
#else
    a.ph_lo = 0; a.ph_hi = N_PHASES;
    void* kargs[] = {&a};
    hipError_t e = hipLaunchCooperativeKernel((const void*)mega_fwd, dim3(grid), dim3(512), kargs, LDS_BYTES, stream);
    if (e != hipSuccess) fprintf(stderr, "cooperative launch failed: %s (grid %d)\n", hipGetErrorString(e), grid);
#endif
}
```

```cpp
#include <hip/hip_runtime.h>
#include <hip/hip_cooperative_groups.h>
#include <cstdio>
#include <cstdint>
namespace cg = cooperative_groups;
#define LAS __attribute__((address_space(3)))
__device__ __forceinline__ int opaque_tid() { int t = threadIdx.x; asm volatile("" : "+v"(t)); return t; }
namespace pg8 {
#define PG8_LAS __attribute__((address_space(3)))
typedef unsigned short bf16_t;
typedef short bf16x8 __attribute__((ext_vector_type(8)));
typedef float f32x4 __attribute__((ext_vector_type(4)));
typedef unsigned u32x4 __attribute__((ext_vector_type(4)));
constexpr int BM = 256, BK = 64, HALF = 128, HTB = HALF * BK * 2  , STAGE_BYTES = 8 * HTB, NXCD = 8, WGM = 8;

__host__ __device__ __forceinline__ int lds_byte(int r, int c) { const int st = (r >> 4) * 2 + (c >> 5), rr = r & 15, cc = c & 31, ob = rr * 64 + cc * 2; return st * 1024 + (ob ^ (((ob >> 9) & 1) << 5)); }
__host__ __device__ __forceinline__ void stage_rc(int b, int& R, int& C) { const int st = b / 1024, sb = b % 1024, swz = sb ^ (((sb >> 9) & 1) << 5); R = (st >> 1) * 16 + swz / 64; C = (st & 1) * 32 + (swz % 64) / 2; }
__host__ __device__ __forceinline__ int perm32(int rho) { const int n = rho >> 4, i = rho & 15; return 8 * (i >> 2) + 4 * n + (i & 3); }

struct Unit { int pm, pn, kt0, nt, split; };
struct Gemm { const bf16_t* A; const bf16_t* Bt; int M, N, K; };

struct StaticOrder {
    int nM, nN, nwg, G, c, ntk, rounds, rem, sp;
    __host__ __device__ void init(int M, int N, int G_, int c_, int ntk_ = 0, bool SPLIT = false) { nM = M / BM; nN = N / BM; nwg = nM * nN; G = G_; c = c_; ntk = ntk_;
        rounds = 0; rem = 0; sp = (SPLIT && G == 256 && nM == 80 && nN == 4 && (ntk & 7) == 0) ? 4 : 1; }
    __host__ __device__ Unit get(int i) const {
        Unit u; u.pm = 0; u.pn = 0; u.kt0 = 0; u.nt = 0; u.split = 0;
        if (sp == 4) {
            if (i == 0) { const int id = (c & 7) * 32 + (c >> 3); u.pm = 16 + (id >> 2); u.pn = id & 3; u.nt = ntk; }
            else if (i == 1) { const int t = c >> 2, part = c & 3; u.pm = t >> 2; u.pn = t & 3; u.nt = ntk >> 2; u.kt0 = part * u.nt; u.split = 1 + part; }
            return u; }
        const long LL = (long)i * G + c;
        if (LL < nwg) {
            int wgid = (int)LL; { const int q = nwg / NXCD, r = nwg % NXCD, xcd = wgid % NXCD, off = wgid / NXCD; wgid = (xcd < r ? xcd * (q + 1) : r * (q + 1) + (xcd - r) * q) + off; }
            const int nig = WGM * nN, gid = wgid / nig, fm = gid * WGM, gsz = (nM - fm) < WGM ? (nM - fm) : WGM;
            u.pm = fm + ((wgid % nig) % gsz); u.pn = (wgid % nig) / gsz; u.nt = ntk; }
        return u; }
    __host__ __device__ bool next(int i, Unit& u) const { u = get(i); return u.nt > 0; }
    __device__ __forceinline__ void a_ready(const Unit&) const {}
    __device__ __forceinline__ void done(const Unit&) const {}
};

__device__ __forceinline__ unsigned cvt_pk_bf16(float lo, float hi) { unsigned r; asm volatile("v_cvt_pk_bf16_f32 %0, %1, %2" : "=v"(r) : "v"(lo), "v"(hi)); return r; }
template <class Epi, class Sched, bool ALIGN_EPI = false, bool SP2 = false>
__device__ __forceinline__ void gemm_phase(PG8_LAS unsigned char* lds, const Gemm g, const Sched& S, const Epi& E) {
    const int tid = opaque_tid(), wid = __builtin_amdgcn_readfirstlane(tid >> 6), lane = tid & 63, wr = wid >> 2, wc = wid & 3, fr = lane & 15, fq = lane >> 4;
    const int K = g.K;
    unsigned voffA[2], voffB[2];
#pragma unroll
    for (int i = 0; i < 2; ++i) { int R, C; stage_rc(tid * 16 + i * 8192, R, C); const int Rb = Epi::PERM ? ((R & ~31) + perm32(R & 31)) : R;
        voffA[i] = (unsigned)(R * K + C) * 2u; voffB[i] = (unsigned)(Rb * K + C) * 2u; }
    const size_t kstep = (size_t)(BK * 2);
    const size_t hstep = (size_t)HALF * K * 2;
    const size_t tstep = 2 * hstep;
    const unsigned ldsw = (unsigned)wid * 1024u;
    const int aoff = lds_byte(wr * 64 + fr, fq * 8), boff = lds_byte(wc * 32 + fr, fq * 8);
#define PG8_SA(b, h) (((b) * 2 + (h)) * HTB)
#define PG8_SB(b, h) ((4 + (b) * 2 + (h)) * HTB)
#define PG8_STAGE(bufoff, gbase, voff) do { _Pragma("unroll") for (int _i = 0; _i < 2; ++_i) \
        __builtin_amdgcn_global_load_lds((const unsigned*)((const char*)(gbase) + (voff)[_i]), (PG8_LAS unsigned*)(lds + (bufoff) + ldsw + _i * 8192), 16, 0, 0); } while (0)
#define PG8_LDA(dst, b, h) do { _Pragma("unroll") for (int m = 0; m < 4; ++m) _Pragma("unroll") for (int k = 0; k < 2; ++k) dst[m][k] = *(const PG8_LAS bf16x8*)(lds + PG8_SA(b, h) + aoff + m * 2048 + k * 1024); } while (0)
#define PG8_LDB(dst, b, h) do { _Pragma("unroll") for (int n = 0; n < 2; ++n) _Pragma("unroll") for (int k = 0; k < 2; ++k) dst[n][k] = *(const PG8_LAS bf16x8*)(lds + PG8_SB(b, h) + boff + n * 2048 + k * 1024); } while (0)
#define PG8_MMA(ai, bj, At, Bt) do { __builtin_amdgcn_s_setprio(1); _Pragma("unroll") for (int m = 0; m < 4; ++m) _Pragma("unroll") for (int n = 0; n < 2; ++n) _Pragma("unroll") for (int k = 0; k < 2; ++k) \
        acc[ai][bj][m][n] = __builtin_amdgcn_mfma_f32_16x16x32_bf16(Bt[n][k], At[m][k], acc[ai][bj][m][n], 0, 0, 0); __builtin_amdgcn_s_setprio(0); } while (0)
#define PG8_WAIT_V(n) asm volatile("s_waitcnt vmcnt(" #n ")" ::: "memory")
#define PG8_WAIT_L(n) asm volatile("s_waitcnt lgkmcnt(" #n ")" ::: "memory")
#define PG8_BAR __builtin_amdgcn_s_barrier()
#define PG8_SCHED __builtin_amdgcn_sched_barrier(0)
    Unit cur, nxt; int ui = 0;
    if (!S.next(0, cur)) return;
    f32x4 acc[2][2][4][2];
#pragma unroll
    for (int a = 0; a < 2; ++a)
#pragma unroll
        for (int b = 0; b < 2; ++b)
#pragma unroll
            for (int m = 0; m < 4; ++m)
#pragma unroll
                for (int n = 0; n < 2; ++n) acc[a][b][m][n] = (f32x4){0.f, 0.f, 0.f, 0.f};
    bf16x8 At[4][2], B0[2][2], B1[2][2];
    const char* cA = (const char*)g.A + (size_t)cur.pm * tstep + (size_t)cur.kt0 * kstep; const char* cB = (const char*)g.Bt + (size_t)cur.pn * tstep + (size_t)cur.kt0 * kstep;
    S.a_ready(cur);
    if constexpr (SP2) {
        PG8_STAGE(PG8_SB(0, 0), cB, voffB); PG8_STAGE(PG8_SB(0, 1), cB + hstep, voffB); PG8_STAGE(PG8_SA(0, 0), cA, voffA); PG8_STAGE(PG8_SA(0, 1), cA + hstep, voffA);
        if (wr == 1) PG8_BAR;
        PG8_WAIT_V(2); PG8_BAR;
        PG8_STAGE(PG8_SB(1, 0), cB + kstep, voffB); PG8_STAGE(PG8_SA(1, 0), cA + kstep, voffA); PG8_STAGE(PG8_SB(1, 1), cB + hstep + kstep, voffB);
        PG8_WAIT_V(6); PG8_BAR;
    } else {
        PG8_STAGE(PG8_SB(0, 0), cB, voffB); PG8_STAGE(PG8_SA(0, 0), cA, voffA); PG8_STAGE(PG8_SB(0, 1), cB + hstep, voffB); PG8_STAGE(PG8_SA(0, 1), cA + hstep, voffA);
        if (wr == 1) PG8_BAR;
        PG8_WAIT_V(4); PG8_BAR;
        PG8_STAGE(PG8_SB(1, 0), cB + kstep, voffB); PG8_STAGE(PG8_SA(1, 0), cA + kstep, voffA); PG8_STAGE(PG8_SB(1, 1), cB + hstep + kstep, voffB);
        PG8_WAIT_V(6); PG8_BAR;
    }
    for (;;) {
        const bool has_next = S.next(ui + 1, nxt);
        const char* nA = has_next ? (const char*)g.A + (size_t)nxt.pm * tstep + (size_t)nxt.kt0 * kstep : cA; const char* nB = has_next ? (const char*)g.Bt + (size_t)nxt.pn * tstep + (size_t)nxt.kt0 * kstep : cB;
        const int nt = cur.nt;
        for (int t = 0; t < nt; t += 2) {
            asm volatile("" : "+v"(voffA[0]), "+v"(voffA[1]), "+v"(voffB[0]), "+v"(voffB[1]));
            const bool last = (t == nt - 2);
            const char* a1 = cA + (size_t)(t + 1) * kstep;
            const char* a2 = last ? nA : cA + (size_t)(t + 2) * kstep; const char* b2 = last ? nB : cB + (size_t)(t + 2) * kstep;
            const char* a3 = a2 + kstep; const char* b3 = b2 + kstep;
            if (last && has_next) S.a_ready(nxt);
            if constexpr (SP2) {
            PG8_LDB(B0, 0, 0); PG8_LDB(B1, 0, 1); PG8_SCHED; PG8_LDA(At, 0, 0); PG8_STAGE(PG8_SA(1, 1), a1 + hstep, voffA);
            PG8_WAIT_V(8); PG8_WAIT_L(0); PG8_BAR; PG8_MMA(0, 0, At, B0); PG8_MMA(0, 1, At, B1); PG8_BAR; PG8_SCHED;
            PG8_LDA(At, 0, 1); PG8_STAGE(PG8_SB(0, 0), b2, voffB); PG8_STAGE(PG8_SB(0, 1), b2 + hstep, voffB); PG8_STAGE(PG8_SA(0, 0), a2, voffA);
            PG8_WAIT_V(8); PG8_WAIT_L(0); PG8_BAR; PG8_MMA(1, 0, At, B0); PG8_MMA(1, 1, At, B1); PG8_BAR; PG8_SCHED;
            PG8_LDB(B0, 1, 0); PG8_LDB(B1, 1, 1); PG8_SCHED; PG8_LDA(At, 1, 0); PG8_STAGE(PG8_SA(0, 1), a2 + hstep, voffA);
            PG8_WAIT_V(8); PG8_WAIT_L(0); PG8_BAR; PG8_MMA(0, 0, At, B0); PG8_MMA(0, 1, At, B1); PG8_BAR; PG8_SCHED;
            PG8_LDA(At, 1, 1); PG8_STAGE(PG8_SB(1, 0), b3, voffB); PG8_STAGE(PG8_SB(1, 1), b3 + hstep, voffB); PG8_STAGE(PG8_SA(1, 0), a3, voffA);
            PG8_WAIT_V(8); PG8_WAIT_L(0); PG8_BAR; PG8_MMA(1, 0, At, B0); PG8_MMA(1, 1, At, B1); PG8_BAR; PG8_SCHED;
            } else {
            PG8_LDB(B0, 0, 0); PG8_SCHED; PG8_LDA(At, 0, 0); PG8_STAGE(PG8_SA(1, 1), a1 + hstep, voffA);
            PG8_WAIT_L(8); PG8_BAR; PG8_WAIT_L(0); PG8_MMA(0, 0, At, B0); PG8_BAR; PG8_SCHED;
            PG8_LDB(B1, 0, 1); PG8_STAGE(PG8_SB(0, 0), b2, voffB);
            PG8_BAR; PG8_WAIT_L(0); PG8_MMA(0, 1, At, B1); PG8_BAR;
            PG8_LDA(At, 0, 1); PG8_STAGE(PG8_SA(0, 0), a2, voffA);
            PG8_BAR; PG8_WAIT_L(0); PG8_MMA(1, 0, At, B0); PG8_BAR; PG8_SCHED;
            PG8_STAGE(PG8_SB(0, 1), b2 + hstep, voffB);
            PG8_WAIT_V(6); PG8_BAR; PG8_MMA(1, 1, At, B1); PG8_BAR;
            PG8_LDB(B0, 1, 0); PG8_SCHED; PG8_LDA(At, 1, 0); PG8_STAGE(PG8_SA(0, 1), a2 + hstep, voffA);
            PG8_WAIT_L(8); PG8_BAR; PG8_WAIT_L(0); PG8_MMA(0, 0, At, B0); PG8_BAR; PG8_SCHED;
            PG8_LDB(B1, 1, 1); PG8_STAGE(PG8_SB(1, 0), b3, voffB);
            PG8_BAR; PG8_WAIT_L(0); PG8_MMA(0, 1, At, B1); PG8_BAR;
            PG8_LDA(At, 1, 1); PG8_STAGE(PG8_SA(1, 0), a3, voffA);
            PG8_BAR; PG8_WAIT_L(0); PG8_MMA(1, 0, At, B0); PG8_BAR; PG8_SCHED;
            PG8_STAGE(PG8_SB(1, 1), b3 + hstep, voffB);
            PG8_WAIT_V(6); PG8_BAR; PG8_MMA(1, 1, At, B1); PG8_BAR;
            }
        }
        if constexpr (ALIGN_EPI) { if (wr == 0) PG8_BAR; }
        if constexpr (!Epi::AFTER_DRAIN) { E(acc, cur, wr, wc, fr, fq); S.done(cur); }
        if (!has_next) break;
#pragma unroll
        for (int a = 0; a < 2; ++a)
#pragma unroll
            for (int b = 0; b < 2; ++b)
#pragma unroll
                for (int m = 0; m < 4; ++m)
#pragma unroll
                    for (int n = 0; n < 2; ++n) acc[a][b][m][n] = (f32x4){0.f, 0.f, 0.f, 0.f};
        cur = nxt; cA = nA; cB = nB; ++ui;
        if constexpr (ALIGN_EPI) { if (wr == 1) PG8_BAR; }
    }
    PG8_WAIT_V(0);
    if constexpr (!ALIGN_EPI) { if (wr == 0) PG8_BAR; }
    PG8_BAR;
    if constexpr (Epi::AFTER_DRAIN) { E.fused(acc, cur, wr, wc, fr, fq, lds, wid, lane); S.done(cur); }
#undef PG8_SA
#undef PG8_SB
#undef PG8_STAGE
#undef PG8_LDA
#undef PG8_LDB
#undef PG8_MMA
#undef PG8_WAIT_V
#undef PG8_WAIT_L
#undef PG8_BAR
#undef PG8_SCHED
}
}
namespace att {
using bf16x8 = __attribute__((ext_vector_type(8))) short;
using s16x4  = __attribute__((ext_vector_type(4))) short;
using f32x16 = __attribute__((ext_vector_type(16))) float;
using u32x4  = __attribute__((ext_vector_type(4))) unsigned;
using u32x2  = __attribute__((ext_vector_type(2))) unsigned;
constexpr int NW = 8, QBLK = 32, KVBLK = 64;
constexpr int SHM_V = 16384, SHM_K = 16384, SHM_ATTN = 3 * SHM_V + 3 * SHM_K + NW * 64 * 4;
#define KSWZ(row, colB) ((row) * 256 + ((colB) ^ (((row) & 7) << 4)))
#define SBAR() __builtin_amdgcn_sched_barrier(0)
__device__ __forceinline__ int crow(int r, int hi) { return (r & 3) + 8 * (r >> 2) + 4 * hi; }
__device__ __forceinline__ unsigned cvtpk(float lo, float hi) { unsigned r; asm volatile("v_cvt_pk_bf16_f32 %0, %1, %2" : "=v"(r) : "v"(lo), "v"(hi)); return r; }

#define MX3(a, b, c) __builtin_fmaxf(__builtin_fmaxf((a), (b)), (c))
template <bool FIRST>
__device__ __forceinline__ void partialSM(f32x16& p0, f32x16& p1, float& m_reg, f32x16& negm, float& alpha, const float thr) {
  float a = MX3(p0[0], p0[1], p1[0]), b = MX3(p0[2], p0[3], p1[1]); a = MX3(a, p1[2], p1[3]);
#pragma unroll
  for (int r = 4; r < 16; r += 4) { a = MX3(a, p0[r], p0[r + 1]); b = MX3(b, p0[r + 2], p0[r + 3]); a = MX3(a, p1[r], p1[r + 1]); b = MX3(b, p1[r + 2], p1[r + 3]); }
  float pmax = fmaxf(a, b);
  { auto rr = __builtin_amdgcn_permlane32_swap(__float_as_uint(pmax), __float_as_uint(pmax), false, false);
    pmax = fmaxf(__uint_as_float(rr[0]), __uint_as_float(rr[1])); }
  alpha = 1.f;
  if (FIRST || !__builtin_expect(__all(pmax <= thr), 1)) {
    const float dl = FIRST ? pmax : fmaxf(pmax, 0.f);
    alpha = __builtin_amdgcn_exp2f(-dl); m_reg += dl;
#pragma unroll
    for (int r = 0; r < 16; ++r) { p0[r] -= dl; p1[r] -= dl; }
#pragma unroll
    for (int r = 0; r < 16; ++r) negm[r] = -m_reg;
  }
#pragma unroll
  for (int r = 0; r < 16; ++r) p0[r] = __builtin_amdgcn_exp2f(p0[r]);
}
__device__ __forceinline__ void finishSM(f32x16& p0, f32x16& p1, bf16x8& pa0, bf16x8& pa1, bf16x8& pa2, bf16x8& pa3) {
#pragma unroll
  for (int r = 0; r < 16; ++r) p1[r] = __builtin_amdgcn_exp2f(p1[r]);
#define PK4(P, BASE, OUT) do { unsigned a0 = cvtpk(P[BASE + 0], P[BASE + 1]), a1 = cvtpk(P[BASE + 2], P[BASE + 3]);   \
    unsigned b0 = cvtpk(P[BASE + 4], P[BASE + 5]), b1 = cvtpk(P[BASE + 6], P[BASE + 7]);                              \
    auto r0 = __builtin_amdgcn_permlane32_swap(a0, b0, false, false); auto r1 = __builtin_amdgcn_permlane32_swap(a1, b1, false, false); \
    u32x4 w = {r0[0], r1[0], r0[1], r1[1]}; OUT = *reinterpret_cast<bf16x8*>(&w); } while (0)
  PK4(p0, 0, pa0); PK4(p0, 8, pa1); PK4(p1, 0, pa2); PK4(p1, 8, pa3);
#undef PK4
}
template <int DQK>
__device__ __forceinline__ void qkt(f32x16& p0, f32x16& p1, const char* Ks, const bf16x8* qr, const f32x16& negm, int r32, int hi) {
  p0 = negm; p1 = negm;
  __builtin_amdgcn_s_setprio(1);
#pragma unroll
  for (int d0 = 0; d0 < DQK / 16; ++d0) { int cb = (d0 * 16 + hi * 8) * 2;
    bf16x8 b0 = *reinterpret_cast<const bf16x8*>(Ks + KSWZ(r32, cb));
    bf16x8 b1 = *reinterpret_cast<const bf16x8*>(Ks + KSWZ(32 + r32, cb));
    p0 = __builtin_amdgcn_mfma_f32_32x32x16_bf16(b0, qr[d0], p0, 0, 0, 0);
    p1 = __builtin_amdgcn_mfma_f32_32x32x16_bf16(b1, qr[d0], p1, 0, 0, 0); }
  __builtin_amdgcn_s_setprio(0);
}
__device__ __forceinline__ int v_st(int k, int c) { const int kk = (k & ~0xC) | ((k & 4) << 1) | ((k & 8) >> 1); return ((kk >> 3) * 4 + (c >> 5)) * 512 + ((kk & 7) * 32 + (c & 31)) * 2; }
__device__ __forceinline__ int v_rd_base(int lane) { return ((lane & 3) << 3) | (((lane >> 2) & 3) << 6) | (((lane >> 4) & 1) << 5) | (((lane >> 5) & 1) << 8); }
constexpr int v_rd_off(int d0, int ks, int half) { return d0 * 512 + ks * 4096 + half * 2048; }
template <int OFF> __device__ __forceinline__ s16x4 tr_read(int vb) {
  s16x4 r; asm volatile("ds_read_b64_tr_b16 %0, %1 offset:%2" : "=&v"(r) : "v"(vb), "i"(OFF) : "memory"); return r;
}
struct VFrag { s16x4 l[4], h[4]; };
template <int D0> __device__ __forceinline__ void v_reads(VFrag& f, int vb) {
  f.l[0] = tr_read<v_rd_off(D0, 0, 0)>(vb); f.h[0] = tr_read<v_rd_off(D0, 0, 1)>(vb); f.l[1] = tr_read<v_rd_off(D0, 1, 0)>(vb); f.h[1] = tr_read<v_rd_off(D0, 1, 1)>(vb);
  f.l[2] = tr_read<v_rd_off(D0, 2, 0)>(vb); f.h[2] = tr_read<v_rd_off(D0, 2, 1)>(vb); f.l[3] = tr_read<v_rd_off(D0, 3, 0)>(vb); f.h[3] = tr_read<v_rd_off(D0, 3, 1)>(vb);
}
__device__ __forceinline__ void pv_mma(f32x16* o, f32x16& lacc, VFrag& f, int vb, bf16x8 pa0, bf16x8 pa1, bf16x8 pa2, bf16x8 pa3) {
  const bf16x8 ones = {0x3F80, 0x3F80, 0x3F80, 0x3F80, 0x3F80, 0x3F80, 0x3F80, 0x3F80};
  asm volatile("s_waitcnt lgkmcnt(0)" ::: "memory"); SBAR();
#define PK(L, H) (bf16x8){L[0], L[1], L[2], L[3], H[0], H[1], H[2], H[3]}
  o[0] = __builtin_amdgcn_mfma_f32_32x32x16_bf16(pa0, PK(f.l[0], f.h[0]), o[0], 0, 0, 0);
  o[0] = __builtin_amdgcn_mfma_f32_32x32x16_bf16(pa1, PK(f.l[1], f.h[1]), o[0], 0, 0, 0);
  o[0] = __builtin_amdgcn_mfma_f32_32x32x16_bf16(pa2, PK(f.l[2], f.h[2]), o[0], 0, 0, 0);
  o[0] = __builtin_amdgcn_mfma_f32_32x32x16_bf16(pa3, PK(f.l[3], f.h[3]), o[0], 0, 0, 0);
  SBAR(); v_reads<1>(f, vb); SBAR();
  lacc = __builtin_amdgcn_mfma_f32_32x32x16_bf16(pa0, ones, lacc, 0, 0, 0);
  lacc = __builtin_amdgcn_mfma_f32_32x32x16_bf16(pa1, ones, lacc, 0, 0, 0);
  lacc = __builtin_amdgcn_mfma_f32_32x32x16_bf16(pa2, ones, lacc, 0, 0, 0);
  lacc = __builtin_amdgcn_mfma_f32_32x32x16_bf16(pa3, ones, lacc, 0, 0, 0);
  asm volatile("s_waitcnt lgkmcnt(0)" ::: "memory"); SBAR();
  o[1] = __builtin_amdgcn_mfma_f32_32x32x16_bf16(pa0, PK(f.l[0], f.h[0]), o[1], 0, 0, 0);
  o[1] = __builtin_amdgcn_mfma_f32_32x32x16_bf16(pa1, PK(f.l[1], f.h[1]), o[1], 0, 0, 0);
  o[1] = __builtin_amdgcn_mfma_f32_32x32x16_bf16(pa2, PK(f.l[2], f.h[2]), o[1], 0, 0, 0);
  o[1] = __builtin_amdgcn_mfma_f32_32x32x16_bf16(pa3, PK(f.l[3], f.h[3]), o[1], 0, 0, 0);
#undef PK
}
struct Unit {
  const unsigned short* Q; const unsigned short* K; const unsigned short* KR; const unsigned short* V; unsigned short* O;
  int ldq, ldk, NT, kstart, q0;
  float C, thr_raw, sinkl2;
};
__device__ __forceinline__ void wmask(f32x16& p0, f32x16& p1, int tilepos, int qpos, int hi) {
#pragma unroll
  for (int r = 0; r < 16; ++r) { const int k0 = tilepos + crow(r, hi); int d0 = qpos - k0; d0 = d0 < 0 ? -d0 : d0; int d1 = qpos - (k0 + 32); d1 = d1 < 0 ? -d1 : d1;
    if (d0 > 128) p0[r] = -1e30f; if (d1 > 128) p1[r] = -1e30f; }
}
template <int DQK, bool WINDOW>
__device__ __forceinline__ void attn_unit(const Unit& U, char* lds) {
  const int tid = opaque_tid(), wid = __builtin_amdgcn_readfirstlane(tid >> 6), lane = tid & 63, r32 = lane & 31, hi = lane >> 5;
  char* V_lds = lds; char* K_lds = lds + 3 * SHM_V;
  float* ws = (float*)(lds + 3 * SHM_V + 3 * SHM_K) + wid * 64; float* li_l = ws; float* al_l = ws + 32;
  const float thr = 11.5415603f;
  float m_reg = 0.f; f32x16 o[2] = {}; f32x16 lacc = {}; f32x16 negm = {}; bf16x8 qr[DQK / 16];
  const unsigned short* Qw = U.Q + (long)(wid * QBLK + r32) * U.ldq + hi * 8;
#pragma unroll
  for (int d0 = 0; d0 < DQK / 16; ++d0) qr[d0] = *reinterpret_cast<const bf16x8*>(Qw + d0 * 16);
  const int sr = tid >> 3, sc = (tid & 7) * 8, vst0 = v_st(sr, sc), kst0 = KSWZ(sr, sc * 2);
  const int srr = (tid >> 2) & 63, scr = (tid & 3) * 8, kst1 = KSWZ(srr, (64 + scr) * 2);
  const bool do_r = (DQK == 96) && (tid < 256);
  const int vb0 = (int)(uintptr_t)V_lds + v_rd_base(lane);
  const int ldk = U.ldk, kstart = U.kstart;
  const int qpos = U.q0 + wid * QBLK + r32; const int qlo = U.q0 + wid * QBLK;
  struct { bf16x8 vs, ks, rs; } sr_[3];
#define KROW(j) ((long)(64 * (j) + ((j) >= 4 ? kstart : 0)))
#define SLOAD(i, j) do { const long kr_ = KROW(j); sr_[i].vs = *reinterpret_cast<const bf16x8*>(U.V + (kr_ + sr) * ldk + sc); \
    sr_[i].ks = *reinterpret_cast<const bf16x8*>(U.K + (kr_ + sr) * ldk + sc); \
    if (DQK == 96) { if (do_r) sr_[i].rs = *reinterpret_cast<const bf16x8*>(U.KR + (kr_ + srr) * 32 + scr); } } while (0)
#define SWRITE(soff, i) do { *(bf16x8*)(V_lds + (soff) + vst0) = sr_[i].vs; *(bf16x8*)(K_lds + (soff) + kst0) = sr_[i].ks; \
    if (DQK == 96) { if (do_r) *(bf16x8*)(K_lds + (soff) + kst1) = sr_[i].rs; } } while (0)
#define RESC(a) do { if (__any((a) < 1.f)) { if (hi == 0) al_l[r32] = (a); asm volatile("s_waitcnt lgkmcnt(0)" ::: "memory"); \
    _Pragma("unroll") for (int r = 0; r < 16; ++r) { const float f_ = al_l[crow(r, hi)]; o[0][r] *= f_; o[1][r] *= f_; lacc[r] *= f_; } } } while (0)
#define WMASK(P0, P1, j) do { if (WINDOW) { if ((j) >= 4) wmask(P0, P1, kstart + 64 * ((j) - 4), qpos, hi); } } while (0)
#define QKM(P0, P1, KP, j, SK) do { SK = false; \
    if (WINDOW && (j) >= 4) { const int tp_ = kstart + 64 * ((j) - 4); \
      if (tp_ + 63 < qlo - 128 || tp_ > qlo + 31 + 128) { SK = true; _Pragma("unroll") for (int r_ = 0; r_ < 16; ++r_) { P0[r_] = 0.f; P1[r_] = 0.f; } } \
      else { qkt<DQK>(P0, P1, KP, qr, negm, r32, hi); if (!(tp_ >= qlo + 31 - 128 && tp_ + 63 <= qlo + 128)) wmask(P0, P1, tp_, qpos, hi); } } \
    else qkt<DQK>(P0, P1, KP, qr, negm, r32, hi); } while (0)
#define LIVE(SK) (!(WINDOW && (SK)))
#define ROT() do { const int t_ = s_prev; s_prev = s_cur; s_cur = s_next; s_next = t_; } while (0)
  static_assert(SHM_V == SHM_K, "one slot offset serves both rings");
  f32x16 pA0, pA1, pB0, pB1; float alA, alB; bool skA = false, skB = false; bf16x8 pa0, pa1, pa2, pa3; const int NT = U.NT; VFrag vf;
  int s_prev = 2 * SHM_V, s_cur = 0, s_next = SHM_V;
  SLOAD(1, 0); SLOAD(2, 1); if (2 < NT) SLOAD(0, 2);
  SWRITE(0, 1); SWRITE(SHM_V, 2);
  __syncthreads();
  qkt<DQK>(pA0, pA1, K_lds, qr, negm, r32, hi); partialSM<true>(pA0, pA1, m_reg, negm, alA, thr);
  ROT();
  for (int j = 1; j + 1 < NT; j += 2) {
    SWRITE(s_next, 0); if (j + 2 < NT) SLOAD(0, j + 2);
    SBAR(); QKM(pB0, pB1, K_lds + s_cur, j, skB);
    if (LIVE(skA)) { v_reads<0>(vf, vb0 + s_prev); finishSM(pA0, pA1, pa0, pa1, pa2, pa3); pv_mma(o, lacc, vf, vb0 + s_prev, pa0, pa1, pa2, pa3); }
    if (LIVE(skB)) partialSM<false>(pB0, pB1, m_reg, negm, alB, thr); else alB = 1.f;
    __syncthreads(); RESC(alB); ROT();
    if (j + 2 < NT) SWRITE(s_next, 0); if (j + 3 < NT) SLOAD(0, j + 3);
    SBAR(); QKM(pA0, pA1, K_lds + s_cur, j + 1, skA);
    if (LIVE(skB)) { v_reads<0>(vf, vb0 + s_prev); finishSM(pB0, pB1, pa0, pa1, pa2, pa3); pv_mma(o, lacc, vf, vb0 + s_prev, pa0, pa1, pa2, pa3); }
    if (LIVE(skA)) partialSM<false>(pA0, pA1, m_reg, negm, alA, thr); else alA = 1.f;
    __syncthreads(); RESC(alA); ROT();
  }
  SBAR(); QKM(pB0, pB1, K_lds + s_cur, NT - 1, skB);
  if (LIVE(skA)) { v_reads<0>(vf, vb0 + s_prev); finishSM(pA0, pA1, pa0, pa1, pa2, pa3); pv_mma(o, lacc, vf, vb0 + s_prev, pa0, pa1, pa2, pa3); }
  if (LIVE(skB)) {
    partialSM<false>(pB0, pB1, m_reg, negm, alB, thr);
    RESC(alB);
    SBAR(); v_reads<0>(vf, vb0 + s_cur); SBAR();
    finishSM(pB0, pB1, pa0, pa1, pa2, pa3);
    pv_mma(o, lacc, vf, vb0 + s_cur, pa0, pa1, pa2, pa3);
  }
  if (hi == 0) li_l[r32] = __builtin_amdgcn_exp2f(fmaxf(U.sinkl2 - m_reg, -126.f));
  asm volatile("s_waitcnt lgkmcnt(0)" ::: "memory");
  float rli[16];
#pragma unroll
  for (int r = 0; r < 16; ++r) rli[r] = __builtin_amdgcn_rcpf(lacc[r] + li_l[crow(r, hi)]);
  unsigned short* Ow = U.O + (long)(wid * QBLK) * 1024;
#pragma unroll
  for (int r = 0; r < 16; ++r) { const int orow = crow(r, hi);
#pragma unroll
    for (int d0 = 0; d0 < 2; ++d0) { const float lo = o[d0][r] * rli[r]; const unsigned pk = cvtpk(lo, lo); Ow[(long)orow * 1024 + d0 * 32 + r32] = (unsigned short)(pk & 0xffffu); } }
  __syncthreads();
#undef KROW
#undef SLOAD
#undef SWRITE
#undef RESC
#undef WMASK
#undef QKM
#undef LIVE
#undef ROT
}
#undef SBAR
}
constexpr int DM = 1024, NP_ROWS = 4096, NS_ROWS = 16384, M_ROWS = 20480, EXT_ROWS = 21504, EXT_B = 4352, DFF = 4096;
constexpr float EPS_ = 1e-6f;
constexpr float LOG2_THETA = 13.287712379549449f;
constexpr float INV_2PI = 0.15915494309189535f;
typedef unsigned short bfu;
typedef float f32x4 __attribute__((ext_vector_type(4)));
typedef unsigned u32x4 __attribute__((ext_vector_type(4)));
typedef unsigned u32x2 __attribute__((ext_vector_type(2)));
__device__ __forceinline__ unsigned pkbf(float lo, float hi) { return pg8::cvt_pk_bf16(lo, hi); }
__device__ __forceinline__ void rope_cs(int pos, int i, float inv_den, float& c, float& s) {
    const float f = __builtin_amdgcn_exp2f(-(float)i * (LOG2_THETA * inv_den));
    const float rev = (float)pos * f * INV_2PI;
    c = __builtin_amdgcn_cosf(rev); s = __builtin_amdgcn_sinf(rev);
}
__device__ __forceinline__ int cond_of_row(int row) { return row < NP_ROWS ? 4 : ((row - NP_ROWS) >> 12); }
__device__ __forceinline__ int ext_of_row(int row) { return row < NP_ROWS ? row : (NP_ROWS + ((row - NP_ROWS) >> 12) * EXT_B + 256 + ((row - NP_ROWS) & 4095)); }

#define EPI_FENCE() asm volatile("" ::: "memory")
template <bool NORMC> struct EpiQKV {
    static constexpr bool PERM = false, AFTER_DRAIN = false;
    bfu* Q; bfu* Kb; bfu* Vb; float* stK; float* stV; const float* gq; const float* gk; int nstate;
    __device__ __forceinline__ void operator()(const f32x4 (&acc)[2][2][4][2], const pg8::Unit& u, int wr, int wc, int fr, int fq) const {
        asm volatile("" : "+v"(fr), "+v"(fq));
        const int pn = u.pn; const bool isQ = pn < 4, isK = pn == 4; const bool sample = u.pm >= 16;
        const bool dorope = sample && pn < 5;
        float frq[4];
#pragma unroll
        for (int j = 0; j < 4; ++j) frq[j] = __builtin_amdgcn_exp2f(-(float)(4 * fq + j) * (LOG2_THETA / 16.0f)) * INV_2PI;
        const unsigned cq = 64 * wc + 4 * fq;
#pragma unroll
        for (int ai = 0; ai < 2; ++ai)
#pragma unroll
            for (int m = 0; m < 4; ++m) {
                unsigned row = u.pm * 256 + ai * 128 + wr * 64 + m * 16 + fr; asm volatile("" : "+v"(row));
                f32x4 v[2][2];
#pragma unroll
                for (int bj = 0; bj < 2; ++bj)
#pragma unroll
                    for (int n = 0; n < 2; ++n) v[bj][n] = acc[ai][bj][m][n];
                if (NORMC && pn < 5) {
                    float ss = 0.f;
#pragma unroll
                    for (int bj = 0; bj < 2; ++bj)
#pragma unroll
                        for (int n = 0; n < 2; ++n) ss += (v[bj][n][0] * v[bj][n][0] + v[bj][n][1] * v[bj][n][1]) + (v[bj][n][2] * v[bj][n][2] + v[bj][n][3] * v[bj][n][3]);
                    ss += __shfl_xor(ss, 16); ss += __shfl_xor(ss, 32);
                    const float rstd = 1.0f / sqrtf(ss * (1.0f / 64.0f) + EPS_);
                    const float* g = (isQ ? gq : gk) + 4 * fq;
#pragma unroll
                    for (int bj = 0; bj < 2; ++bj)
#pragma unroll
                        for (int n = 0; n < 2; ++n) { const f32x4 gv = *(const f32x4*)(g + 32 * bj + 16 * n); v[bj][n] = v[bj][n] * rstd * gv; }
                }
                const unsigned t = (row - NP_ROWS) & 4095u;
                if (dorope) {
#pragma unroll
                    for (int bj = 0; bj < 2; ++bj) { const float pos = (float)(bj == 0 ? (t >> 6) : (t & 63u));
#pragma unroll
                        for (int j = 0; j < 4; ++j) { const float rev = pos * frq[j]; const float c = __builtin_amdgcn_cosf(rev), s = __builtin_amdgcn_sinf(rev); const float x1 = v[bj][0][j], x2 = v[bj][1][j];
                            v[bj][0][j] = x1 * c - x2 * s; v[bj][1][j] = x1 * s + x2 * c; } }
                }
                if (isQ) { bfu* p = Q + (row * 1024u + 256u * pn + cq);
#pragma unroll
                    for (int bj = 0; bj < 2; ++bj)
#pragma unroll
                        for (int n = 0; n < 2; ++n) { const f32x4 x = v[bj][n] * (0.125f * 1.4426950408889634f);     u32x2 w; w.x = pkbf(x[0], x[1]); w.y = pkbf(x[2], x[3]); *(u32x2*)(p + 32 * bj + 16 * n) = w; }
                } else {
                    const unsigned e = sample ? (NP_ROWS + ((row - NP_ROWS) >> 12) * EXT_B + 256u + t) : row;
                    bfu* p = (isK ? Kb : Vb) + (e * 256u + cq);
#pragma unroll
                    for (int bj = 0; bj < 2; ++bj)
#pragma unroll
                        for (int n = 0; n < 2; ++n) { const f32x4 x = v[bj][n]; u32x2 w; w.x = pkbf(x[0], x[1]); w.y = pkbf(x[2], x[3]); *(u32x2*)(p + 32 * bj + 16 * n) = w; }
                    if (!sample) { float* st = (isK ? stK : stV) + ((((row >> 8) * nstate) * 256u + (row & 255u)) * 256u + cq);
#pragma unroll
                        for (int bj = 0; bj < 2; ++bj)
#pragma unroll
                            for (int n = 0; n < 2; ++n) *(f32x4*)(st + 32 * bj + 16 * n) = v[bj][n]; }
                }
                EPI_FENCE();
            }
    }
};
struct EpiResid {
    static constexpr bool PERM = true, AFTER_DRAIN = false;
    float* x; const float* gate; bfu* P;
    __device__ __forceinline__ void operator()(const f32x4 (&acc)[2][2][4][2], const pg8::Unit& u, int wr, int wc, int fr, int fq) const {
        asm volatile("" : "+v"(fr), "+v"(fq));
        const int cond = cond_of_row(u.pm * 256); const unsigned c0 = u.pn * 256 + wc * 32 + 8 * fq; const float* g = gate + cond * 6144 + c0;
#pragma unroll
        for (int ai = 0; ai < 2; ++ai)
#pragma unroll
            for (int m = 0; m < 4; ++m) { const unsigned row = u.pm * 256 + ai * 128 + wr * 64 + m * 16 + fr; const unsigned off = row * 1024u + c0;
#pragma unroll
                for (int bj = 0; bj < 2; ++bj) { const f32x4 g0 = *(const f32x4*)(g + bj * 128), g1 = *(const f32x4*)(g + bj * 128 + 4);
                    const f32x4 y0 = g0 * acc[ai][bj][m][0], y1 = g1 * acc[ai][bj][m][1]; const unsigned o2 = off + bj * 128;
                    if (u.split) { u32x4 w; w.x = pkbf(y0[0], y0[1]); w.y = pkbf(y0[2], y0[3]); w.z = pkbf(y1[0], y1[1]); w.w = pkbf(y1[2], y1[3]); *(u32x4*)(P + ((size_t)(u.split - 1) * 4096 * 1024 + o2)) = w; }
                    else { const f32x4 b0 = *(const f32x4*)(x + o2), b1 = *(const f32x4*)(x + o2 + 4); *(f32x4*)(x + o2) = b0 + y0; *(f32x4*)(x + o2 + 4) = b1 + y1; } }
                EPI_FENCE(); }
    }
};
struct EpiSqRelu {
    static constexpr bool PERM = true, AFTER_DRAIN = false;
    bfu* O; int ldc;
    __device__ __forceinline__ void operator()(const f32x4 (&acc)[2][2][4][2], const pg8::Unit& u, int wr, int wc, int fr, int fq) const {
        asm volatile("" : "+v"(fr), "+v"(fq));
#pragma unroll
        for (int ai = 0; ai < 2; ++ai)
#pragma unroll
            for (int m = 0; m < 4; ++m) { const unsigned row = u.pm * 256 + ai * 128 + wr * 64 + m * 16 + fr; bfu* p = O + ((size_t)row * ldc + u.pn * 256 + wc * 32 + 8 * fq);
#pragma unroll
                for (int bj = 0; bj < 2; ++bj) { f32x4 v0 = acc[ai][bj][m][0], v1 = acc[ai][bj][m][1];
#pragma unroll
                    for (int j = 0; j < 4; ++j) { const float a = fmaxf(v0[j], 0.f), b = fmaxf(v1[j], 0.f); v0[j] = a * a; v1[j] = b * b; }
                    u32x4 w; w.x = pkbf(v0[0], v0[1]); w.y = pkbf(v0[2], v0[3]); w.z = pkbf(v1[0], v1[1]); w.w = pkbf(v1[2], v1[3]);
                    *(u32x4*)(p + bj * 128) = w; }
                EPI_FENCE(); }
    }
};
struct EpiUKV {
    static constexpr bool PERM = true, AFTER_DRAIN = false;
    bfu* Kn; bfu* Vb;
    __device__ __forceinline__ void operator()(const f32x4 (&acc)[2][2][4][2], const pg8::Unit& u, int wr, int wc, int fr, int fq) const {
        asm volatile("" : "+v"(fr), "+v"(fq));
        bfu* base = (wc < 2 ? Kn : Vb) + (2 * u.pn * 64 + 32 * (wc & 1) + 8 * fq);
#pragma unroll
        for (int ai = 0; ai < 2; ++ai)
#pragma unroll
            for (int m = 0; m < 4; ++m) { const unsigned row = u.pm * 256 + ai * 128 + wr * 64 + m * 16 + fr; bfu* p = base + row * 1024u;
#pragma unroll
                for (int bj = 0; bj < 2; ++bj) { const f32x4 v0 = acc[ai][bj][m][0], v1 = acc[ai][bj][m][1];
                    u32x4 w; w.x = pkbf(v0[0], v0[1]); w.y = pkbf(v0[2], v0[3]); w.z = pkbf(v1[0], v1[1]); w.w = pkbf(v1[2], v1[3]);
                    *(u32x4*)(p + bj * 64) = w; }
                EPI_FENCE(); }
    }
};
struct EpiF32 {
    static constexpr bool PERM = true, AFTER_DRAIN = false;
    bfu* T; int ldc;
    __device__ __forceinline__ void operator()(const f32x4 (&acc)[2][2][4][2], const pg8::Unit& u, int wr, int wc, int fr, int fq) const {
        asm volatile("" : "+v"(fr), "+v"(fq));
#pragma unroll
        for (int ai = 0; ai < 2; ++ai)
#pragma unroll
            for (int m = 0; m < 4; ++m) { const unsigned row = u.pm * 256 + ai * 128 + wr * 64 + m * 16 + fr; bfu* p = T + ((size_t)row * ldc + u.pn * 256 + wc * 32 + 8 * fq);
#pragma unroll
                for (int bj = 0; bj < 2; ++bj) { const f32x4 v0 = acc[ai][bj][m][0], v1 = acc[ai][bj][m][1];
                    u32x4 w; w.x = pkbf(v0[0], v0[1]); w.y = pkbf(v0[2], v0[3]); w.z = pkbf(v1[0], v1[1]); w.w = pkbf(v1[2], v1[3]); *(u32x4*)(p + bj * 128) = w; }
                EPI_FENCE(); }
    }
};
struct EpiUQ {
    static constexpr bool PERM = false, AFTER_DRAIN = false;
    bfu* Q;
    __device__ __forceinline__ void operator()(const f32x4 (&acc)[2][2][4][2], const pg8::Unit& u, int wr, int wc, int fr, int fq) const {
        asm volatile("" : "+v"(fr), "+v"(fq));
        const bool sample = u.pm >= 16;
        float frq[4];
#pragma unroll
        for (int j = 0; j < 4; ++j) frq[j] = __builtin_amdgcn_exp2f(-(float)(4 * (fq & 1) + j) * (LOG2_THETA / 8.0f)) * INV_2PI;
        const bool lowhalf = fq < 2;
#pragma unroll
        for (int ai = 0; ai < 2; ++ai)
#pragma unroll
            for (int m = 0; m < 4; ++m) { unsigned row = u.pm * 256 + ai * 128 + wr * 64 + m * 16 + fr; asm volatile("" : "+v"(row)); const unsigned t = (row - NP_ROWS) & 4095u;
                bfu* p = Q + (row * 1536u + u.pn * 256 + wc * 32 + 4 * fq);
#pragma unroll
                for (int bj = 0; bj < 2; ++bj) {
                    const int g32 = (u.pn * 256 + bj * 128 + wc * 32) >> 5; const bool ropeg = (g32 % 3) == 2;
#pragma unroll
                    for (int n = 0; n < 2; ++n) { f32x4 v = acc[ai][bj][m][n];
                        if (sample && ropeg) { const float pos = (float)(n == 0 ? (t >> 6) : (t & 63u));
#pragma unroll
                            for (int j = 0; j < 4; ++j) { const float other = __shfl_xor(v[j], 32); const float rev = pos * frq[j]; const float c = __builtin_amdgcn_cosf(rev), s = __builtin_amdgcn_sinf(rev);
                                v[j] = lowhalf ? (v[j] * c - other * s) : (other * s + v[j] * c); } }
                        v = v * (0.10206207261596577f * 1.4426950408889634f);
                        u32x2 w; w.x = pkbf(v[0], v[1]); w.y = pkbf(v[2], v[3]);
                        *(u32x2*)(p + bj * 128 + n * 16) = w; } }
                EPI_FENCE(); }
    }
};
#define XB_TMO      128
#define XB_XCNT(j)  (256  + 64 * (j))
#define XB_XSUB(j)  (1280 + 64 * (j))
#define XB_XGEN(j)  (2304 + 64 * (j))
#define XB_TOP      3328
#define XB_TOPGEN   3392
#define XCD_BAR_WORDS 3456
#define XB_SPIN_CAP (1u << 18)

__device__ __forceinline__ unsigned xb_ld(unsigned* p)              { return __hip_atomic_load(p, __ATOMIC_RELAXED, __HIP_MEMORY_SCOPE_AGENT); }
__device__ __forceinline__ unsigned xb_add(unsigned* p, unsigned v) { return __hip_atomic_fetch_add(p, v, __ATOMIC_RELAXED, __HIP_MEMORY_SCOPE_AGENT); }
__device__ __forceinline__ unsigned xb_xcc_id() { return (unsigned)__builtin_amdgcn_s_getreg((3 << 11) | 20) & 0xFu; }
#define XB_SPIN(cond, bar) do { unsigned _sp = 0; while (cond) { __builtin_amdgcn_s_sleep(1); \
    if ((++_sp & 255u) == 0u) { if (xb_ld(&(bar)[XB_TMO])) break; if (_sp > XB_SPIN_CAP) { atomicAdd(&(bar)[XB_TMO], 1u); break; } } } } while (0)

struct XcdBarrier {
    unsigned* bar; unsigned x;
    volatile LAS unsigned* st;
};

__device__ __forceinline__ XcdBarrier xcd_barrier_post(unsigned* bar, volatile LAS unsigned* st) {
    XcdBarrier b; b.bar = bar; b.x = xb_xcc_id(); b.st = st;
    if (threadIdx.x == 0) (void)xb_add(&bar[XB_XCNT(b.x)], 1u);
    return b;
}
__device__ __forceinline__ void xcd_barrier_complete(unsigned* bar, unsigned x, unsigned& nloc, unsigned& nx) {
    const unsigned G = gridDim.x * gridDim.y * gridDim.z;
    unsigned sum, cnt, mine, sp = 0u;
    for (;;) {
        sum = 0u; cnt = 0u; mine = 0u;
#pragma unroll
        for (unsigned j = 0; j < 16; ++j) { const unsigned c = xb_ld(&bar[XB_XCNT(j)]); sum += c; cnt += (c > 0u) ? 1u : 0u; mine = (j == x) ? c : mine; }
        if (sum == G) break;
        __builtin_amdgcn_s_sleep(1);
        if ((++sp & 255u) == 0u) { if (xb_ld(&bar[XB_TMO])) break; if (sp > XB_SPIN_CAP) { atomicAdd(&bar[XB_TMO], 1u); break; } }
    }
    nloc = mine > 0u ? mine : 1u; nx = cnt > 0u ? cnt : 1u;
}

__device__ __forceinline__ void xcd_barrier(const XcdBarrier& b) {
    asm volatile("s_waitcnt vmcnt(0)" ::: "memory");
    __syncthreads();
    if (threadIdx.x == 0) {
        unsigned* bar = b.bar;
        __builtin_amdgcn_s_waitcnt(0);
        unsigned nloc = b.st[0], nx = b.st[1];
        if (nloc == 0u) { xcd_barrier_complete(bar, b.x, nloc, nx); b.st[0] = nloc; b.st[1] = nx; }
        const unsigned old = xb_add(&bar[XB_XSUB(b.x)], 1u);
        const unsigned gen = old / nloc;
        if (old + 1u == (gen + 1u) * nloc) {
            __builtin_amdgcn_fence(__ATOMIC_RELEASE, "agent");
            asm volatile("s_waitcnt vmcnt(0)" ::: "memory");
            const unsigned og = xb_add(&bar[XB_TOP], 1u);
            const unsigned tg = og / nx;
            if (og + 1u == (tg + 1u) * nx) xb_add(&bar[XB_TOPGEN], 1u);
            else XB_SPIN(xb_ld(&bar[XB_TOPGEN]) == tg, bar);
            __builtin_amdgcn_fence(__ATOMIC_ACQUIRE, "agent");
            xb_add(&bar[XB_XGEN(b.x)], 1u);
            asm volatile("s_waitcnt vmcnt(0)" ::: "memory");
        } else {
            XB_SPIN(xb_ld(&bar[XB_XGEN(b.x)]) == gen, bar);
            __builtin_amdgcn_fence(__ATOMIC_ACQUIRE, "agent");
            asm volatile("s_waitcnt vmcnt(0)" ::: "memory");
        }
    }
    __syncthreads();
}

constexpr size_t MiB = 1u << 20;
constexpr size_t WT_MLP_IN = 0;
constexpr size_t WT_MLP_OUT = 4 * (size_t)DM * DFF;
constexpr size_t WT_A_QKV = 8 * (size_t)DM * DFF;
constexpr size_t WT_A_O = WT_A_QKV + 2 * 1536 * 1024;
constexpr size_t WT_C_QKV = WT_A_O + 2 * 1024 * 1024;
constexpr size_t WT_C_O = WT_C_QKV + 1536 * 1024;
constexpr size_t WT_B_DQKV = WT_C_O + 1024 * 1024;
constexpr size_t WT_B_UQ = WT_B_DQKV + 768 * 1024;
constexpr size_t WT_B_UKV = WT_B_UQ + 1536 * 384;
constexpr size_t WT_B_O = WT_B_UKV + 2048 * 256;
constexpr size_t WT_END = WT_B_O + 1024 * 1024;
static_assert(WT_END * 2 <= 88 * MiB, "WT region");
constexpr size_t WS_WT = 0, WS_MODS = 88 * MiB, WS_KR = 89 * MiB, WS_CKVN = 91 * MiB, WS_DQN = 102 * MiB, WS_H = 117 * MiB, WS_R1 = 157 * MiB;
constexpr size_t WS_Q = WS_R1, WS_K = WS_R1 + 60 * MiB, WS_V = WS_K + 42 * MiB, WS_T = WS_R1, WS_HID = WS_R1, WS_CTL = WS_R1 + 160 * MiB, WS_P = WS_CTL + 1 * MiB, WS_END = WS_P + 64 * MiB;

#define GAS1 __attribute__((address_space(1)))
struct Args { const GAS1 float* in[30]; GAS1 float* out; GAS1 unsigned char* ws; int ph_lo, ph_hi; };
struct ArgsH { const float* in[30]; float* out; unsigned char* ws; int ph_lo, ph_hi; };
static_assert(sizeof(Args) == sizeof(ArgsH), "Args layout");

__device__ __forceinline__ float wave_sum(float v) {
#pragma unroll
    for (int o = 1; o < 64; o <<= 1) v += __shfl_xor(v, o);
    return v;
}
template <int MAP>
__device__ __forceinline__ void transpose_item(const float* W, int K, int N, bfu* WT, int row_off, LAS float* scr, int item, int lane) {
    const int nblk = N / 32, kb = item / nblk, nb = item % nblk, k0 = 64 * kb, n0 = 32 * nb;
#pragma unroll 8
    for (int i = 0; i < 32; ++i) { const int kk = 2 * i + (lane >> 5); scr[kk * 33 + (lane & 31)] = W[(size_t)(k0 + kk) * N + n0 + (lane & 31)]; }
    asm volatile("s_waitcnt lgkmcnt(0)" ::: "memory");
    const int c = lane & 7;
#pragma unroll
    for (int j = 0; j < 4; ++j) { const int n = (lane >> 3) + 8 * j; const LAS float* s = scr + (8 * c) * 33 + n;
        u32x4 o; o.x = pkbf(s[0 * 33], s[1 * 33]); o.y = pkbf(s[2 * 33], s[3 * 33]); o.z = pkbf(s[4 * 33], s[5 * 33]); o.w = pkbf(s[6 * 33], s[7 * 33]);
        int src = n0 + n, dst;
        if (MAP == 1) { const int tile = src >> 8, loc = src & 255, hl = loc >> 6, d = loc & 63; dst = tile * 256 + (d >> 5) * 128 + hl * 32 + (d & 31); } else dst = row_off + src;
        *(u32x4*)(WT + (size_t)dst * K + k0 + 8 * c) = o; }
    asm volatile("s_waitcnt lgkmcnt(0)" ::: "memory");
}
__device__ __forceinline__ void norm_row(float* xrow, const bfu* prow, const float* g, const float* shift, const float* scale, bfu* orow, int lane) {
    f32x4 v[4]; float s = 0.f;
#pragma unroll
    for (int j = 0; j < 4; ++j) { v[j] = *((const f32x4*)xrow + lane + 64 * j);
        if (prow) { const u32x2* pp = (const u32x2*)prow + lane + 64 * j;
#pragma unroll
            for (int q = 0; q < 4; ++q) { const u32x2 w = pp[(size_t)q * 1048576]; v[j][0] += __uint_as_float(w.x << 16); v[j][1] += __uint_as_float(w.x & 0xffff0000u); v[j][2] += __uint_as_float(w.y << 16); v[j][3] += __uint_as_float(w.y & 0xffff0000u); }
            *((f32x4*)xrow + lane + 64 * j) = v[j]; } s += (v[j][0] * v[j][0] + v[j][1] * v[j][1]) + (v[j][2] * v[j][2] + v[j][3] * v[j][3]); }
    const float rstd = 1.0f / sqrtf(wave_sum(s) * (1.0f / 1024.0f) + EPS_);
#pragma unroll
    for (int j = 0; j < 4; ++j) { const int c = 4 * lane + 256 * j; const f32x4 gv = *(const f32x4*)(g + c), sh = *(const f32x4*)(shift + c), sc = *(const f32x4*)(scale + c);
        const f32x4 y = v[j] * rstd * gv * (sc + 1.0f) + sh; u32x2 w; w.x = pkbf(y[0], y[1]); w.y = pkbf(y[2], y[3]); *((u32x2*)orow + lane + 64 * j) = w; }
}
__device__ __forceinline__ void cvt_rows(const float* src, size_t src_stride, bfu* dst, size_t dst_stride, int nrows, int ncols, int gtid, int gthreads) {
    const int cpr = ncols / 8;
    for (long i = gtid; i < (long)nrows * cpr; i += gthreads) { const int r = (int)(i / cpr), c = (int)(i % cpr) * 8;
        const f32x4 a = *(const f32x4*)(src + (size_t)r * src_stride + c), b = *(const f32x4*)(src + (size_t)r * src_stride + c + 4);
        u32x4 w; w.x = pkbf(a[0], a[1]); w.y = pkbf(a[2], a[3]); w.z = pkbf(b[0], b[1]); w.w = pkbf(b[2], b[3]); *(u32x4*)(dst + (size_t)r * dst_stride + c) = w; }
}

#ifndef G_ALIGN
#define G_ALIGN true
#endif
#ifndef G_SP2
#define G_SP2 true
#endif
#ifndef QKV_SP2
#define QKV_SP2 true
#endif
struct LdsOrder {
    const LAS int* ul;
    __device__ __forceinline__ bool next(int i, pg8::Unit& u) const {
        if (i >= 16) return false;
        const LAS int* p = ul + i * 8;
        const int ok = __builtin_amdgcn_readfirstlane(p[0]); if (!ok) return false;
        u.pm = __builtin_amdgcn_readfirstlane(p[1]); u.pn = __builtin_amdgcn_readfirstlane(p[2]); u.kt0 = __builtin_amdgcn_readfirstlane(p[3]);
        u.nt = __builtin_amdgcn_readfirstlane(p[4]); u.split = __builtin_amdgcn_readfirstlane(p[5]); return true;
    }
    __device__ __forceinline__ void a_ready(const pg8::Unit&) const {}
    __device__ __forceinline__ void done(const pg8::Unit&) const {}
};
constexpr int LDS_UNITS = 131072;
template <class Epi, bool SP2 = G_SP2, bool SPLIT = false>
__device__ __forceinline__ void run_gemm(LAS unsigned char* lds, const bfu* A, const bfu* Bt, int M, int N, int K, const Epi& E) {
    int Kv = K; asm volatile("" : "+s"(Kv));
    LAS int* ul = (LAS int*)(lds + LDS_UNITS);
    { const int t = opaque_tid();
      if (t < 16) { int G_ = gridDim.x, bx_ = blockIdx.x; pg8::StaticOrder S; S.init(M, N, G_, bx_, Kv / 64, SPLIT); const pg8::Unit u = S.get(t);
          ul[t * 8 + 0] = u.nt > 0 ? 1 : 0; ul[t * 8 + 1] = u.pm; ul[t * 8 + 2] = u.pn; ul[t * 8 + 3] = u.kt0; ul[t * 8 + 4] = u.nt; ul[t * 8 + 5] = u.split; }
      __syncthreads(); }
    pg8::Gemm g{A, Bt, M, N, Kv}; LdsOrder S{ul};
    pg8::gemm_phase<Epi, LdsOrder, G_ALIGN, SP2>(lds, g, S, E);
    __syncthreads();
}

constexpr int LDS_BYTES = 147456, LDS_MISC = 147456 - 64;
constexpr int N_PHASES = 32;
#ifndef REP_ATT
#define REP_ATT 1
#endif
#ifndef REP_UP
#define REP_UP 1
#endif
#ifndef REP_RES
#define REP_RES 1
#endif
#ifndef REP_NORM
#define REP_NORM 1
#endif
#ifndef REP_P0
#define REP_P0 1
#endif
#ifndef PH_MASK
#define PH_MASK 0xffff
#endif
#define EN(k) (((PH_MASK) >> (k)) & 1)

typedef const __attribute__((address_space(4))) Args* KArgsP;
__device__ __forceinline__ KArgsP ka() { KArgsP p = (KArgsP)__builtin_amdgcn_kernarg_segment_ptr(); asm volatile("" : "+s"(p)); return p; }
__global__ void __launch_bounds__(512, 2) mega_fwd(Args args) {
    extern __shared__ __attribute__((aligned(16))) unsigned char lds[];
    cg::grid_group grid = cg::this_grid();
    const int lo = args.ph_lo, hi = args.ph_hi; int ph = 0;
    XcdBarrier xbar; xbar.bar = nullptr; xbar.x = 0; xbar.st = nullptr;
    if (hi - lo > 1) {
        volatile LAS unsigned* misc = (volatile LAS unsigned*)((LAS unsigned char*)lds + LDS_MISC);
        if (threadIdx.x < 16) misc[threadIdx.x] = 0u;
        __syncthreads();
        xbar = xcd_barrier_post((unsigned*)((unsigned char*)args.ws + WS_CTL), misc + 8);
    }
#define INP(i) ((const float*)A->in[i])
#define PHASE_LOCALS KArgsP A = ka(); const int tid = opaque_tid(), lane = tid & 63, wave = __builtin_amdgcn_readfirstlane(tid >> 6); \
    int G = gridDim.x, bx = blockIdx.x; asm volatile("" : "+s"(G), "+s"(bx)); const int vcu = (G % 8 == 0) ? (bx % 8) * (G / 8) + bx / 8 : bx; \
    const int gw = bx * 8 + wave, NGW = G * 8, gtid = bx * 512 + tid, GT = G * 512; (void)lane; (void)vcu; (void)gw; (void)NGW; (void)gtid; (void)GT; \
    LAS unsigned char* const ldsl = (LAS unsigned char*)lds; (void)ldsl; unsigned char* const ws = (unsigned char*)A->ws; float* const X = (float*)A->out; \
    bfu* const WT = (bfu*)(ws + WS_WT); float* const mods = (float*)(ws + WS_MODS); bfu* const KR = (bfu*)(ws + WS_KR); bfu* const CKVN = (bfu*)(ws + WS_CKVN); bfu* const DQN = (bfu*)(ws + WS_DQN); \
    bfu* const HB = (bfu*)(ws + WS_H); bfu* const QB = (bfu*)(ws + WS_Q); bfu* const KB = (bfu*)(ws + WS_K); bfu* const VB = (bfu*)(ws + WS_V); float* const TB = (float*)(ws + WS_T); bfu* const HID = (bfu*)(ws + WS_HID); \
    float* const st_a_k = X + 20971520; float* const st_a_v = X + 23068672; float* const st_b_ckv = X + 25165824; float* const st_b_kr = X + 26214400; float* const st_c_k = X + 26345472; float* const st_c_v = X + 27394048; \
    const float* const modl = mods + (size_t)layer * 5 * 6144; const float* const ng = INP(12) + (size_t)layer * 2 * 1024; \
    (void)WT; (void)KR; (void)CKVN; (void)DQN; (void)HB; (void)QB; (void)KB; (void)VB; (void)TB; (void)HID; (void)st_a_k; (void)st_a_v; (void)st_b_ckv; (void)st_b_kr; (void)st_c_k; (void)st_c_v; (void)modl; (void)ng;
#define PH_BEGIN if (ph >= lo && ph < hi) { PHASE_LOCALS
#ifndef REP_SYNC
#define REP_SYNC 1
#endif
#define PH_END if (ph + 1 < hi) { for (int rs_ = 0; rs_ < REP_SYNC; ++rs_) { if (ph == 0) grid.sync(); else xcd_barrier(xbar); } } } ++ph;

    { const int layer = 0;
    PH_BEGIN
    if constexpr (EN(0)) for (int rep_ = 0; rep_ < REP_P0; ++rep_) {
        if (rep_) __syncthreads();
        LAS float* scr = (LAS float*)(ldsl + wave * 16384);
        for (int seg = 0; seg < 20; ++seg) {
            const float* W; int K, N, map = 0, roff = 0; size_t dsto;
            if (seg < 4)       { W = INP(13) + (size_t)seg * DM * DFF; K = DM; N = DFF; dsto = WT_MLP_IN + (size_t)seg * DM * DFF; }
            else if (seg < 8)  { W = INP(14) + (size_t)(seg - 4) * DM * DFF; K = DFF; N = DM; dsto = WT_MLP_OUT + (size_t)(seg - 4) * DM * DFF; }
            else if (seg < 10) { W = INP(15) + (size_t)(seg - 8) * 1024 * 1536; K = 1024; N = 1536; dsto = WT_A_QKV + (size_t)(seg - 8) * 1536 * 1024; map = 1; }
            else if (seg < 12) { W = INP(17) + (size_t)(seg - 10) * 1024 * 1024; K = 1024; N = 1024; dsto = WT_A_O + (size_t)(seg - 10) * 1024 * 1024; }
            else if (seg == 12) { W = INP(25); K = 1024; N = 1536; dsto = WT_C_QKV; map = 1; }
            else if (seg == 13) { W = INP(28); K = 1024; N = 1024; dsto = WT_C_O; }
            else if (seg == 14) { W = INP(18); K = 1024; N = 384; dsto = WT_B_DQKV; }
            else if (seg == 15) { W = INP(21); K = 1024; N = 288; dsto = WT_B_DQKV; roff = 384; }
            else if (seg == 16) { W = INP(20); K = 384; N = 1536; dsto = WT_B_UQ; }
            else if (seg == 17) { W = INP(23); K = 256; N = 2048; dsto = WT_B_UKV; }
            else if (seg == 18) { W = INP(24); K = 1024; N = 1024; dsto = WT_B_O; }
            else break;
            const int nitems = (K / 64) * (N / 32);
            if (map == 1) { for (int it = gw; it < nitems; it += NGW) transpose_item<1>(W, K, N, WT + dsto, 0, scr, it, lane); }
            else          { for (int it = gw; it < nitems; it += NGW) transpose_item<0>(W, K, N, WT + dsto, roff, scr, it, lane); }
        }
        for (int i = gtid; i < 96 * 1024 / 8; i += GT) *(u32x4*)(WT + WT_B_DQKV + (size_t)672 * 1024 + (size_t)i * 8) = (u32x4){0u, 0u, 0u, 0u};
        { const f32x4* s0 = (const f32x4*)INP(0); const f32x4* s1 = (const f32x4*)INP(1); f32x4* d = (f32x4*)X;
          for (long i = gtid; i < (long)M_ROWS * 256; i += GT) d[i] = i < (long)NP_ROWS * 256 ? s0[i] : s1[i - (long)NP_ROWS * 256]; }
        __syncthreads();
        LAS float* sc = (LAS float*)ldsl;
        LAS float* part = (LAS float*)(ldsl + 20480);
        for (int i = tid; i < 5 * 1024; i += 512) { const int cnd = i >> 10, k = i & 1023; const float v = cnd < 4 ? INP(2)[cnd * 1024 + k] : INP(9)[k]; sc[i] = v / (1.0f + __expf(-v)); }
        __syncthreads();
        for (int item = bx; item < 4 * 96; item += G) {
            const int l = item / 96, cb = item % 96, col = cb * 64 + lane; const float* Wl = INP(10) + (size_t)l * 1024 * 6144;
            float a0 = 0.f, a1 = 0.f, a2 = 0.f, a3 = 0.f, a4 = 0.f;
#pragma unroll 8
            for (int kk = 0; kk < 128; ++kk) { const int k = wave * 128 + kk; const float w = Wl[(size_t)k * 6144 + col];
                a0 += sc[k] * w; a1 += sc[1024 + k] * w; a2 += sc[2048 + k] * w; a3 += sc[3072 + k] * w; a4 += sc[4096 + k] * w; }
            part[(wave * 5 + 0) * 64 + lane] = a0; part[(wave * 5 + 1) * 64 + lane] = a1; part[(wave * 5 + 2) * 64 + lane] = a2; part[(wave * 5 + 3) * 64 + lane] = a3; part[(wave * 5 + 4) * 64 + lane] = a4;
            __syncthreads();
            if (tid < 320) { const int cnd = tid >> 6, ln = tid & 63; float s = INP(11)[l * 6144 + cb * 64 + ln];
#pragma unroll
                for (int w8 = 0; w8 < 8; ++w8) s += part[(w8 * 5 + cnd) * 64 + ln];
                mods[((size_t)l * 5 + cnd) * 6144 + cb * 64 + ln] = s; }
            __syncthreads();
        }
    }
    PH_END
    }

    for (int layer = 0; layer < 4; ++layer) {
        const int kind = layer % 3, jj = layer / 3;
        PH_BEGIN
        if constexpr (EN(1))
        for (int rep_ = 0; rep_ < REP_NORM; ++rep_)
        for (int r = gw; r < M_ROWS; r += NGW) { const float* mc = modl + cond_of_row(r) * 6144; const bfu* pr = (G == 256 && layer > 0 && r < NP_ROWS) ? (const bfu*)(ws + WS_P) + (size_t)r * 1024 : nullptr; norm_row(X + (size_t)r * 1024, pr, ng, mc, mc + 1024, HB + (size_t)r * 1024, lane); }
        if constexpr (EN(1))
        for (int b = 0; b < 4; ++b) {
            const size_t e0 = NP_ROWS + (size_t)b * EXT_B;
            if (kind == 0)      { cvt_rows(INP(3) + (size_t)(b * 2 + jj) * 65536, 256, KB + e0 * 256, 256, 256, 256, gtid, GT); cvt_rows(INP(4) + (size_t)(b * 2 + jj) * 65536, 256, VB + e0 * 256, 256, 256, 256, gtid, GT); }
            else if (kind == 2) { cvt_rows(INP(7) + (size_t)b * 65536, 256, KB + e0 * 256, 256, 256, 256, gtid, GT); cvt_rows(INP(8) + (size_t)b * 65536, 256, VB + e0 * 256, 256, 256, 256, gtid, GT); }
            else                { cvt_rows(INP(5) + (size_t)b * 65536, 256, CKVN + e0 * 256, 256, 256, 256, gtid, GT); cvt_rows(INP(6) + (size_t)b * 8192, 32, KR + e0 * 32, 32, 256, 32, gtid, GT); }
        }
        PH_END
        if (kind == 1) {
            PH_BEGIN
            if constexpr (EN(2)) { EpiF32 E{(bfu*)TB, 1024}; run_gemm(ldsl, HB, WT + WT_B_DQKV, M_ROWS, 768, 1024, E); }
            PH_END
            PH_BEGIN
            if constexpr (EN(3))
            for (int r = gw; r < M_ROWS; r += NGW) {
                const bfu* tr = (const bfu*)TB + (size_t)r * 1024; f32x4 v[3];
#pragma unroll
                for (int k = 0; k < 3; ++k) { const u32x2 w = *(const u32x2*)(tr + 4 * lane + 256 * k); v[k][0] = __uint_as_float(w.x << 16); v[k][1] = __uint_as_float(w.x & 0xffff0000u); v[k][2] = __uint_as_float(w.y << 16); v[k][3] = __uint_as_float(w.y & 0xffff0000u); }
                float sq = (v[0][0] * v[0][0] + v[0][1] * v[0][1]) + (v[0][2] * v[0][2] + v[0][3] * v[0][3]);
                const float s1 = (v[1][0] * v[1][0] + v[1][1] * v[1][1]) + (v[1][2] * v[1][2] + v[1][3] * v[1][3]);
                const float s2 = (v[2][0] * v[2][0] + v[2][1] * v[2][1]) + (v[2][2] * v[2][2] + v[2][3] * v[2][3]);
                float skv = 0.f;
                if (lane < 32) { sq += s1; skv = s2; } else { skv = s1; }
                sq = wave_sum(sq); skv = wave_sum(skv);
                const float rq = 1.0f / sqrtf(sq * (1.0f / 384.0f) + EPS_), rkv = 1.0f / sqrtf(skv * (1.0f / 256.0f) + EPS_);
                const bool sample = r >= NP_ROWS; const int e = ext_of_row(r); const int t = (r - NP_ROWS) & 4095;
                { const f32x4 g = *(const f32x4*)(INP(19) + 4 * lane); const f32x4 y = v[0] * rq * g; u32x2 w; w.x = pkbf(y[0], y[1]); w.y = pkbf(y[2], y[3]); *(u32x2*)(DQN + (size_t)r * 384 + 4 * lane) = w; }
                if (lane < 32) {
                    { const f32x4 g = *(const f32x4*)(INP(19) + 256 + 4 * lane); const f32x4 y = v[1] * rq * g; u32x2 w; w.x = pkbf(y[0], y[1]); w.y = pkbf(y[2], y[3]); *(u32x2*)(DQN + (size_t)r * 384 + 256 + 4 * lane) = w; }
                    { const int c = 128 + 4 * lane; const f32x4 g = *(const f32x4*)(INP(22) + c); const f32x4 y = v[2] * rkv * g; u32x2 w; w.x = pkbf(y[0], y[1]); w.y = pkbf(y[2], y[3]); *(u32x2*)(CKVN + (size_t)e * 256 + c) = w;
                      if (!sample) *(f32x4*)(st_b_ckv + (size_t)r * 256 + c) = y; }
                } else {
                    { const int c = 4 * (lane - 32); const f32x4 g = *(const f32x4*)(INP(22) + c); const f32x4 y = v[1] * rkv * g; u32x2 w; w.x = pkbf(y[0], y[1]); w.y = pkbf(y[2], y[3]); *(u32x2*)(CKVN + (size_t)e * 256 + c) = w;
                      if (!sample) *(f32x4*)(st_b_ckv + (size_t)r * 256 + c) = y; }
                }
                { f32x4 y = v[2]; const int l8 = lane - 32;
                  f32x4 oth; oth[0] = __shfl_xor(y[0], 2); oth[1] = __shfl_xor(y[1], 2); oth[2] = __shfl_xor(y[2], 2); oth[3] = __shfl_xor(y[3], 2);
                  if (lane >= 32 && lane < 40) {
                      if (sample) { const int pos = l8 < 4 ? (t >> 6) : (t & 63); const bool first = (l8 & 2) == 0;
#pragma unroll
                          for (int j = 0; j < 4; ++j) { float c, s; rope_cs(pos, 4 * (l8 & 1) + j, 1.0f / 8.0f, c, s); y[j] = first ? (y[j] * c - oth[j] * s) : (oth[j] * s + y[j] * c); } }
                      else *(f32x4*)(st_b_kr + (size_t)r * 32 + 4 * l8) = y;
                      u32x2 w; w.x = pkbf(y[0], y[1]); w.y = pkbf(y[2], y[3]); *(u32x2*)(KR + (size_t)e * 32 + 4 * l8) = w; } }
            }
            PH_END
            PH_BEGIN
            if constexpr (EN(4)) { EpiUQ E{QB}; run_gemm(ldsl, DQN, WT + WT_B_UQ, M_ROWS, 1536, 384, E); }
            if constexpr (EN(5)) { EpiUKV E{KB, VB}; run_gemm(ldsl, CKVN, WT + WT_B_UKV, EXT_ROWS, 2048, 256, E); }
            PH_END
        } else if (kind == 0) {
            PH_BEGIN
            if constexpr (EN(6)) { EpiQKV<false> E{QB, KB, VB, st_a_k + (size_t)jj * 65536, st_a_v + (size_t)jj * 65536, nullptr, nullptr, 2}; run_gemm(ldsl, HB, WT + WT_A_QKV + (size_t)jj * 1536 * 1024, M_ROWS, 1536, 1024, E); }
            PH_END
        } else {
            PH_BEGIN
            if constexpr (EN(7)) { EpiQKV<true> E{QB, KB, VB, st_c_k, st_c_v, INP(26), INP(27), 1}; run_gemm<EpiQKV<true>, QKV_SP2>(ldsl, HB, WT + WT_C_QKV, M_ROWS, 1536, 1024, E); }
            PH_END
        }
        PH_BEGIN
        for (int rep_ = 0; rep_ < REP_ATT; ++rep_)
        for (int i = 0; i < 5; ++i) {
            const int ui = i * G + vcu; if (ui >= 1280) break;
            att::Unit U; int b, h, qb; bool prompt = ui >= 1024;
            if (!prompt) { if (kind == 1) { qb = ui & 15; h = (ui >> 4) & 15; b = ui >> 8; } else { qb = ui & 15; const int g4 = (ui >> 4) & 3, kvh = (ui >> 6) & 3; b = ui >> 8; h = kvh * 4 + g4; } }
            else { const int u2 = ui - 1024; qb = 0; h = u2 & 15; b = u2 >> 4; if (kind != 1) { h = ((u2 >> 2) & 3) * 4 + (u2 & 3); } }
            const int r0 = prompt ? b * 256 : NP_ROWS + b * 4096 + qb * 256; const size_t ebase = prompt ? (size_t)b * 256 : NP_ROWS + (size_t)b * EXT_B;
            U.O = HB + (size_t)r0 * 1024 + h * 64; U.q0 = qb * 256; U.kstart = 0; U.sinkl2 = -1e30f;
            if (kind == 1) { U.Q = QB + (size_t)r0 * 1536 + h * 96; U.ldq = 1536; U.K = KB + ebase * 1024 + h * 64; U.V = VB + ebase * 1024 + h * 64; U.KR = KR + ebase * 32; U.ldk = 1024;
                U.NT = prompt ? 4 : 68; U.C = 0.10206207261596577f * 1.4426950408889634f; U.thr_raw = 8.0f / 0.10206207261596577f; }
            else { const int kvh = h >> 2; U.Q = QB + (size_t)r0 * 1024 + h * 64; U.ldq = 1024; U.K = KB + ebase * 256 + kvh * 64; U.V = VB + ebase * 256 + kvh * 64; U.KR = nullptr; U.ldk = 256;
                U.NT = prompt ? 4 : 68; U.C = 0.125f * 1.4426950408889634f; U.thr_raw = 64.0f;
                if (kind == 0) { U.sinkl2 = INP(16)[jj * 16 + h] * 1.4426950408889634f;
                    if (!prompt) { const int q0 = qb * 256; const int ks = q0 - 128 < 0 ? 0 : q0 - 128; const int ke = q0 + 384 > 4096 ? 4096 : q0 + 384; U.kstart = ks; U.NT = 4 + (ke - ks) / 64; } } }
            if (kind == 1) { if constexpr (EN(8)) att::attn_unit<96, false>(U, (char*)lds); }
            else if (kind == 0) { if constexpr (EN(9)) att::attn_unit<64, true>(U, (char*)lds); }
            else { if constexpr (EN(10)) att::attn_unit<64, false>(U, (char*)lds); }
        }
        PH_END
        PH_BEGIN
        if constexpr (EN(11)) { const bfu* wo = WT + (kind == 0 ? WT_A_O + (size_t)jj * 1024 * 1024 : kind == 1 ? WT_B_O : WT_C_O); EpiResid E{X, modl + 2048, (bfu*)(ws + WS_P)}; run_gemm<EpiResid, G_SP2, true>(ldsl, HB, wo, M_ROWS, 1024, 1024, E); }
        PH_END
        PH_BEGIN
        if constexpr (EN(1))
        for (int rep_ = 0; rep_ < REP_NORM; ++rep_)
        for (int r = gw; r < M_ROWS; r += NGW) { const float* mc = modl + cond_of_row(r) * 6144; const bfu* pr = (G == 256 && r < NP_ROWS) ? (const bfu*)(ws + WS_P) + (size_t)r * 1024 : nullptr; norm_row(X + (size_t)r * 1024, pr, ng + 1024, mc + 3072, mc + 4096, HB + (size_t)r * 1024, lane); }
        PH_END
        PH_BEGIN
        for (int rep_ = 0; rep_ < REP_UP; ++rep_)
        if constexpr (EN(12)) { EpiSqRelu E{HID, DFF}; run_gemm(ldsl, HB, WT + WT_MLP_IN + (size_t)layer * DM * DFF, M_ROWS, DFF, DM, E); }
        PH_END
        PH_BEGIN
        if constexpr (EN(11)) { EpiResid E{X, modl + 5120, (bfu*)(ws + WS_P)}; run_gemm<EpiResid, G_SP2, true>(ldsl, HID, WT + WT_MLP_OUT + (size_t)layer * DM * DFF, M_ROWS, DM, DFF, E); }
        PH_END
    }
    { const int layer = 0;
    PH_BEGIN
    if constexpr (EN(1))
    for (int r = gw; r < M_ROWS; r += NGW) {
        float* xr = X + (size_t)r * 1024; f32x4 v[4]; float s = 0.f;
#pragma unroll
        for (int j = 0; j < 4; ++j) { v[j] = *((const f32x4*)xr + lane + 64 * j);
            if (G == 256 && r < NP_ROWS) { const u32x2* pp = (const u32x2*)((const bfu*)(ws + WS_P) + (size_t)r * 1024) + lane + 64 * j;
#pragma unroll
                for (int q = 0; q < 4; ++q) { const u32x2 w = pp[(size_t)q * 1048576]; v[j][0] += __uint_as_float(w.x << 16); v[j][1] += __uint_as_float(w.x & 0xffff0000u); v[j][2] += __uint_as_float(w.y << 16); v[j][3] += __uint_as_float(w.y & 0xffff0000u); } }
            s += (v[j][0] * v[j][0] + v[j][1] * v[j][1]) + (v[j][2] * v[j][2] + v[j][3] * v[j][3]); }
        const float rstd = 1.0f / sqrtf(wave_sum(s) * (1.0f / 1024.0f) + EPS_);
#pragma unroll
        for (int j = 0; j < 4; ++j) { const f32x4 g = *(const f32x4*)(INP(29) + 4 * lane + 256 * j); *((f32x4*)xr + lane + 64 * j) = v[j] * rstd * g; }
    }
    PH_END
    }
#undef PH_BEGIN
#undef PH_END
}

#ifndef MK_MULTI
#define MK_MULTI 0
#endif
extern "C" void kernel_launch(void* const* d_in, const int* in_sizes, int n_in, void* d_out, int out_size, void* d_ws, size_t ws_size, hipStream_t stream) {
    static int grid = 0;
    if (grid == 0) {
        if (n_in != 30 || ws_size < WS_END) { fprintf(stderr, "kernel_launch: n_in %d ws %zu (need %zu)\n", n_in, ws_size, (size_t)WS_END); grid = -1; return; }
        int dev = 0, cus = 0, per_cu = 0;
        hipGetDevice(&dev); hipDeviceGetAttribute(&cus, hipDeviceAttributeMultiprocessorCount, dev);
        if (hipFuncSetAttribute((const void*)mega_fwd, hipFuncAttributeMaxDynamicSharedMemorySize, LDS_BYTES) != hipSuccess) { fprintf(stderr, "kernel_launch: hipFuncSetAttribute failed\n"); grid = -1; return; }
        hipOccupancyMaxActiveBlocksPerMultiprocessor(&per_cu, (const void*)mega_fwd, 512, LDS_BYTES);
        if (per_cu < 1) { fprintf(stderr, "kernel_launch: occupancy query says %d\n", per_cu); per_cu = 1; }
        (void)hipGetLastError();
        grid = cus * 1;
    }
    if (grid < 0) return;
    ArgsH a{};
    for (int i = 0; i < 30; ++i) a.in[i] = (const float*)d_in[i];
    a.out = (float*)d_out; a.ws = (unsigned char*)d_ws;
    if (hipMemsetAsync((char*)d_ws + WS_CTL, 0, 16384, stream) != hipSuccess) { fprintf(stderr, "memset failed\n"); return; }
#if MK_MULTI
    for (int p = 0; p < N_PHASES; ++p) { a.ph_lo = p; a.ph_hi = p + 1; void* kargs[] = {&a}; hipError_t e = hipLaunchKernel((const void*)mega_fwd, dim3(grid), dim3(512), kargs, LDS_BYTES, stream); if (e != hipSuccess) { fprintf(stderr, "launch %d failed: %s\n", p, hipGetErrorString(e)); break; } }
#else
    a.ph_lo = 0; a.ph_hi = N_PHASES;
    void* kargs[] = {&a};
    hipError_t e = hipLaunchCooperativeKernel((const void*)mega_fwd, dim3(grid), dim3(512), kargs, LDS_BYTES, stream);
    if (e != hipSuccess) fprintf(stderr, "cooperative launch failed: %s (grid %d)\n", hipGetErrorString(e), grid);
#endif
}
```

```cpp
#include <hip/hip_runtime.h>
#include <hip/hip_cooperative_groups.h>
#include <cstdio>
#include <cstdint>
namespace cg = cooperative_groups;
#define LAS __attribute__((address_space(3)))
__device__ __forceinline__ int opaque_tid() { int t = threadIdx.x; asm volatile("" : "+v"(t)); return t; }
namespace pg8 {
#define PG8_LAS __attribute__((address_space(3)))
typedef unsigned short bf16_t;
typedef short bf16x8 __attribute__((ext_vector_type(8)));
typedef float f32x4 __attribute__((ext_vector_type(4)));
typedef unsigned u32x4 __attribute__((ext_vector_type(4)));
constexpr int BM = 256, BK = 64, HALF = 128, HTB = HALF * BK * 2  , STAGE_BYTES = 8 * HTB, NXCD = 8, WGM = 8;

__host__ __device__ __forceinline__ int lds_byte(int r, int c) { const int st = (r >> 4) * 2 + (c >> 5), rr = r & 15, cc = c & 31, ob = rr * 64 + cc * 2; return st * 1024 + (ob ^ (((ob >> 9) & 1) << 5)); }
__host__ __device__ __forceinline__ void stage_rc(int b, int& R, int& C) { const int st = b / 1024, sb = b % 1024, swz = sb ^ (((sb >> 9) & 1) << 5); R = (st >> 1) * 16 + swz / 64; C = (st & 1) * 32 + (swz % 64) / 2; }
__host__ __device__ __forceinline__ int perm32(int rho) { const int n = rho >> 4, i = rho & 15; return 8 * (i >> 2) + 4 * n + (i & 3); }

struct Unit { int pm, pn, kt0, nt, split; };
struct Gemm { const bf16_t* A; const bf16_t* Bt; int M, N, K; };

struct StaticOrder {
    int nM, nN, nwg, G, c, ntk, rounds, rem, sp;
    __host__ __device__ void init(int M, int N, int G_, int c_, int ntk_ = 0, bool SPLIT = false) { nM = M / BM; nN = N / BM; nwg = nM * nN; G = G_; c = c_; ntk = ntk_;
        rounds = 0; rem = 0; sp = (SPLIT && G == 256 && nM == 80 && nN == 4 && (ntk & 7) == 0) ? 4 : 1; }
    __host__ __device__ Unit get(int i) const {
        Unit u; u.pm = 0; u.pn = 0; u.kt0 = 0; u.nt = 0; u.split = 0;
        if (sp == 4) {
            if (i == 0) { const int id = (c & 7) * 32 + (c >> 3); u.pm = 16 + (id >> 2); u.pn = id & 3; u.nt = ntk; }
            else if (i == 1) { const int t = c >> 2, part = c & 3; u.pm = t >> 2; u.pn = t & 3; u.nt = ntk >> 2; u.kt0 = part * u.nt; u.split = 1 + part; }
            return u; }
        const long LL = (long)i * G + c;
        if (LL < nwg) {
            int wgid = (int)LL; { const int q = nwg / NXCD, r = nwg % NXCD, xcd = wgid % NXCD, off = wgid / NXCD; wgid = (xcd < r ? xcd * (q + 1) : r * (q + 1) + (xcd - r) * q) + off; }
            const int nig = WGM * nN, gid = wgid / nig, fm = gid * WGM, gsz = (nM - fm) < WGM ? (nM - fm) : WGM;
            u.pm = fm + ((wgid % nig) % gsz); u.pn = (wgid % nig) / gsz; u.nt = ntk; }
        return u; }
    __host__ __device__ bool next(int i, Unit& u) const { u = get(i); return u.nt > 0; }
    __device__ __forceinline__ void a_ready(const Unit&) const {}
    __device__ __forceinline__ void done(const Unit&) const {}
};

__device__ __forceinline__ unsigned cvt_pk_bf16(float lo, float hi) { unsigned r; asm volatile("v_cvt_pk_bf16_f32 %0, %1, %2" : "=v"(r) : "v"(lo), "v"(hi)); return r; }
template <class Epi, class Sched, bool ALIGN_EPI = false, bool SP2 = false>
__device__ __forceinline__ void gemm_phase(PG8_LAS unsigned char* lds, const Gemm g, const Sched& S, const Epi& E) {
    const int tid = opaque_tid(), wid = __builtin_amdgcn_readfirstlane(tid >> 6), lane = tid & 63, wr = wid >> 2, wc = wid & 3, fr = lane & 15, fq = lane >> 4;
    const int K = g.K;
    unsigned voffA[2], voffB[2];
#pragma unroll
    for (int i = 0; i < 2; ++i) { int R, C; stage_rc(tid * 16 + i * 8192, R, C); const int Rb = Epi::PERM ? ((R & ~31) + perm32(R & 31)) : R;
        voffA[i] = (unsigned)(R * K + C) * 2u; voffB[i] = (unsigned)(Rb * K + C) * 2u; }
    const size_t kstep = (size_t)(BK * 2);
    const size_t hstep = (size_t)HALF * K * 2;
    const size_t tstep = 2 * hstep;
    const unsigned ldsw = (unsigned)wid * 1024u;
    const int aoff = lds_byte(wr * 64 + fr, fq * 8), boff = lds_byte(wc * 32 + fr, fq * 8);
#define PG8_SA(b, h) (((b) * 2 + (h)) * HTB)
#define PG8_SB(b, h) ((4 + (b) * 2 + (h)) * HTB)
#define PG8_STAGE(bufoff, gbase, voff) do { _Pragma("unroll") for (int _i = 0; _i < 2; ++_i) \
        __builtin_amdgcn_global_load_lds((const unsigned*)((const char*)(gbase) + (voff)[_i]), (PG8_LAS unsigned*)(lds + (bufoff) + ldsw + _i * 8192), 16, 0, 0); } while (0)
#define PG8_LDA(dst, b, h) do { _Pragma("unroll") for (int m = 0; m < 4; ++m) _Pragma("unroll") for (int k = 0; k < 2; ++k) dst[m][k] = *(const PG8_LAS bf16x8*)(lds + PG8_SA(b, h) + aoff + m * 2048 + k * 1024); } while (0)
#define PG8_LDB(dst, b, h) do { _Pragma("unroll") for (int n = 0; n < 2; ++n) _Pragma("unroll") for (int k = 0; k < 2; ++k) dst[n][k] = *(const PG8_LAS bf16x8*)(lds + PG8_SB(b, h) + boff + n * 2048 + k * 1024); } while (0)
#define PG8_MMA(ai, bj, At, Bt) do { __builtin_amdgcn_s_setprio(1); _Pragma("unroll") for (int m = 0; m < 4; ++m) _Pragma("unroll") for (int n = 0; n < 2; ++n) _Pragma("unroll") for (int k = 0; k < 2; ++k) \
        acc[ai][bj][m][n] = __builtin_amdgcn_mfma_f32_16x16x32_bf16(Bt[n][k], At[m][k], acc[ai][bj][m][n], 0, 0, 0); __builtin_amdgcn_s_setprio(0); } while (0)
#define PG8_WAIT_V(n) asm volatile("s_waitcnt vmcnt(" #n ")" ::: "memory")
#define PG8_WAIT_L(n) asm volatile("s_waitcnt lgkmcnt(" #n ")" ::: "memory")
#define PG8_BAR __builtin_amdgcn_s_barrier()
#define PG8_SCHED __builtin_amdgcn_sched_barrier(0)
    Unit cur, nxt; int ui = 0;
    if (!S.next(0, cur)) return;
    f32x4 acc[2][2][4][2];
#pragma unroll
    for (int a = 0; a < 2; ++a)
#pragma unroll
        for (int b = 0; b < 2; ++b)
#pragma unroll
            for (int m = 0; m < 4; ++m)
#pragma unroll
                for (int n = 0; n < 2; ++n) acc[a][b][m][n] = (f32x4){0.f, 0.f, 0.f, 0.f};
    bf16x8 At[4][2], B0[2][2], B1[2][2];
    const char* cA = (const char*)g.A + (size_t)cur.pm * tstep + (size_t)cur.kt0 * kstep; const char* cB = (const char*)g.Bt + (size_t)cur.pn * tstep + (size_t)cur.kt0 * kstep;
    S.a_ready(cur);
    if constexpr (SP2) {
        PG8_STAGE(PG8_SB(0, 0), cB, voffB); PG8_STAGE(PG8_SB(0, 1), cB + hstep, voffB); PG8_STAGE(PG8_SA(0, 0), cA, voffA); PG8_STAGE(PG8_SA(0, 1), cA + hstep, voffA);
        if (wr == 1) PG8_BAR;
        PG8_WAIT_V(2); PG8_BAR;
        PG8_STAGE(PG8_SB(1, 0), cB + kstep, voffB); PG8_STAGE(PG8_SA(1, 0), cA + kstep, voffA); PG8_STAGE(PG8_SB(1, 1), cB + hstep + kstep, voffB);
        PG8_WAIT_V(6); PG8_BAR;
    } else {
        PG8_STAGE(PG8_SB(0, 0), cB, voffB); PG8_STAGE(PG8_SA(0, 0), cA, voffA); PG8_STAGE(PG8_SB(0, 1), cB + hstep, voffB); PG8_STAGE(PG8_SA(0, 1), cA + hstep, voffA);
        if (wr == 1) PG8_BAR;
        PG8_WAIT_V(4); PG8_BAR;
        PG8_STAGE(PG8_SB(1, 0), cB + kstep, voffB); PG8_STAGE(PG8_SA(1, 0), cA + kstep, voffA); PG8_STAGE(PG8_SB(1, 1), cB + hstep + kstep, voffB);
        PG8_WAIT_V(6); PG8_BAR;
    }
    for (;;) {
        const bool has_next = S.next(ui + 1, nxt);
        const char* nA = has_next ? (const char*)g.A + (size_t)nxt.pm * tstep + (size_t)nxt.kt0 * kstep : cA; const char* nB = has_next ? (const char*)g.Bt + (size_t)nxt.pn * tstep + (size_t)nxt.kt0 * kstep : cB;
        const int nt = cur.nt;
        for (int t = 0; t < nt; t += 2) {
            asm volatile("" : "+v"(voffA[0]), "+v"(voffA[1]), "+v"(voffB[0]), "+v"(voffB[1]));
            const bool last = (t == nt - 2);
            const char* a1 = cA + (size_t)(t + 1) * kstep;
            const char* a2 = last ? nA : cA + (size_t)(t + 2) * kstep; const char* b2 = last ? nB : cB + (size_t)(t + 2) * kstep;
            const char* a3 = a2 + kstep; const char* b3 = b2 + kstep;
            if (last && has_next) S.a_ready(nxt);
            if constexpr (SP2) {
            PG8_LDB(B0, 0, 0); PG8_LDB(B1, 0, 1); PG8_SCHED; PG8_LDA(At, 0, 0); PG8_STAGE(PG8_SA(1, 1), a1 + hstep, voffA);
            PG8_WAIT_V(8); PG8_WAIT_L(0); PG8_BAR; PG8_MMA(0, 0, At, B0); PG8_MMA(0, 1, At, B1); PG8_BAR; PG8_SCHED;
            PG8_LDA(At, 0, 1); PG8_STAGE(PG8_SB(0, 0), b2, voffB); PG8_STAGE(PG8_SB(0, 1), b2 + hstep, voffB); PG8_STAGE(PG8_SA(0, 0), a2, voffA);
            PG8_WAIT_V(8); PG8_WAIT_L(0); PG8_BAR; PG8_MMA(1, 0, At, B0); PG8_MMA(1, 1, At, B1); PG8_BAR; PG8_SCHED;
            PG8_LDB(B0, 1, 0); PG8_LDB(B1, 1, 1); PG8_SCHED; PG8_LDA(At, 1, 0); PG8_STAGE(PG8_SA(0, 1), a2 + hstep, voffA);
            PG8_WAIT_V(8); PG8_WAIT_L(0); PG8_BAR; PG8_MMA(0, 0, At, B0); PG8_MMA(0, 1, At, B1); PG8_BAR; PG8_SCHED;
            PG8_LDA(At, 1, 1); PG8_STAGE(PG8_SB(1, 0), b3, voffB); PG8_STAGE(PG8_SB(1, 1), b3 + hstep, voffB); PG8_STAGE(PG8_SA(1, 0), a3, voffA);
            PG8_WAIT_V(8); PG8_WAIT_L(0); PG8_BAR; PG8_MMA(1, 0, At, B0); PG8_MMA(1, 1, At, B1); PG8_BAR; PG8_SCHED;
            } else {
            PG8_LDB(B0, 0, 0); PG8_SCHED; PG8_LDA(At, 0, 0); PG8_STAGE(PG8_SA(1, 1), a1 + hstep, voffA);
            PG8_WAIT_L(8); PG8_BAR; PG8_WAIT_L(0); PG8_MMA(0, 0, At, B0); PG8_BAR; PG8_SCHED;
            PG8_LDB(B1, 0, 1); PG8_STAGE(PG8_SB(0, 0), b2, voffB);
            PG8_BAR; PG8_WAIT_L(0); PG8_MMA(0, 1, At, B1); PG8_BAR;
            PG8_LDA(At, 0, 1); PG8_STAGE(PG8_SA(0, 0), a2, voffA);
            PG8_BAR; PG8_WAIT_L(0); PG8_MMA(1, 0, At, B0); PG8_BAR; PG8_SCHED;
            PG8_STAGE(PG8_SB(0, 1), b2 + hstep, voffB);
            PG8_WAIT_V(6); PG8_BAR; PG8_MMA(1, 1, At, B1); PG8_BAR;
            PG8_LDB(B0, 1, 0); PG8_SCHED; PG8_LDA(At, 1, 0); PG8_STAGE(PG8_SA(0, 1), a2 + hstep, voffA);
            PG8_WAIT_L(8); PG8_BAR; PG8_WAIT_L(0); PG8_MMA(0, 0, At, B0); PG8_BAR; PG8_SCHED;
            PG8_LDB(B1, 1, 1); PG8_STAGE(PG8_SB(1, 0), b3, voffB);
            PG8_BAR; PG8_WAIT_L(0); PG8_MMA(0, 1, At, B1); PG8_BAR;
            PG8_LDA(At, 1, 1); PG8_STAGE(PG8_SA(1, 0), a3, voffA);
            PG8_BAR; PG8_WAIT_L(0); PG8_MMA(1, 0, At, B0); PG8_BAR; PG8_SCHED;
            PG8_STAGE(PG8_SB(1, 1), b3 + hstep, voffB);
            PG8_WAIT_V(6); PG8_BAR; PG8_MMA(1, 1, At, B1); PG8_BAR;
            }
        }
        if constexpr (ALIGN_EPI) { if (wr == 0) PG8_BAR; }
        if constexpr (!Epi::AFTER_DRAIN) { E(acc, cur, wr, wc, fr, fq); S.done(cur); }
        if (!has_next) break;
#pragma unroll
        for (int a = 0; a < 2; ++a)
#pragma unroll
            for (int b = 0; b < 2; ++b)
#pragma unroll
                for (int m = 0; m < 4; ++m)
#pragma unroll
                    for (int n = 0; n < 2; ++n) acc[a][b][m][n] = (f32x4){0.f, 0.f, 0.f, 0.f};
        cur = nxt; cA = nA; cB = nB; ++ui;
        if constexpr (ALIGN_EPI) { if (wr == 1) PG8_BAR; }
    }
    PG8_WAIT_V(0);
    if constexpr (!ALIGN_EPI) { if (wr == 0) PG8_BAR; }
    PG8_BAR;
    if constexpr (Epi::AFTER_DRAIN) { E.fused(acc, cur, wr, wc, fr, fq, lds, wid, lane); S.done(cur); }
#undef PG8_SA
#undef PG8_SB
#undef PG8_STAGE
#undef PG8_LDA
#undef PG8_LDB
#undef PG8_MMA
#undef PG8_WAIT_V
#undef PG8_WAIT_L
#undef PG8_BAR
#undef PG8_SCHED
}
}
namespace att {
using bf16x8 = __attribute__((ext_vector_type(8))) short;
using s16x4  = __attribute__((ext_vector_type(4))) short;
using f32x16 = __attribute__((ext_vector_type(16))) float;
using u32x4  = __attribute__((ext_vector_type(4))) unsigned;
using u32x2  = __attribute__((ext_vector_type(2))) unsigned;
constexpr int NW = 8, QBLK = 32, KVBLK = 64;
constexpr int SHM_V = 16384, SHM_K = 16384, SHM_ATTN = 3 * SHM_V + 3 * SHM_K + NW * 64 * 4;
#define KSWZ(row, colB) ((row) * 256 + ((colB) ^ (((row) & 7) << 4)))
#define SBAR() __builtin_amdgcn_sched_barrier(0)
__device__ __forceinline__ int crow(int r, int hi) { return (r & 3) + 8 * (r >> 2) + 4 * hi; }
__device__ __forceinline__ unsigned cvtpk(float lo, float hi) { unsigned r; asm volatile("v_cvt_pk_bf16_f32 %0, %1, %2" : "=v"(r) : "v"(lo), "v"(hi)); return r; }

#define MX3(a, b, c) __builtin_fmaxf(__builtin_fmaxf((a), (b)), (c))
template <bool FIRST>
__device__ __forceinline__ void partialSM(f32x16& p0, f32x16& p1, float& m_reg, f32x16& negm, float& alpha, const float thr) {
  float a = MX3(p0[0], p0[1], p1[0]), b = MX3(p0[2], p0[3], p1[1]); a = MX3(a, p1[2], p1[3]);
#pragma unroll
  for (int r = 4; r < 16; r += 4) { a = MX3(a, p0[r], p0[r + 1]); b = MX3(b, p0[r + 2], p0[r + 3]); a = MX3(a, p1[r], p1[r + 1]); b = MX3(b, p1[r + 2], p1[r + 3]); }
  float pmax = fmaxf(a, b);
  { auto rr = __builtin_amdgcn_permlane32_swap(__float_as_uint(pmax), __float_as_uint(pmax), false, false);
    pmax = fmaxf(__uint_as_float(rr[0]), __uint_as_float(rr[1])); }
  alpha = 1.f;
  if (FIRST || !__builtin_expect(__all(pmax <= thr), 1)) {
    const float dl = FIRST ? pmax : fmaxf(pmax, 0.f);
    alpha = __builtin_amdgcn_exp2f(-dl); m_reg += dl;
#pragma unroll
    for (int r = 0; r < 16; ++r) { p0[r] -= dl; p1[r] -= dl; }
#pragma unroll
    for (int r = 0; r < 16; ++r) negm[r] = -m_reg;
  }
#pragma unroll
  for (int r = 0; r < 16; ++r) p0[r] = __builtin_amdgcn_exp2f(p0[r]);
}
__device__ __forceinline__ void finishSM(f32x16& p0, f32x16& p1, bf16x8& pa0, bf16x8& pa1, bf16x8& pa2, bf16x8& pa3) {
#pragma unroll
  for (int r = 0; r < 16; ++r) p1[r] = __builtin_amdgcn_exp2f(p1[r]);
#define PK4(P, BASE, OUT) do { unsigned a0 = cvtpk(P[BASE + 0], P[BASE + 1]), a1 = cvtpk(P[BASE + 2], P[BASE + 3]);   \
    unsigned b0 = cvtpk(P[BASE + 4], P[BASE + 5]), b1 = cvtpk(P[BASE + 6], P[BASE + 7]);                              \
    auto r0 = __builtin_amdgcn_permlane32_swap(a0, b0, false, false); auto r1 = __builtin_amdgcn_permlane32_swap(a1, b1, false, false); \
    u32x4 w = {r0[0], r1[0], r0[1], r1[1]}; OUT = *reinterpret_cast<bf16x8*>(&w); } while (0)
  PK4(p0, 0, pa0); PK4(p0, 8, pa1); PK4(p1, 0, pa2); PK4(p1, 8, pa3);
#undef PK4
}
template <int DQK>
__device__ __forceinline__ void qkt(f32x16& p0, f32x16& p1, const char* Ks, const bf16x8* qr, const f32x16& negm, int r32, int hi) {
  p0 = negm; p1 = negm;
  __builtin_amdgcn_s_setprio(1);
#pragma unroll
  for (int d0 = 0; d0 < DQK / 16; ++d0) { int cb = (d0 * 16 + hi * 8) * 2;
    bf16x8 b0 = *reinterpret_cast<const bf16x8*>(Ks + KSWZ(r32, cb));
    bf16x8 b1 = *reinterpret_cast<const bf16x8*>(Ks + KSWZ(32 + r32, cb));
    p0 = __builtin_amdgcn_mfma_f32_32x32x16_bf16(b0, qr[d0], p0, 0, 0, 0);
    p1 = __builtin_amdgcn_mfma_f32_32x32x16_bf16(b1, qr[d0], p1, 0, 0, 0); }
  __builtin_amdgcn_s_setprio(0);
}
__device__ __forceinline__ int v_st(int k, int c) { const int kk = (k & ~0xC) | ((k & 4) << 1) | ((k & 8) >> 1); return ((kk >> 3) * 4 + (c >> 5)) * 512 + ((kk & 7) * 32 + (c & 31)) * 2; }
__device__ __forceinline__ int v_rd_base(int lane) { return ((lane & 3) << 3) | (((lane >> 2) & 3) << 6) | (((lane >> 4) & 1) << 5) | (((lane >> 5) & 1) << 8); }
constexpr int v_rd_off(int d0, int ks, int half) { return d0 * 512 + ks * 4096 + half * 2048; }
template <int OFF> __device__ __forceinline__ s16x4 tr_read(int vb) {
  s16x4 r; asm volatile("ds_read_b64_tr_b16 %0, %1 offset:%2" : "=&v"(r) : "v"(vb), "i"(OFF) : "memory"); return r;
}
struct VFrag { s16x4 l[4], h[4]; };
template <int D0> __device__ __forceinline__ void v_reads(VFrag& f, int vb) {
  f.l[0] = tr_read<v_rd_off(D0, 0, 0)>(vb); f.h[0] = tr_read<v_rd_off(D0, 0, 1)>(vb); f.l[1] = tr_read<v_rd_off(D0, 1, 0)>(vb); f.h[1] = tr_read<v_rd_off(D0, 1, 1)>(vb);
  f.l[2] = tr_read<v_rd_off(D0, 2, 0)>(vb); f.h[2] = tr_read<v_rd_off(D0, 2, 1)>(vb); f.l[3] = tr_read<v_rd_off(D0, 3, 0)>(vb); f.h[3] = tr_read<v_rd_off(D0, 3, 1)>(vb);
}
__device__ __forceinline__ void pv_mma(f32x16* o, f32x16& lacc, VFrag& f, int vb, bf16x8 pa0, bf16x8 pa1, bf16x8 pa2, bf16x8 pa3) {
  const bf16x8 ones = {0x3F80, 0x3F80, 0x3F80, 0x3F80, 0x3F80, 0x3F80, 0x3F80, 0x3F80};
  asm volatile("s_waitcnt lgkmcnt(0)" ::: "memory"); SBAR();
#define PK(L, H) (bf16x8){L[0], L[1], L[2], L[3], H[0], H[1], H[2], H[3]}
  o[0] = __builtin_amdgcn_mfma_f32_32x32x16_bf16(pa0, PK(f.l[0], f.h[0]), o[0], 0, 0, 0);
  o[0] = __builtin_amdgcn_mfma_f32_32x32x16_bf16(pa1, PK(f.l[1], f.h[1]), o[0], 0, 0, 0);
  o[0] = __builtin_amdgcn_mfma_f32_32x32x16_bf16(pa2, PK(f.l[2], f.h[2]), o[0], 0, 0, 0);
  o[0] = __builtin_amdgcn_mfma_f32_32x32x16_bf16(pa3, PK(f.l[3], f.h[3]), o[0], 0, 0, 0);
  SBAR(); v_reads<1>(f, vb); SBAR();
  lacc = __builtin_amdgcn_mfma_f32_32x32x16_bf16(pa0, ones, lacc, 0, 0, 0);
  lacc = __builtin_amdgcn_mfma_f32_32x32x16_bf16(pa1, ones, lacc, 0, 0, 0);
  lacc = __builtin_amdgcn_mfma_f32_32x32x16_bf16(pa2, ones, lacc, 0, 0, 0);
  lacc = __builtin_amdgcn_mfma_f32_32x32x16_bf16(pa3, ones, lacc, 0, 0, 0);
  asm volatile("s_waitcnt lgkmcnt(0)" ::: "memory"); SBAR();
  o[1] = __builtin_amdgcn_mfma_f32_32x32x16_bf16(pa0, PK(f.l[0], f.h[0]), o[1], 0, 0, 0);
  o[1] = __builtin_amdgcn_mfma_f32_32x32x16_bf16(pa1, PK(f.l[1], f.h[1]), o[1], 0, 0, 0);
  o[1] = __builtin_amdgcn_mfma_f32_32x32x16_bf16(pa2, PK(f.l[2], f.h[2]), o[1], 0, 0, 0);
  o[1] = __builtin_amdgcn_mfma_f32_32x32x16_bf16(pa3, PK(f.l[3], f.h[3]), o[1], 0, 0, 0);
#undef PK
}
struct Unit {
  const unsigned short* Q; const unsigned short* K; const unsigned short* KR; const unsigned short* V; unsigned short* O;
  int ldq, ldk, NT, kstart, q0;
  float C, thr_raw, sinkl2;
};
__device__ __forceinline__ void wmask(f32x16& p0, f32x16& p1, int tilepos, int qpos, int hi) {
#pragma unroll
  for (int r = 0; r < 16; ++r) { const int k0 = tilepos + crow(r, hi); int d0 = qpos - k0; d0 = d0 < 0 ? -d0 : d0; int d1 = qpos - (k0 + 32); d1 = d1 < 0 ? -d1 : d1;
    if (d0 > 128) p0[r] = -1e30f; if (d1 > 128) p1[r] = -1e30f; }
}
template <int DQK, bool WINDOW>
__device__ __forceinline__ void attn_unit(const Unit& U, char* lds) {
  const int tid = opaque_tid(), wid = __builtin_amdgcn_readfirstlane(tid >> 6), lane = tid & 63, r32 = lane & 31, hi = lane >> 5;
  char* V_lds = lds; char* K_lds = lds + 3 * SHM_V;
  float* ws = (float*)(lds + 3 * SHM_V + 3 * SHM_K) + wid * 64; float* li_l = ws; float* al_l = ws + 32;
  const float thr = 11.5415603f;
  float m_reg = 0.f; f32x16 o[2] = {}; f32x16 lacc = {}; f32x16 negm = {}; bf16x8 qr[DQK / 16];
  const unsigned short* Qw = U.Q + (long)(wid * QBLK + r32) * U.ldq + hi * 8;
#pragma unroll
  for (int d0 = 0; d0 < DQK / 16; ++d0) qr[d0] = *reinterpret_cast<const bf16x8*>(Qw + d0 * 16);
  const int sr = tid >> 3, sc = (tid & 7) * 8, vst0 = v_st(sr, sc), kst0 = KSWZ(sr, sc * 2);
  const int srr = (tid >> 2) & 63, scr = (tid & 3) * 8, kst1 = KSWZ(srr, (64 + scr) * 2);
  const bool do_r = (DQK == 96) && (tid < 256);
  const int vb0 = (int)(uintptr_t)V_lds + v_rd_base(lane);
  const int ldk = U.ldk, kstart = U.kstart;
  const int qpos = U.q0 + wid * QBLK + r32; const int qlo = U.q0 + wid * QBLK;
  struct { bf16x8 vs, ks, rs; } sr_[3];
#define KROW(j) ((long)(64 * (j) + ((j) >= 4 ? kstart : 0)))
#define SLOAD(i, j) do { const long kr_ = KROW(j); sr_[i].vs = *reinterpret_cast<const bf16x8*>(U.V + (kr_ + sr) * ldk + sc); \
    sr_[i].ks = *reinterpret_cast<const bf16x8*>(U.K + (kr_ + sr) * ldk + sc); \
    if (DQK == 96) { if (do_r) sr_[i].rs = *reinterpret_cast<const bf16x8*>(U.KR + (kr_ + srr) * 32 + scr); } } while (0)
#define SWRITE(soff, i) do { *(bf16x8*)(V_lds + (soff) + vst0) = sr_[i].vs; *(bf16x8*)(K_lds + (soff) + kst0) = sr_[i].ks; \
    if (DQK == 96) { if (do_r) *(bf16x8*)(K_lds + (soff) + kst1) = sr_[i].rs; } } while (0)
#define RESC(a) do { if (__any((a) < 1.f)) { if (hi == 0) al_l[r32] = (a); asm volatile("s_waitcnt lgkmcnt(0)" ::: "memory"); \
    _Pragma("unroll") for (int r = 0; r < 16; ++r) { const float f_ = al_l[crow(r, hi)]; o[0][r] *= f_; o[1][r] *= f_; lacc[r] *= f_; } } } while (0)
#define WMASK(P0, P1, j) do { if (WINDOW) { if ((j) >= 4) wmask(P0, P1, kstart + 64 * ((j) - 4), qpos, hi); } } while (0)
#define QKM(P0, P1, KP, j, SK) do { SK = false; \
    if (WINDOW && (j) >= 4) { const int tp_ = kstart + 64 * ((j) - 4); \
      if (tp_ + 63 < qlo - 128 || tp_ > qlo + 31 + 128) { SK = true; _Pragma("unroll") for (int r_ = 0; r_ < 16; ++r_) { P0[r_] = 0.f; P1[r_] = 0.f; } } \
      else { qkt<DQK>(P0, P1, KP, qr, negm, r32, hi); if (!(tp_ >= qlo + 31 - 128 && tp_ + 63 <= qlo + 128)) wmask(P0, P1, tp_, qpos, hi); } } \
    else qkt<DQK>(P0, P1, KP, qr, negm, r32, hi); } while (0)
#define LIVE(SK) (!(WINDOW && (SK)))
#define ROT() do { const int t_ = s_prev; s_prev = s_cur; s_cur = s_next; s_next = t_; } while (0)
  static_assert(SHM_V == SHM_K, "one slot offset serves both rings");
  f32x16 pA0, pA1, pB0, pB1; float alA, alB; bool skA = false, skB = false; bf16x8 pa0, pa1, pa2, pa3; const int NT = U.NT; VFrag vf;
  int s_prev = 2 * SHM_V, s_cur = 0, s_next = SHM_V;
  SLOAD(1, 0); SLOAD(2, 1); if (2 < NT) SLOAD(0, 2);
  SWRITE(0, 1); SWRITE(SHM_V, 2);
  __syncthreads();
  qkt<DQK>(pA0, pA1, K_lds, qr, negm, r32, hi); partialSM<true>(pA0, pA1, m_reg, negm, alA, thr);
  ROT();
  for (int j = 1; j + 1 < NT; j += 2) {
    SWRITE(s_next, 0); if (j + 2 < NT) SLOAD(0, j + 2);
    SBAR(); QKM(pB0, pB1, K_lds + s_cur, j, skB);
    if (LIVE(skA)) { v_reads<0>(vf, vb0 + s_prev); finishSM(pA0, pA1, pa0, pa1, pa2, pa3); pv_mma(o, lacc, vf, vb0 + s_prev, pa0, pa1, pa2, pa3); }
    if (LIVE(skB)) partialSM<false>(pB0, pB1, m_reg, negm, alB, thr); else alB = 1.f;
    __syncthreads(); RESC(alB); ROT();
    if (j + 2 < NT) SWRITE(s_next, 0); if (j + 3 < NT) SLOAD(0, j + 3);
    SBAR(); QKM(pA0, pA1, K_lds + s_cur, j + 1, skA);
    if (LIVE(skB)) { v_reads<0>(vf, vb0 + s_prev); finishSM(pB0, pB1, pa0, pa1, pa2, pa3); pv_mma(o, lacc, vf, vb0 + s_prev, pa0, pa1, pa2, pa3); }
    if (LIVE(skA)) partialSM<false>(pA0, pA1, m_reg, negm, alA, thr); else alA = 1.f;
    __syncthreads(); RESC(alA); ROT();
  }
  SBAR(); QKM(pB0, pB1, K_lds + s_cur, NT - 1, skB);
  if (LIVE(skA)) { v_reads<0>(vf, vb0 + s_prev); finishSM(pA0, pA1, pa0, pa1, pa2, pa3); pv_mma(o, lacc, vf, vb0 + s_prev, pa0, pa1, pa2, pa3); }
  if (LIVE(skB)) {
    partialSM<false>(pB0, pB1, m_reg, negm, alB, thr);
    RESC(alB);
    SBAR(); v_reads<0>(vf, vb0 + s_cur); SBAR();
    finishSM(pB0, pB1, pa0, pa1, pa2, pa3);
    pv_mma(o, lacc, vf, vb0 + s_cur, pa0, pa1, pa2, pa3);
  }
  if (hi == 0) li_l[r32] = __builtin_amdgcn_exp2f(fmaxf(U.sinkl2 - m_reg, -126.f));
  asm volatile("s_waitcnt lgkmcnt(0)" ::: "memory");
  float rli[16];
#pragma unroll
  for (int r = 0; r < 16; ++r) rli[r] = __builtin_amdgcn_rcpf(lacc[r] + li_l[crow(r, hi)]);
  unsigned short* Ow = U.O + (long)(wid * QBLK) * 1024;
#pragma unroll
  for (int r = 0; r < 16; ++r) { const int orow = crow(r, hi);
#pragma unroll
    for (int d0 = 0; d0 < 2; ++d0) { const float lo = o[d0][r] * rli[r]; const unsigned pk = cvtpk(lo, lo); Ow[(long)orow * 1024 + d0 * 32 + r32] = (unsigned short)(pk & 0xffffu); } }
  __syncthreads();
#undef KROW
#undef SLOAD
#undef SWRITE
#undef RESC
#undef WMASK
#undef QKM
#undef LIVE
#undef ROT
}
#undef SBAR
}
constexpr int DM = 1024, NP_ROWS = 4096, NS_ROWS = 16384, M_ROWS = 20480, EXT_ROWS = 21504, EXT_B = 4352, DFF = 4096;
constexpr float EPS_ = 1e-6f;
constexpr float LOG2_THETA = 13.287712379549449f;
constexpr float INV_2PI = 0.15915494309189535f;
typedef unsigned short bfu;
typedef float f32x4 __attribute__((ext_vector_type(4)));
typedef unsigned u32x4 __attribute__((ext_vector_type(4)));
typedef unsigned u32x2 __attribute__((ext_vector_type(2)));
__device__ __forceinline__ unsigned pkbf(float lo, float hi) { return pg8::cvt_pk_bf16(lo, hi); }
__device__ __forceinline__ void rope_cs(int pos, int i, float inv_den, float& c, float& s) {
    const float f = __builtin_amdgcn_exp2f(-(float)i * (LOG2_THETA * inv_den));
    const float rev = (float)pos * f * INV_2PI;
    c = __builtin_amdgcn_cosf(rev); s = __builtin_amdgcn_sinf(rev);
}
__device__ __forceinline__ int cond_of_row(int row) { return row < NP_ROWS ? 4 : ((row - NP_ROWS) >> 12); }
__device__ __forceinline__ int ext_of_row(int row) { return row < NP_ROWS ? row : (NP_ROWS + ((row - NP_ROWS) >> 12) * EXT_B + 256 + ((row - NP_ROWS) & 4095)); }

#define EPI_FENCE() asm volatile("" ::: "memory")
template <bool NORMC> struct EpiQKV {
    static constexpr bool PERM = false, AFTER_DRAIN = false;
    bfu* Q; bfu* Kb; bfu* Vb; float* stK; float* stV; const float* gq; const float* gk; int nstate;
    __device__ __forceinline__ void operator()(const f32x4 (&acc)[2][2][4][2], const pg8::Unit& u, int wr, int wc, int fr, int fq) const {
        asm volatile("" : "+v"(fr), "+v"(fq));
        const int pn = u.pn; const bool isQ = pn < 4, isK = pn == 4; const bool sample = u.pm >= 16;
        const bool dorope = sample && pn < 5;
        float frq[4];
#pragma unroll
        for (int j = 0; j < 4; ++j) frq[j] = __builtin_amdgcn_exp2f(-(float)(4 * fq + j) * (LOG2_THETA / 16.0f)) * INV_2PI;
        const unsigned cq = 64 * wc + 4 * fq;
#pragma unroll
        for (int ai = 0; ai < 2; ++ai)
#pragma unroll
            for (int m = 0; m < 4; ++m) {
                unsigned row = u.pm * 256 + ai * 128 + wr * 64 + m * 16 + fr; asm volatile("" : "+v"(row));
                f32x4 v[2][2];
#pragma unroll
                for (int bj = 0; bj < 2; ++bj)
#pragma unroll
                    for (int n = 0; n < 2; ++n) v[bj][n] = acc[ai][bj][m][n];
                if (NORMC && pn < 5) {
                    float ss = 0.f;
#pragma unroll
                    for (int bj = 0; bj < 2; ++bj)
#pragma unroll
                        for (int n = 0; n < 2; ++n) ss += (v[bj][n][0] * v[bj][n][0] + v[bj][n][1] * v[bj][n][1]) + (v[bj][n][2] * v[bj][n][2] + v[bj][n][3] * v[bj][n][3]);
                    ss += __shfl_xor(ss, 16); ss += __shfl_xor(ss, 32);
                    const float rstd = 1.0f / sqrtf(ss * (1.0f / 64.0f) + EPS_);
                    const float* g = (isQ ? gq : gk) + 4 * fq;
#pragma unroll
                    for (int bj = 0; bj < 2; ++bj)
#pragma unroll
                        for (int n = 0; n < 2; ++n) { const f32x4 gv = *(const f32x4*)(g + 32 * bj + 16 * n); v[bj][n] = v[bj][n] * rstd * gv; }
                }
                const unsigned t = (row - NP_ROWS) & 4095u;
                if (dorope) {
#pragma unroll
                    for (int bj = 0; bj < 2; ++bj) { const float pos = (float)(bj == 0 ? (t >> 6) : (t & 63u));
#pragma unroll
                        for (int j = 0; j < 4; ++j) { const float rev = pos * frq[j]; const float c = __builtin_amdgcn_cosf(rev), s = __builtin_amdgcn_sinf(rev); const float x1 = v[bj][0][j], x2 = v[bj][1][j];
                            v[bj][0][j] = x1 * c - x2 * s; v[bj][1][j] = x1 * s + x2 * c; } }
                }
                if (isQ) { bfu* p = Q + (row * 1024u + 256u * pn + cq);
#pragma unroll
                    for (int bj = 0; bj < 2; ++bj)
#pragma unroll
                        for (int n = 0; n < 2; ++n) { const f32x4 x = v[bj][n] * (0.125f * 1.4426950408889634f);     u32x2 w; w.x = pkbf(x[0], x[1]); w.y = pkbf(x[2], x[3]); *(u32x2*)(p + 32 * bj + 16 * n) = w; }
                } else {
                    const unsigned e = sample ? (NP_ROWS + ((row - NP_ROWS) >> 12) * EXT_B + 256u + t) : row;
                    bfu* p = (isK ? Kb : Vb) + (e * 256u + cq);
#pragma unroll
                    for (int bj = 0; bj < 2; ++bj)
#pragma unroll
                        for (int n = 0; n < 2; ++n) { const f32x4 x = v[bj][n]; u32x2 w; w.x = pkbf(x[0], x[1]); w.y = pkbf(x[2], x[3]); *(u32x2*)(p + 32 * bj + 16 * n) = w; }
                    if (!sample) { float* st = (isK ? stK : stV) + ((((row >> 8) * nstate) * 256u + (row & 255u)) * 256u + cq);
#pragma unroll
                        for (int bj = 0; bj < 2; ++bj)
#pragma unroll
                            for (int n = 0; n < 2; ++n) *(f32x4*)(st + 32 * bj + 16 * n) = v[bj][n]; }
                }
                EPI_FENCE();
            }
    }
};
struct EpiResid {
    static constexpr bool PERM = true, AFTER_DRAIN = false;
    float* x; const float* gate; bfu* P; const float* xin;
    __device__ __forceinline__ void operator()(const f32x4 (&acc)[2][2][4][2], const pg8::Unit& u, int wr, int wc, int fr, int fq) const {
        asm volatile("" : "+v"(fr), "+v"(fq));
        const int cond = cond_of_row(u.pm * 256); const unsigned c0 = u.pn * 256 + wc * 32 + 8 * fq; const float* g = gate + cond * 6144 + c0;
#pragma unroll
        for (int ai = 0; ai < 2; ++ai)
#pragma unroll
            for (int m = 0; m < 4; ++m) { const unsigned row = u.pm * 256 + ai * 128 + wr * 64 + m * 16 + fr; const unsigned off = row * 1024u + c0;
#pragma unroll
                for (int bj = 0; bj < 2; ++bj) { const f32x4 g0 = *(const f32x4*)(g + bj * 128), g1 = *(const f32x4*)(g + bj * 128 + 4);
                    const f32x4 y0 = g0 * acc[ai][bj][m][0], y1 = g1 * acc[ai][bj][m][1]; const unsigned o2 = off + bj * 128;
                    if (u.split) { u32x4 w; w.x = pkbf(y0[0], y0[1]); w.y = pkbf(y0[2], y0[3]); w.z = pkbf(y1[0], y1[1]); w.w = pkbf(y1[2], y1[3]); *(u32x4*)(P + ((size_t)(u.split - 1) * 4096 * 1024 + o2)) = w; }
                    else { const f32x4 b0 = *(const f32x4*)(xin + o2), b1 = *(const f32x4*)(xin + o2 + 4); *(f32x4*)(x + o2) = b0 + y0; *(f32x4*)(x + o2 + 4) = b1 + y1; } }
                EPI_FENCE(); }
    }
};
struct EpiSqRelu {
    static constexpr bool PERM = true, AFTER_DRAIN = false;
    bfu* O; int ldc;
    __device__ __forceinline__ void operator()(const f32x4 (&acc)[2][2][4][2], const pg8::Unit& u, int wr, int wc, int fr, int fq) const {
        asm volatile("" : "+v"(fr), "+v"(fq));
#pragma unroll
        for (int ai = 0; ai < 2; ++ai)
#pragma unroll
            for (int m = 0; m < 4; ++m) { const unsigned row = u.pm * 256 + ai * 128 + wr * 64 + m * 16 + fr; bfu* p = O + ((size_t)row * ldc + u.pn * 256 + wc * 32 + 8 * fq);
#pragma unroll
                for (int bj = 0; bj < 2; ++bj) { f32x4 v0 = acc[ai][bj][m][0], v1 = acc[ai][bj][m][1];
#pragma unroll
                    for (int j = 0; j < 4; ++j) { const float a = fmaxf(v0[j], 0.f), b = fmaxf(v1[j], 0.f); v0[j] = a * a; v1[j] = b * b; }
                    u32x4 w; w.x = pkbf(v0[0], v0[1]); w.y = pkbf(v0[2], v0[3]); w.z = pkbf(v1[0], v1[1]); w.w = pkbf(v1[2], v1[3]);
                    *(u32x4*)(p + bj * 128) = w; }
                EPI_FENCE(); }
    }
};
struct EpiUKV {
    static constexpr bool PERM = true, AFTER_DRAIN = false;
    bfu* Kn; bfu* Vb;
    __device__ __forceinline__ void operator()(const f32x4 (&acc)[2][2][4][2], const pg8::Unit& u, int wr, int wc, int fr, int fq) const {
        asm volatile("" : "+v"(fr), "+v"(fq));
        bfu* base = (wc < 2 ? Kn : Vb) + (2 * u.pn * 64 + 32 * (wc & 1) + 8 * fq);
#pragma unroll
        for (int ai = 0; ai < 2; ++ai)
#pragma unroll
            for (int m = 0; m < 4; ++m) { const unsigned row = u.pm * 256 + ai * 128 + wr * 64 + m * 16 + fr; bfu* p = base + row * 1024u;
#pragma unroll
                for (int bj = 0; bj < 2; ++bj) { const f32x4 v0 = acc[ai][bj][m][0], v1 = acc[ai][bj][m][1];
                    u32x4 w; w.x = pkbf(v0[0], v0[1]); w.y = pkbf(v0[2], v0[3]); w.z = pkbf(v1[0], v1[1]); w.w = pkbf(v1[2], v1[3]);
                    *(u32x4*)(p + bj * 64) = w; }
                EPI_FENCE(); }
    }
};
struct EpiF32 {
    static constexpr bool PERM = true, AFTER_DRAIN = false;
    bfu* T; int ldc;
    __device__ __forceinline__ void operator()(const f32x4 (&acc)[2][2][4][2], const pg8::Unit& u, int wr, int wc, int fr, int fq) const {
        asm volatile("" : "+v"(fr), "+v"(fq));
#pragma unroll
        for (int ai = 0; ai < 2; ++ai)
#pragma unroll
            for (int m = 0; m < 4; ++m) { const unsigned row = u.pm * 256 + ai * 128 + wr * 64 + m * 16 + fr; bfu* p = T + ((size_t)row * ldc + u.pn * 256 + wc * 32 + 8 * fq);
#pragma unroll
                for (int bj = 0; bj < 2; ++bj) { const f32x4 v0 = acc[ai][bj][m][0], v1 = acc[ai][bj][m][1];
                    u32x4 w; w.x = pkbf(v0[0], v0[1]); w.y = pkbf(v0[2], v0[3]); w.z = pkbf(v1[0], v1[1]); w.w = pkbf(v1[2], v1[3]); *(u32x4*)(p + bj * 128) = w; }
                EPI_FENCE(); }
    }
};
struct EpiUQ {
    static constexpr bool PERM = false, AFTER_DRAIN = false;
    bfu* Q;
    __device__ __forceinline__ void operator()(const f32x4 (&acc)[2][2][4][2], const pg8::Unit& u, int wr, int wc, int fr, int fq) const {
        asm volatile("" : "+v"(fr), "+v"(fq));
        const bool sample = u.pm >= 16;
        float frq[4];
#pragma unroll
        for (int j = 0; j < 4; ++j) frq[j] = __builtin_amdgcn_exp2f(-(float)(4 * (fq & 1) + j) * (LOG2_THETA / 8.0f)) * INV_2PI;
        const bool lowhalf = fq < 2;
#pragma unroll
        for (int ai = 0; ai < 2; ++ai)
#pragma unroll
            for (int m = 0; m < 4; ++m) { unsigned row = u.pm * 256 + ai * 128 + wr * 64 + m * 16 + fr; asm volatile("" : "+v"(row)); const unsigned t = (row - NP_ROWS) & 4095u;
                bfu* p = Q + (row * 1536u + u.pn * 256 + wc * 32 + 4 * fq);
#pragma unroll
                for (int bj = 0; bj < 2; ++bj) {
                    const int g32 = (u.pn * 256 + bj * 128 + wc * 32) >> 5; const bool ropeg = (g32 % 3) == 2;
#pragma unroll
                    for (int n = 0; n < 2; ++n) { f32x4 v = acc[ai][bj][m][n];
                        if (sample && ropeg) { const float pos = (float)(n == 0 ? (t >> 6) : (t & 63u));
#pragma unroll
                            for (int j = 0; j < 4; ++j) { const float other = __shfl_xor(v[j], 32); const float rev = pos * frq[j]; const float c = __builtin_amdgcn_cosf(rev), s = __builtin_amdgcn_sinf(rev);
                                v[j] = lowhalf ? (v[j] * c - other * s) : (other * s + v[j] * c); } }
                        v = v * (0.10206207261596577f * 1.4426950408889634f);
                        u32x2 w; w.x = pkbf(v[0], v[1]); w.y = pkbf(v[2], v[3]);
                        *(u32x2*)(p + bj * 128 + n * 16) = w; } }
                EPI_FENCE(); }
    }
};
#define XB_TMO      128
#define XB_XCNT(j)  (256  + 64 * (j))
#define XB_XSUB(j)  (1280 + 64 * (j))
#define XB_XGEN(j)  (2304 + 64 * (j))
#define XB_TOP      3328
#define XB_TOPGEN   3392
#define XCD_BAR_WORDS 3456
#define XB_SPIN_CAP (1u << 18)

__device__ __forceinline__ unsigned xb_ld(unsigned* p)              { return __hip_atomic_load(p, __ATOMIC_RELAXED, __HIP_MEMORY_SCOPE_AGENT); }
__device__ __forceinline__ unsigned xb_add(unsigned* p, unsigned v) { return __hip_atomic_fetch_add(p, v, __ATOMIC_RELAXED, __HIP_MEMORY_SCOPE_AGENT); }
__device__ __forceinline__ unsigned xb_xcc_id() { return (unsigned)__builtin_amdgcn_s_getreg((3 << 11) | 20) & 0xFu; }
#define XB_SPIN(cond, bar) do { unsigned _sp = 0; while (cond) { __builtin_amdgcn_s_sleep(1); \
    if ((++_sp & 255u) == 0u) { if (xb_ld(&(bar)[XB_TMO])) break; if (_sp > XB_SPIN_CAP) { atomicAdd(&(bar)[XB_TMO], 1u); break; } } } } while (0)

struct XcdBarrier {
    unsigned* bar; unsigned x;
    volatile LAS unsigned* st;
};

__device__ __forceinline__ XcdBarrier xcd_barrier_post(unsigned* bar, volatile LAS unsigned* st) {
    XcdBarrier b; b.bar = bar; b.x = xb_xcc_id(); b.st = st;
    if (threadIdx.x == 0) (void)xb_add(&bar[XB_XCNT(b.x)], 1u);
    return b;
}
__device__ __forceinline__ void xcd_barrier_complete(unsigned* bar, unsigned x, unsigned& nloc, unsigned& nx) {
    const unsigned G = gridDim.x * gridDim.y * gridDim.z;
    unsigned sum, cnt, mine, sp = 0u;
    for (;;) {
        sum = 0u; cnt = 0u; mine = 0u;
#pragma unroll
        for (unsigned j = 0; j < 16; ++j) { const unsigned c = xb_ld(&bar[XB_XCNT(j)]); sum += c; cnt += (c > 0u) ? 1u : 0u; mine = (j == x) ? c : mine; }
        if (sum == G) break;
        __builtin_amdgcn_s_sleep(1);
        if ((++sp & 255u) == 0u) { if (xb_ld(&bar[XB_TMO])) break; if (sp > XB_SPIN_CAP) { atomicAdd(&bar[XB_TMO], 1u); break; } }
    }
    nloc = mine > 0u ? mine : 1u; nx = cnt > 0u ? cnt : 1u;
}

__device__ __forceinline__ void xcd_barrier(const XcdBarrier& b) {
    asm volatile("s_waitcnt vmcnt(0)" ::: "memory");
    __syncthreads();
    if (threadIdx.x == 0) {
        unsigned* bar = b.bar;
        __builtin_amdgcn_s_waitcnt(0);
        unsigned nloc = b.st[0], nx = b.st[1];
        if (nloc == 0u) { xcd_barrier_complete(bar, b.x, nloc, nx); b.st[0] = nloc; b.st[1] = nx; }
        const unsigned old = xb_add(&bar[XB_XSUB(b.x)], 1u);
        const unsigned gen = old / nloc;
        if (old + 1u == (gen + 1u) * nloc) {
            __builtin_amdgcn_fence(__ATOMIC_RELEASE, "agent");
            asm volatile("s_waitcnt vmcnt(0)" ::: "memory");
            const unsigned og = xb_add(&bar[XB_TOP], 1u);
            const unsigned tg = og / nx;
            if (og + 1u == (tg + 1u) * nx) xb_add(&bar[XB_TOPGEN], 1u);
            else XB_SPIN(xb_ld(&bar[XB_TOPGEN]) == tg, bar);
            __builtin_amdgcn_fence(__ATOMIC_ACQUIRE, "agent");
            xb_add(&bar[XB_XGEN(b.x)], 1u);
            asm volatile("s_waitcnt vmcnt(0)" ::: "memory");
        } else {
            XB_SPIN(xb_ld(&bar[XB_XGEN(b.x)]) == gen, bar);
            __builtin_amdgcn_fence(__ATOMIC_ACQUIRE, "agent");
            asm volatile("s_waitcnt vmcnt(0)" ::: "memory");
        }
    }
    __syncthreads();
}

constexpr size_t MiB = 1u << 20;
constexpr size_t WT_MLP_IN = 0;
constexpr size_t WT_MLP_OUT = 4 * (size_t)DM * DFF;
constexpr size_t WT_A_QKV = 8 * (size_t)DM * DFF;
constexpr size_t WT_A_O = WT_A_QKV + 2 * 1536 * 1024;
constexpr size_t WT_C_QKV = WT_A_O + 2 * 1024 * 1024;
constexpr size_t WT_C_O = WT_C_QKV + 1536 * 1024;
constexpr size_t WT_B_DQKV = WT_C_O + 1024 * 1024;
constexpr size_t WT_B_UQ = WT_B_DQKV + 768 * 1024;
constexpr size_t WT_B_UKV = WT_B_UQ + 1536 * 384;
constexpr size_t WT_B_O = WT_B_UKV + 2048 * 256;
constexpr size_t WT_END = WT_B_O + 1024 * 1024;
static_assert(WT_END * 2 <= 88 * MiB, "WT region");
constexpr size_t WS_WT = 0, WS_MODS = 88 * MiB, WS_KR = 89 * MiB, WS_CKVN = 91 * MiB, WS_DQN = 102 * MiB, WS_H = 117 * MiB, WS_R1 = 157 * MiB;
constexpr size_t WS_Q = WS_R1, WS_K = WS_R1 + 60 * MiB, WS_V = WS_K + 42 * MiB, WS_T = WS_R1, WS_HID = WS_R1, WS_CTL = WS_R1 + 160 * MiB, WS_P = WS_CTL + 1 * MiB, WS_END = WS_P + 64 * MiB;

#define GAS1 __attribute__((address_space(1)))
struct Args { const GAS1 float* in[30]; GAS1 float* out; GAS1 unsigned char* ws; int ph_lo, ph_hi; };
struct ArgsH { const float* in[30]; float* out; unsigned char* ws; int ph_lo, ph_hi; };
static_assert(sizeof(Args) == sizeof(ArgsH), "Args layout");

__device__ __forceinline__ float wave_sum(float v) {
#pragma unroll
    for (int o = 1; o < 64; o <<= 1) v += __shfl_xor(v, o);
    return v;
}
template <int MAP>
__device__ __forceinline__ void transpose_item(const float* W, int K, int N, bfu* WT, int row_off, LAS float* scr, int item, int lane) {
    const int nblk = N / 32, kb = item / nblk, nb = item % nblk, k0 = 64 * kb, n0 = 32 * nb;
#pragma unroll 8
    for (int i = 0; i < 32; ++i) { const int kk = 2 * i + (lane >> 5); scr[kk * 33 + (lane & 31)] = W[(size_t)(k0 + kk) * N + n0 + (lane & 31)]; }
    asm volatile("s_waitcnt lgkmcnt(0)" ::: "memory");
    const int c = lane & 7;
#pragma unroll
    for (int j = 0; j < 4; ++j) { const int n = (lane >> 3) + 8 * j; const LAS float* s = scr + (8 * c) * 33 + n;
        u32x4 o; o.x = pkbf(s[0 * 33], s[1 * 33]); o.y = pkbf(s[2 * 33], s[3 * 33]); o.z = pkbf(s[4 * 33], s[5 * 33]); o.w = pkbf(s[6 * 33], s[7 * 33]);
        int src = n0 + n, dst;
        if (MAP == 1) { const int tile = src >> 8, loc = src & 255, hl = loc >> 6, d = loc & 63; dst = tile * 256 + (d >> 5) * 128 + hl * 32 + (d & 31); } else dst = row_off + src;
        *(u32x4*)(WT + (size_t)dst * K + k0 + 8 * c) = o; }
    asm volatile("s_waitcnt lgkmcnt(0)" ::: "memory");
}
__device__ __forceinline__ void norm_row(const float* xin, float* xrow, const bfu* prow, const float* g, const float* shift, const float* scale, bfu* orow, int lane) {
    f32x4 v[4]; float s = 0.f;
#pragma unroll
    for (int j = 0; j < 4; ++j) { v[j] = *((const f32x4*)xin + lane + 64 * j);
        if (prow) { const u32x2* pp = (const u32x2*)prow + lane + 64 * j;
#pragma unroll
            for (int q = 0; q < 4; ++q) { const u32x2 w = pp[(size_t)q * 1048576]; v[j][0] += __uint_as_float(w.x << 16); v[j][1] += __uint_as_float(w.x & 0xffff0000u); v[j][2] += __uint_as_float(w.y << 16); v[j][3] += __uint_as_float(w.y & 0xffff0000u); }
            *((f32x4*)xrow + lane + 64 * j) = v[j]; } s += (v[j][0] * v[j][0] + v[j][1] * v[j][1]) + (v[j][2] * v[j][2] + v[j][3] * v[j][3]); }
    const float rstd = 1.0f / sqrtf(wave_sum(s) * (1.0f / 1024.0f) + EPS_);
#pragma unroll
    for (int j = 0; j < 4; ++j) { const int c = 4 * lane + 256 * j; const f32x4 gv = *(const f32x4*)(g + c), sh = *(const f32x4*)(shift + c), sc = *(const f32x4*)(scale + c);
        const f32x4 y = v[j] * rstd * gv * (sc + 1.0f) + sh; u32x2 w; w.x = pkbf(y[0], y[1]); w.y = pkbf(y[2], y[3]); *((u32x2*)orow + lane + 64 * j) = w; }
}
__device__ __forceinline__ void cvt_rows(const float* src, size_t src_stride, bfu* dst, size_t dst_stride, int nrows, int ncols, int gtid, int gthreads) {
    const int cpr = ncols / 8;
    for (long i = gtid; i < (long)nrows * cpr; i += gthreads) { const int r = (int)(i / cpr), c = (int)(i % cpr) * 8;
        const f32x4 a = *(const f32x4*)(src + (size_t)r * src_stride + c), b = *(const f32x4*)(src + (size_t)r * src_stride + c + 4);
        u32x4 w; w.x = pkbf(a[0], a[1]); w.y = pkbf(a[2], a[3]); w.z = pkbf(b[0], b[1]); w.w = pkbf(b[2], b[3]); *(u32x4*)(dst + (size_t)r * dst_stride + c) = w; }
}

#ifndef G_ALIGN
#define G_ALIGN true
#endif
#ifndef G_SP2
#define G_SP2 true
#endif
#ifndef QKV_SP2
#define QKV_SP2 true
#endif
struct LdsOrder {
    const LAS int* ul;
    __device__ __forceinline__ bool next(int i, pg8::Unit& u) const {
        if (i >= 16) return false;
        const LAS int* p = ul + i * 8;
        const int ok = __builtin_amdgcn_readfirstlane(p[0]); if (!ok) return false;
        u.pm = __builtin_amdgcn_readfirstlane(p[1]); u.pn = __builtin_amdgcn_readfirstlane(p[2]); u.kt0 = __builtin_amdgcn_readfirstlane(p[3]);
        u.nt = __builtin_amdgcn_readfirstlane(p[4]); u.split = __builtin_amdgcn_readfirstlane(p[5]); return true;
    }
    __device__ __forceinline__ void a_ready(const pg8::Unit&) const {}
    __device__ __forceinline__ void done(const pg8::Unit&) const {}
};
constexpr int LDS_UNITS = 131072;
template <class Epi, bool SP2 = G_SP2, bool SPLIT = false>
__device__ __forceinline__ void run_gemm(LAS unsigned char* lds, const bfu* A, const bfu* Bt, int M, int N, int K, const Epi& E) {
    int Kv = K; asm volatile("" : "+s"(Kv));
    LAS int* ul = (LAS int*)(lds + LDS_UNITS);
    { const int t = opaque_tid();
      if (t < 16) { int G_ = gridDim.x, bx_ = blockIdx.x; pg8::StaticOrder S; S.init(M, N, G_, bx_, Kv / 64, SPLIT); const pg8::Unit u = S.get(t);
          ul[t * 8 + 0] = u.nt > 0 ? 1 : 0; ul[t * 8 + 1] = u.pm; ul[t * 8 + 2] = u.pn; ul[t * 8 + 3] = u.kt0; ul[t * 8 + 4] = u.nt; ul[t * 8 + 5] = u.split; }
      __syncthreads(); }
    pg8::Gemm g{A, Bt, M, N, Kv}; LdsOrder S{ul};
    pg8::gemm_phase<Epi, LdsOrder, G_ALIGN, SP2>(lds, g, S, E);
    __syncthreads();
}

constexpr int LDS_BYTES = 147456, LDS_MISC = 147456 - 64;
constexpr int N_PHASES = 32;
#ifndef REP_ATT
#define REP_ATT 1
#endif
#ifndef REP_UP
#define REP_UP 1
#endif
#ifndef REP_RES
#define REP_RES 1
#endif
#ifndef REP_NORM
#define REP_NORM 1
#endif
#ifndef REP_P0
#define REP_P0 1
#endif
#ifndef PH_MASK
#define PH_MASK 0xffff
#endif
#define EN(k) (((PH_MASK) >> (k)) & 1)

typedef const __attribute__((address_space(4))) Args* KArgsP;
__device__ __forceinline__ KArgsP ka() { KArgsP p = (KArgsP)__builtin_amdgcn_kernarg_segment_ptr(); asm volatile("" : "+s"(p)); return p; }
__global__ void __launch_bounds__(512, 2) mega_fwd(Args args) {
    extern __shared__ __attribute__((aligned(16))) unsigned char lds[];
    cg::grid_group grid = cg::this_grid();
    const int lo = args.ph_lo, hi = args.ph_hi; int ph = 0;
    XcdBarrier xbar; xbar.bar = nullptr; xbar.x = 0; xbar.st = nullptr;
    if (hi - lo > 1) {
        volatile LAS unsigned* misc = (volatile LAS unsigned*)((LAS unsigned char*)lds + LDS_MISC);
        if (threadIdx.x < 16) misc[threadIdx.x] = 0u;
        __syncthreads();
        xbar = xcd_barrier_post((unsigned*)((unsigned char*)args.ws + WS_CTL), misc + 8);
    }
#define INP(i) ((const float*)A->in[i])
#define PHASE_LOCALS KArgsP A = ka(); const int tid = opaque_tid(), lane = tid & 63, wave = __builtin_amdgcn_readfirstlane(tid >> 6); \
    int G = gridDim.x, bx = blockIdx.x; asm volatile("" : "+s"(G), "+s"(bx)); const int vcu = (G % 8 == 0) ? (bx % 8) * (G / 8) + bx / 8 : bx; \
    const int gw = bx * 8 + wave, NGW = G * 8, gtid = bx * 512 + tid, GT = G * 512; (void)lane; (void)vcu; (void)gw; (void)NGW; (void)gtid; (void)GT; \
    LAS unsigned char* const ldsl = (LAS unsigned char*)lds; (void)ldsl; unsigned char* const ws = (unsigned char*)A->ws; float* const X = (float*)A->out; \
    bfu* const WT = (bfu*)(ws + WS_WT); float* const mods = (float*)(ws + WS_MODS); bfu* const KR = (bfu*)(ws + WS_KR); bfu* const CKVN = (bfu*)(ws + WS_CKVN); bfu* const DQN = (bfu*)(ws + WS_DQN); \
    bfu* const HB = (bfu*)(ws + WS_H); bfu* const QB = (bfu*)(ws + WS_Q); bfu* const KB = (bfu*)(ws + WS_K); bfu* const VB = (bfu*)(ws + WS_V); float* const TB = (float*)(ws + WS_T); bfu* const HID = (bfu*)(ws + WS_HID); \
    float* const st_a_k = X + 20971520; float* const st_a_v = X + 23068672; float* const st_b_ckv = X + 25165824; float* const st_b_kr = X + 26214400; float* const st_c_k = X + 26345472; float* const st_c_v = X + 27394048; \
    const float* const modl = mods + (size_t)layer * 5 * 6144; const float* const ng = INP(12) + (size_t)layer * 2 * 1024; \
    (void)WT; (void)KR; (void)CKVN; (void)DQN; (void)HB; (void)QB; (void)KB; (void)VB; (void)TB; (void)HID; (void)st_a_k; (void)st_a_v; (void)st_b_ckv; (void)st_b_kr; (void)st_c_k; (void)st_c_v; (void)modl; (void)ng;
#define PH_BEGIN if (ph >= lo && ph < hi) { PHASE_LOCALS
#ifndef REP_SYNC
#define REP_SYNC 1
#endif
#define PH_END if (ph + 1 < hi) { for (int rs_ = 0; rs_ < REP_SYNC; ++rs_) { if (ph == 0) grid.sync(); else xcd_barrier(xbar); } } } ++ph;

    { const int layer = 0;
    PH_BEGIN
    if constexpr (EN(0)) for (int rep_ = 0; rep_ < REP_P0; ++rep_) {
        if (rep_) __syncthreads();
        LAS float* scr = (LAS float*)(ldsl + wave * 16384);
        for (int seg = 0; seg < 20; ++seg) {
            const float* W; int K, N, map = 0, roff = 0; size_t dsto;
            if (seg < 4)       { W = INP(13) + (size_t)seg * DM * DFF; K = DM; N = DFF; dsto = WT_MLP_IN + (size_t)seg * DM * DFF; }
            else if (seg < 8)  { W = INP(14) + (size_t)(seg - 4) * DM * DFF; K = DFF; N = DM; dsto = WT_MLP_OUT + (size_t)(seg - 4) * DM * DFF; }
            else if (seg < 10) { W = INP(15) + (size_t)(seg - 8) * 1024 * 1536; K = 1024; N = 1536; dsto = WT_A_QKV + (size_t)(seg - 8) * 1536 * 1024; map = 1; }
            else if (seg < 12) { W = INP(17) + (size_t)(seg - 10) * 1024 * 1024; K = 1024; N = 1024; dsto = WT_A_O + (size_t)(seg - 10) * 1024 * 1024; }
            else if (seg == 12) { W = INP(25); K = 1024; N = 1536; dsto = WT_C_QKV; map = 1; }
            else if (seg == 13) { W = INP(28); K = 1024; N = 1024; dsto = WT_C_O; }
            else if (seg == 14) { W = INP(18); K = 1024; N = 384; dsto = WT_B_DQKV; }
            else if (seg == 15) { W = INP(21); K = 1024; N = 288; dsto = WT_B_DQKV; roff = 384; }
            else if (seg == 16) { W = INP(20); K = 384; N = 1536; dsto = WT_B_UQ; }
            else if (seg == 17) { W = INP(23); K = 256; N = 2048; dsto = WT_B_UKV; }
            else if (seg == 18) { W = INP(24); K = 1024; N = 1024; dsto = WT_B_O; }
            else break;
            const int nitems = (K / 64) * (N / 32);
            if (map == 1) { for (int it = gw; it < nitems; it += NGW) transpose_item<1>(W, K, N, WT + dsto, 0, scr, it, lane); }
            else          { for (int it = gw; it < nitems; it += NGW) transpose_item<0>(W, K, N, WT + dsto, roff, scr, it, lane); }
        }
        for (int i = gtid; i < 96 * 1024 / 8; i += GT) *(u32x4*)(WT + WT_B_DQKV + (size_t)672 * 1024 + (size_t)i * 8) = (u32x4){0u, 0u, 0u, 0u};
        __syncthreads();
        LAS float* sc = (LAS float*)ldsl;
        LAS float* part = (LAS float*)(ldsl + 20480);
        for (int i = tid; i < 5 * 1024; i += 512) { const int cnd = i >> 10, k = i & 1023; const float v = cnd < 4 ? INP(2)[cnd * 1024 + k] : INP(9)[k]; sc[i] = v / (1.0f + __expf(-v)); }
        __syncthreads();
        for (int item = bx; item < 4 * 96; item += G) {
            const int l = item / 96, cb = item % 96, col = cb * 64 + lane; const float* Wl = INP(10) + (size_t)l * 1024 * 6144;
            float a0 = 0.f, a1 = 0.f, a2 = 0.f, a3 = 0.f, a4 = 0.f;
#pragma unroll 8
            for (int kk = 0; kk < 128; ++kk) { const int k = wave * 128 + kk; const float w = Wl[(size_t)k * 6144 + col];
                a0 += sc[k] * w; a1 += sc[1024 + k] * w; a2 += sc[2048 + k] * w; a3 += sc[3072 + k] * w; a4 += sc[4096 + k] * w; }
            part[(wave * 5 + 0) * 64 + lane] = a0; part[(wave * 5 + 1) * 64 + lane] = a1; part[(wave * 5 + 2) * 64 + lane] = a2; part[(wave * 5 + 3) * 64 + lane] = a3; part[(wave * 5 + 4) * 64 + lane] = a4;
            __syncthreads();
            if (tid < 320) { const int cnd = tid >> 6, ln = tid & 63; float s = INP(11)[l * 6144 + cb * 64 + ln];
#pragma unroll
                for (int w8 = 0; w8 < 8; ++w8) s += part[(w8 * 5 + cnd) * 64 + ln];
                mods[((size_t)l * 5 + cnd) * 6144 + cb * 64 + ln] = s; }
            __syncthreads();
        }
    }
    PH_END
    }

    for (int layer = 0; layer < 4; ++layer) {
        const int kind = layer % 3, jj = layer / 3;
        PH_BEGIN
        if constexpr (EN(1))
        for (int rep_ = 0; rep_ < REP_NORM; ++rep_)
        for (int r = gw; r < M_ROWS; r += NGW) { const float* mc = modl + cond_of_row(r) * 6144; const bfu* pr = (G == 256 && layer > 0 && r < NP_ROWS) ? (const bfu*)(ws + WS_P) + (size_t)r * 1024 : nullptr; const float* xi = layer > 0 ? X + (size_t)r * 1024 : (r < NP_ROWS ? INP(0) + (size_t)r * 1024 : INP(1) + (size_t)(r - NP_ROWS) * 1024); norm_row(xi, X + (size_t)r * 1024, pr, ng, mc, mc + 1024, HB + (size_t)r * 1024, lane); }
        if constexpr (EN(1))
        for (int b = 0; b < 4; ++b) {
            const size_t e0 = NP_ROWS + (size_t)b * EXT_B;
            if (kind == 0)      { cvt_rows(INP(3) + (size_t)(b * 2 + jj) * 65536, 256, KB + e0 * 256, 256, 256, 256, gtid, GT); cvt_rows(INP(4) + (size_t)(b * 2 + jj) * 65536, 256, VB + e0 * 256, 256, 256, 256, gtid, GT); }
            else if (kind == 2) { cvt_rows(INP(7) + (size_t)b * 65536, 256, KB + e0 * 256, 256, 256, 256, gtid, GT); cvt_rows(INP(8) + (size_t)b * 65536, 256, VB + e0 * 256, 256, 256, 256, gtid, GT); }
            else                { cvt_rows(INP(5) + (size_t)b * 65536, 256, CKVN + e0 * 256, 256, 256, 256, gtid, GT); cvt_rows(INP(6) + (size_t)b * 8192, 32, KR + e0 * 32, 32, 256, 32, gtid, GT); }
        }
        PH_END
        if (kind == 1) {
            PH_BEGIN
            if constexpr (EN(2)) { EpiF32 E{(bfu*)TB, 1024}; run_gemm(ldsl, HB, WT + WT_B_DQKV, M_ROWS, 768, 1024, E); }
            PH_END
            PH_BEGIN
            if constexpr (EN(3))
            for (int r = gw; r < M_ROWS; r += NGW) {
                const bfu* tr = (const bfu*)TB + (size_t)r * 1024; f32x4 v[3];
#pragma unroll
                for (int k = 0; k < 3; ++k) { const u32x2 w = *(const u32x2*)(tr + 4 * lane + 256 * k); v[k][0] = __uint_as_float(w.x << 16); v[k][1] = __uint_as_float(w.x & 0xffff0000u); v[k][2] = __uint_as_float(w.y << 16); v[k][3] = __uint_as_float(w.y & 0xffff0000u); }
                float sq = (v[0][0] * v[0][0] + v[0][1] * v[0][1]) + (v[0][2] * v[0][2] + v[0][3] * v[0][3]);
                const float s1 = (v[1][0] * v[1][0] + v[1][1] * v[1][1]) + (v[1][2] * v[1][2] + v[1][3] * v[1][3]);
                const float s2 = (v[2][0] * v[2][0] + v[2][1] * v[2][1]) + (v[2][2] * v[2][2] + v[2][3] * v[2][3]);
                float skv = 0.f;
                if (lane < 32) { sq += s1; skv = s2; } else { skv = s1; }
                sq = wave_sum(sq); skv = wave_sum(skv);
                const float rq = 1.0f / sqrtf(sq * (1.0f / 384.0f) + EPS_), rkv = 1.0f / sqrtf(skv * (1.0f / 256.0f) + EPS_);
                const bool sample = r >= NP_ROWS; const int e = ext_of_row(r); const int t = (r - NP_ROWS) & 4095;
                { const f32x4 g = *(const f32x4*)(INP(19) + 4 * lane); const f32x4 y = v[0] * rq * g; u32x2 w; w.x = pkbf(y[0], y[1]); w.y = pkbf(y[2], y[3]); *(u32x2*)(DQN + (size_t)r * 384 + 4 * lane) = w; }
                if (lane < 32) {
                    { const f32x4 g = *(const f32x4*)(INP(19) + 256 + 4 * lane); const f32x4 y = v[1] * rq * g; u32x2 w; w.x = pkbf(y[0], y[1]); w.y = pkbf(y[2], y[3]); *(u32x2*)(DQN + (size_t)r * 384 + 256 + 4 * lane) = w; }
                    { const int c = 128 + 4 * lane; const f32x4 g = *(const f32x4*)(INP(22) + c); const f32x4 y = v[2] * rkv * g; u32x2 w; w.x = pkbf(y[0], y[1]); w.y = pkbf(y[2], y[3]); *(u32x2*)(CKVN + (size_t)e * 256 + c) = w;
                      if (!sample) *(f32x4*)(st_b_ckv + (size_t)r * 256 + c) = y; }
                } else {
                    { const int c = 4 * (lane - 32); const f32x4 g = *(const f32x4*)(INP(22) + c); const f32x4 y = v[1] * rkv * g; u32x2 w; w.x = pkbf(y[0], y[1]); w.y = pkbf(y[2], y[3]); *(u32x2*)(CKVN + (size_t)e * 256 + c) = w;
                      if (!sample) *(f32x4*)(st_b_ckv + (size_t)r * 256 + c) = y; }
                }
                { f32x4 y = v[2]; const int l8 = lane - 32;
                  f32x4 oth; oth[0] = __shfl_xor(y[0], 2); oth[1] = __shfl_xor(y[1], 2); oth[2] = __shfl_xor(y[2], 2); oth[3] = __shfl_xor(y[3], 2);
                  if (lane >= 32 && lane < 40) {
                      if (sample) { const int pos = l8 < 4 ? (t >> 6) : (t & 63); const bool first = (l8 & 2) == 0;
#pragma unroll
                          for (int j = 0; j < 4; ++j) { float c, s; rope_cs(pos, 4 * (l8 & 1) + j, 1.0f / 8.0f, c, s); y[j] = first ? (y[j] * c - oth[j] * s) : (oth[j] * s + y[j] * c); } }
                      else *(f32x4*)(st_b_kr + (size_t)r * 32 + 4 * l8) = y;
                      u32x2 w; w.x = pkbf(y[0], y[1]); w.y = pkbf(y[2], y[3]); *(u32x2*)(KR + (size_t)e * 32 + 4 * l8) = w; } }
            }
            PH_END
            PH_BEGIN
            if constexpr (EN(4)) { EpiUQ E{QB}; run_gemm(ldsl, DQN, WT + WT_B_UQ, M_ROWS, 1536, 384, E); }
            if constexpr (EN(5)) { EpiUKV E{KB, VB}; run_gemm(ldsl, CKVN, WT + WT_B_UKV, EXT_ROWS, 2048, 256, E); }
            PH_END
        } else if (kind == 0) {
            PH_BEGIN
            if constexpr (EN(6)) { EpiQKV<false> E{QB, KB, VB, st_a_k + (size_t)jj * 65536, st_a_v + (size_t)jj * 65536, nullptr, nullptr, 2}; run_gemm(ldsl, HB, WT + WT_A_QKV + (size_t)jj * 1536 * 1024, M_ROWS, 1536, 1024, E); }
            PH_END
        } else {
            PH_BEGIN
            if constexpr (EN(7)) { EpiQKV<true> E{QB, KB, VB, st_c_k, st_c_v, INP(26), INP(27), 1}; run_gemm<EpiQKV<true>, QKV_SP2>(ldsl, HB, WT + WT_C_QKV, M_ROWS, 1536, 1024, E); }
            PH_END
        }
        PH_BEGIN
        for (int rep_ = 0; rep_ < REP_ATT; ++rep_)
        for (int i = 0; i < 5; ++i) {
            const int ui = i * G + vcu; if (ui >= 1280) break;
            att::Unit U; int b, h, qb; bool prompt = ui >= 1024;
            if (!prompt) { if (kind == 1) { qb = ui & 15; h = (ui >> 4) & 15; b = ui >> 8; } else { qb = ui & 15; const int g4 = (ui >> 4) & 3, kvh = (ui >> 6) & 3; b = ui >> 8; h = kvh * 4 + g4; } }
            else { const int u2 = ui - 1024; qb = 0; h = u2 & 15; b = u2 >> 4; if (kind != 1) { h = ((u2 >> 2) & 3) * 4 + (u2 & 3); } }
            const int r0 = prompt ? b * 256 : NP_ROWS + b * 4096 + qb * 256; const size_t ebase = prompt ? (size_t)b * 256 : NP_ROWS + (size_t)b * EXT_B;
            U.O = HB + (size_t)r0 * 1024 + h * 64; U.q0 = qb * 256; U.kstart = 0; U.sinkl2 = -1e30f;
            if (kind == 1) { U.Q = QB + (size_t)r0 * 1536 + h * 96; U.ldq = 1536; U.K = KB + ebase * 1024 + h * 64; U.V = VB + ebase * 1024 + h * 64; U.KR = KR + ebase * 32; U.ldk = 1024;
                U.NT = prompt ? 4 : 68; U.C = 0.10206207261596577f * 1.4426950408889634f; U.thr_raw = 8.0f / 0.10206207261596577f; }
            else { const int kvh = h >> 2; U.Q = QB + (size_t)r0 * 1024 + h * 64; U.ldq = 1024; U.K = KB + ebase * 256 + kvh * 64; U.V = VB + ebase * 256 + kvh * 64; U.KR = nullptr; U.ldk = 256;
                U.NT = prompt ? 4 : 68; U.C = 0.125f * 1.4426950408889634f; U.thr_raw = 64.0f;
                if (kind == 0) { U.sinkl2 = INP(16)[jj * 16 + h] * 1.4426950408889634f;
                    if (!prompt) { const int q0 = qb * 256; const int ks = q0 - 128 < 0 ? 0 : q0 - 128; const int ke = q0 + 384 > 4096 ? 4096 : q0 + 384; U.kstart = ks; U.NT = 4 + (ke - ks) / 64; } } }
            if (kind == 1) { if constexpr (EN(8)) att::attn_unit<96, false>(U, (char*)lds); }
            else if (kind == 0) { if constexpr (EN(9)) att::attn_unit<64, true>(U, (char*)lds); }
            else { if constexpr (EN(10)) att::attn_unit<64, false>(U, (char*)lds); }
        }
        PH_END
        PH_BEGIN
        if constexpr (EN(11)) { const bfu* wo = WT + (kind == 0 ? WT_A_O + (size_t)jj * 1024 * 1024 : kind == 1 ? WT_B_O : WT_C_O); EpiResid E{X, modl + 2048, (bfu*)(ws + WS_P), layer == 0 ? INP(1) - (size_t)NP_ROWS * 1024 : (const float*)X}; run_gemm<EpiResid, G_SP2, true>(ldsl, HB, wo, M_ROWS, 1024, 1024, E); }
        PH_END
        PH_BEGIN
        if constexpr (EN(1))
        for (int rep_ = 0; rep_ < REP_NORM; ++rep_)
        for (int r = gw; r < M_ROWS; r += NGW) { const float* mc = modl + cond_of_row(r) * 6144; const bfu* pr = (G == 256 && r < NP_ROWS) ? (const bfu*)(ws + WS_P) + (size_t)r * 1024 : nullptr; const float* xi = (layer == 0 && r < NP_ROWS) ? INP(0) + (size_t)r * 1024 : X + (size_t)r * 1024; norm_row(xi, X + (size_t)r * 1024, pr, ng + 1024, mc + 3072, mc + 4096, HB + (size_t)r * 1024, lane); }
        PH_END
        PH_BEGIN
        for (int rep_ = 0; rep_ < REP_UP; ++rep_)
        if constexpr (EN(12)) { EpiSqRelu E{HID, DFF}; run_gemm(ldsl, HB, WT + WT_MLP_IN + (size_t)layer * DM * DFF, M_ROWS, DFF, DM, E); }
        PH_END
        PH_BEGIN
        if constexpr (EN(11)) { EpiResid E{X, modl + 5120, (bfu*)(ws + WS_P), (const float*)X}; run_gemm<EpiResid, G_SP2, true>(ldsl, HID, WT + WT_MLP_OUT + (size_t)layer * DM * DFF, M_ROWS, DM, DFF, E); }
        PH_END
    }
    { const int layer = 0;
    PH_BEGIN
    if constexpr (EN(1))
    for (int r = gw; r < M_ROWS; r += NGW) {
        float* xr = X + (size_t)r * 1024; f32x4 v[4]; float s = 0.f;
#pragma unroll
        for (int j = 0; j < 4; ++j) { v[j] = *((const f32x4*)xr + lane + 64 * j);
            if (G == 256 && r < NP_ROWS) { const u32x2* pp = (const u32x2*)((const bfu*)(ws + WS_P) + (size_t)r * 1024) + lane + 64 * j;
#pragma unroll
                for (int q = 0; q < 4; ++q) { const u32x2 w = pp[(size_t)q * 1048576]; v[j][0] += __uint_as_float(w.x << 16); v[j][1] += __uint_as_float(w.x & 0xffff0000u); v[j][2] += __uint_as_float(w.y << 16); v[j][3] += __uint_as_float(w.y & 0xffff0000u); } }
            s += (v[j][0] * v[j][0] + v[j][1] * v[j][1]) + (v[j][2] * v[j][2] + v[j][3] * v[j][3]); }
        const float rstd = 1.0f / sqrtf(wave_sum(s) * (1.0f / 1024.0f) + EPS_);
#pragma unroll
        for (int j = 0; j < 4; ++j) { const f32x4 g = *(const f32x4*)(INP(29) + 4 * lane + 256 * j); *((f32x4*)xr + lane + 64 * j) = v[j] * rstd * g; }
    }
    PH_END
    }
#undef PH_BEGIN
#undef PH_END
}

#ifndef MK_MULTI
#define MK_MULTI 0
#endif
extern "C" void kernel_launch(void* const* d_in, const int* in_sizes, int n_in, void* d_out, int out_size, void* d_ws, size_t ws_size, hipStream_t stream) {
    static int grid = 0;
    if (grid == 0) {
        if (n_in != 30 || ws_size < WS_END) { fprintf(stderr, "kernel_launch: n_in %d ws %zu (need %zu)\n", n_in, ws_size, (size_t)WS_END); grid = -1; return; }
        int dev = 0, cus = 0, per_cu = 0;
        hipGetDevice(&dev); hipDeviceGetAttribute(&cus, hipDeviceAttributeMultiprocessorCount, dev);
        if (hipFuncSetAttribute((const void*)mega_fwd, hipFuncAttributeMaxDynamicSharedMemorySize, LDS_BYTES) != hipSuccess) { fprintf(stderr, "kernel_launch: hipFuncSetAttribute failed\n"); grid = -1; return; }
        hipOccupancyMaxActiveBlocksPerMultiprocessor(&per_cu, (const void*)mega_fwd, 512, LDS_BYTES);
        if (per_cu < 1) { fprintf(stderr, "kernel_launch: occupancy query says %d\n", per_cu); per_cu = 1; }
        (void)hipGetLastError();
        grid = cus * 1;
        if (cus != 256) { fprintf(stderr, "kernel_launch: the phase program is laid out for the 256 CUs of MI355X, got %d\n", cus); grid = -1; return; }
    }
    if (grid < 0) return;
    ArgsH a{};
    for (int i = 0; i < 30; ++i) a.in[i] = (const float*)d_in[i];
    a.out = (float*)d_out; a.ws = (unsigned char*)d_ws;
    if (hipMemsetAsync((char*)d_ws + WS_CTL, 0, 16384, stream) != hipSuccess) { fprintf(stderr, "memset failed\n"); return; }
#if MK_MULTI
    for (int p = 0; p < N_PHASES; ++p) { a.ph_lo = p; a.ph_hi = p + 1; void* kargs[] = {&a}; hipError_t e = hipLaunchKernel((const void*)mega_fwd, dim3(grid), dim3(512), kargs, LDS_BYTES, stream); if (e != hipSuccess) { fprintf(stderr, "launch %d failed: %s\n", p, hipGetErrorString(e)); break; } }
#else
    a.ph_lo = 0; a.ph_hi = N_PHASES;
    void* kargs[] = {&a};
    hipError_t e = hipLaunchCooperativeKernel((const void*)mega_fwd, dim3(grid), dim3(512), kargs, LDS_BYTES, stream);
    if (e != hipSuccess) fprintf(stderr, "cooperative launch failed: %s (grid %d)\n", hipGetErrorString(e), grid);
#endif
}
```

```cpp
#include <hip/hip_runtime.h>
#include <hip/hip_cooperative_groups.h>
#include <cstdio>
#include <cstdint>
namespace cg = cooperative_groups;
#define LAS __attribute__((address_space(3)))
__device__ __forceinline__ int opaque_tid() { int t = threadIdx.x; asm volatile("" : "+v"(t)); return t; }
namespace pg8 {
#define PG8_LAS __attribute__((address_space(3)))
typedef unsigned short bf16_t;
typedef short bf16x8 __attribute__((ext_vector_type(8)));
typedef float f32x4 __attribute__((ext_vector_type(4)));
typedef unsigned u32x4 __attribute__((ext_vector_type(4)));
constexpr int BM = 256, BK = 64, HALF = 128, HTB = HALF * BK * 2  , STAGE_BYTES = 8 * HTB, NXCD = 8, WGM = 8;

__host__ __device__ __forceinline__ int lds_byte(int r, int c) { const int st = (r >> 4) * 2 + (c >> 5), rr = r & 15, cc = c & 31, ob = rr * 64 + cc * 2; return st * 1024 + (ob ^ (((ob >> 9) & 1) << 5)); }
__host__ __device__ __forceinline__ void stage_rc(int b, int& R, int& C) { const int st = b / 1024, sb = b % 1024, swz = sb ^ (((sb >> 9) & 1) << 5); R = (st >> 1) * 16 + swz / 64; C = (st & 1) * 32 + (swz % 64) / 2; }
__host__ __device__ __forceinline__ int perm32(int rho) { const int n = rho >> 4, i = rho & 15; return 8 * (i >> 2) + 4 * n + (i & 3); }

struct Unit { int pm, pn, kt0, nt, split; };
struct Gemm { const bf16_t* A; const bf16_t* Bt; int M, N, K; };

struct StaticOrder {
    int nM, nN, nwg, G, c, ntk, rounds, rem, sp;
    __host__ __device__ void init(int M, int N, int G_, int c_, int ntk_ = 0, bool SPLIT = false) { nM = M / BM; nN = N / BM; nwg = nM * nN; G = G_; c = c_; ntk = ntk_;
        rounds = 0; rem = 0; sp = (SPLIT && G == 256 && nM == 80 && nN == 4 && (ntk & 7) == 0) ? 4 : 1; }
    __host__ __device__ Unit get(int i) const {
        Unit u; u.pm = 0; u.pn = 0; u.kt0 = 0; u.nt = 0; u.split = 0;
        if (sp == 4) {
            if (i == 0) { const int id = (c & 7) * 32 + (c >> 3); u.pm = 16 + (id >> 2); u.pn = id & 3; u.nt = ntk; }
            else if (i == 1) { const int t = c >> 2, part = c & 3; u.pm = t >> 2; u.pn = t & 3; u.nt = ntk >> 2; u.kt0 = part * u.nt; u.split = 1 + part; }
            return u; }
        const long LL = (long)i * G + c;
        if (LL < nwg) {
            int wgid = (int)LL; { const int q = nwg / NXCD, r = nwg % NXCD, xcd = wgid % NXCD, off = wgid / NXCD; wgid = (xcd < r ? xcd * (q + 1) : r * (q + 1) + (xcd - r) * q) + off; }
            const int nig = WGM * nN, gid = wgid / nig, fm = gid * WGM, gsz = (nM - fm) < WGM ? (nM - fm) : WGM;
            u.pm = fm + ((wgid % nig) % gsz); u.pn = (wgid % nig) / gsz; u.nt = ntk; }
        return u; }
    __host__ __device__ bool next(int i, Unit& u) const { u = get(i); return u.nt > 0; }
    __device__ __forceinline__ void a_ready(const Unit&) const {}
    __device__ __forceinline__ void done(const Unit&) const {}
};

__device__ __forceinline__ unsigned cvt_pk_bf16(float lo, float hi) { unsigned r; asm volatile("v_cvt_pk_bf16_f32 %0, %1, %2" : "=v"(r) : "v"(lo), "v"(hi)); return r; }
template <class Epi, class Sched, bool ALIGN_EPI = false, bool SP2 = false>
__device__ __forceinline__ void gemm_phase(PG8_LAS unsigned char* lds, const Gemm g, const Sched& S, const Epi& E) {
    const int tid = opaque_tid(), wid = __builtin_amdgcn_readfirstlane(tid >> 6), lane = tid & 63, wr = wid >> 2, wc = wid & 3, fr = lane & 15, fq = lane >> 4;
    const int K = g.K;
    unsigned voffA[2], voffB[2];
#pragma unroll
    for (int i = 0; i < 2; ++i) { int R, C; stage_rc(tid * 16 + i * 8192, R, C); const int Rb = Epi::PERM ? ((R & ~31) + perm32(R & 31)) : R;
        voffA[i] = (unsigned)(R * K + C) * 2u; voffB[i] = (unsigned)(Rb * K + C) * 2u; }
    const size_t kstep = (size_t)(BK * 2);
    const size_t hstep = (size_t)HALF * K * 2;
    const size_t tstep = 2 * hstep;
    const unsigned ldsw = (unsigned)wid * 1024u;
    const int aoff = lds_byte(wr * 64 + fr, fq * 8), boff = lds_byte(wc * 32 + fr, fq * 8);
#define PG8_SA(b, h) (((b) * 2 + (h)) * HTB)
#define PG8_SB(b, h) ((4 + (b) * 2 + (h)) * HTB)
#define PG8_STAGE(bufoff, gbase, voff) do { _Pragma("unroll") for (int _i = 0; _i < 2; ++_i) \
        __builtin_amdgcn_global_load_lds((const unsigned*)((const char*)(gbase) + (voff)[_i]), (PG8_LAS unsigned*)(lds + (bufoff) + ldsw + _i * 8192), 16, 0, 0); } while (0)
#define PG8_LDA(dst, b, h) do { _Pragma("unroll") for (int m = 0; m < 4; ++m) _Pragma("unroll") for (int k = 0; k < 2; ++k) dst[m][k] = *(const PG8_LAS bf16x8*)(lds + PG8_SA(b, h) + aoff + m * 2048 + k * 1024); } while (0)
#define PG8_LDB(dst, b, h) do { _Pragma("unroll") for (int n = 0; n < 2; ++n) _Pragma("unroll") for (int k = 0; k < 2; ++k) dst[n][k] = *(const PG8_LAS bf16x8*)(lds + PG8_SB(b, h) + boff + n * 2048 + k * 1024); } while (0)
#define PG8_MMA(ai, bj, At, Bt) do { __builtin_amdgcn_s_setprio(1); _Pragma("unroll") for (int m = 0; m < 4; ++m) _Pragma("unroll") for (int n = 0; n < 2; ++n) _Pragma("unroll") for (int k = 0; k < 2; ++k) \
        acc[ai][bj][m][n] = __builtin_amdgcn_mfma_f32_16x16x32_bf16(Bt[n][k], At[m][k], acc[ai][bj][m][n], 0, 0, 0); __builtin_amdgcn_s_setprio(0); } while (0)
#define PG8_WAIT_V(n) asm volatile("s_waitcnt vmcnt(" #n ")" ::: "memory")
#define PG8_WAIT_L(n) asm volatile("s_waitcnt lgkmcnt(" #n ")" ::: "memory")
#define PG8_BAR __builtin_amdgcn_s_barrier()
#define PG8_SCHED __builtin_amdgcn_sched_barrier(0)
    Unit cur, nxt; int ui = 0;
    if (!S.next(0, cur)) return;
    f32x4 acc[2][2][4][2];
#pragma unroll
    for (int a = 0; a < 2; ++a)
#pragma unroll
        for (int b = 0; b < 2; ++b)
#pragma unroll
            for (int m = 0; m < 4; ++m)
#pragma unroll
                for (int n = 0; n < 2; ++n) acc[a][b][m][n] = (f32x4){0.f, 0.f, 0.f, 0.f};
    bf16x8 At[4][2], B0[2][2], B1[2][2];
    const char* cA = (const char*)g.A + (size_t)cur.pm * tstep + (size_t)cur.kt0 * kstep; const char* cB = (const char*)g.Bt + (size_t)cur.pn * tstep + (size_t)cur.kt0 * kstep;
    S.a_ready(cur);
    if constexpr (SP2) {
        PG8_STAGE(PG8_SB(0, 0), cB, voffB); PG8_STAGE(PG8_SB(0, 1), cB + hstep, voffB); PG8_STAGE(PG8_SA(0, 0), cA, voffA); PG8_STAGE(PG8_SA(0, 1), cA + hstep, voffA);
        if (wr == 1) PG8_BAR;
        PG8_WAIT_V(2); PG8_BAR;
        PG8_STAGE(PG8_SB(1, 0), cB + kstep, voffB); PG8_STAGE(PG8_SA(1, 0), cA + kstep, voffA); PG8_STAGE(PG8_SB(1, 1), cB + hstep + kstep, voffB);
        PG8_WAIT_V(6); PG8_BAR;
    } else {
        PG8_STAGE(PG8_SB(0, 0), cB, voffB); PG8_STAGE(PG8_SA(0, 0), cA, voffA); PG8_STAGE(PG8_SB(0, 1), cB + hstep, voffB); PG8_STAGE(PG8_SA(0, 1), cA + hstep, voffA);
        if (wr == 1) PG8_BAR;
        PG8_WAIT_V(4); PG8_BAR;
        PG8_STAGE(PG8_SB(1, 0), cB + kstep, voffB); PG8_STAGE(PG8_SA(1, 0), cA + kstep, voffA); PG8_STAGE(PG8_SB(1, 1), cB + hstep + kstep, voffB);
        PG8_WAIT_V(6); PG8_BAR;
    }
    for (;;) {
        const bool has_next = S.next(ui + 1, nxt);
        const char* nA = has_next ? (const char*)g.A + (size_t)nxt.pm * tstep + (size_t)nxt.kt0 * kstep : cA; const char* nB = has_next ? (const char*)g.Bt + (size_t)nxt.pn * tstep + (size_t)nxt.kt0 * kstep : cB;
        const int nt = cur.nt;
        for (int t = 0; t < nt; t += 2) {
            asm volatile("" : "+v"(voffA[0]), "+v"(voffA[1]), "+v"(voffB[0]), "+v"(voffB[1]));
            const bool last = (t == nt - 2);
            const char* a1 = cA + (size_t)(t + 1) * kstep;
            const char* a2 = last ? nA : cA + (size_t)(t + 2) * kstep; const char* b2 = last ? nB : cB + (size_t)(t + 2) * kstep;
            const char* a3 = a2 + kstep; const char* b3 = b2 + kstep;
            if (last && has_next) S.a_ready(nxt);
            if constexpr (SP2) {
            PG8_LDB(B0, 0, 0); PG8_LDB(B1, 0, 1); PG8_SCHED; PG8_LDA(At, 0, 0); PG8_STAGE(PG8_SA(1, 1), a1 + hstep, voffA);
            PG8_WAIT_V(8); PG8_WAIT_L(0); PG8_BAR; PG8_MMA(0, 0, At, B0); PG8_MMA(0, 1, At, B1); PG8_BAR; PG8_SCHED;
            PG8_LDA(At, 0, 1); PG8_STAGE(PG8_SB(0, 0), b2, voffB); PG8_STAGE(PG8_SB(0, 1), b2 + hstep, voffB); PG8_STAGE(PG8_SA(0, 0), a2, voffA);
            PG8_WAIT_V(8); PG8_WAIT_L(0); PG8_BAR; PG8_MMA(1, 0, At, B0); PG8_MMA(1, 1, At, B1); PG8_BAR; PG8_SCHED;
            PG8_LDB(B0, 1, 0); PG8_LDB(B1, 1, 1); PG8_SCHED; PG8_LDA(At, 1, 0); PG8_STAGE(PG8_SA(0, 1), a2 + hstep, voffA);
            PG8_WAIT_V(8); PG8_WAIT_L(0); PG8_BAR; PG8_MMA(0, 0, At, B0); PG8_MMA(0, 1, At, B1); PG8_BAR; PG8_SCHED;
            PG8_LDA(At, 1, 1); PG8_STAGE(PG8_SB(1, 0), b3, voffB); PG8_STAGE(PG8_SB(1, 1), b3 + hstep, voffB); PG8_STAGE(PG8_SA(1, 0), a3, voffA);
            PG8_WAIT_V(8); PG8_WAIT_L(0); PG8_BAR; PG8_MMA(1, 0, At, B0); PG8_MMA(1, 1, At, B1); PG8_BAR; PG8_SCHED;
            } else {
            PG8_LDB(B0, 0, 0); PG8_SCHED; PG8_LDA(At, 0, 0); PG8_STAGE(PG8_SA(1, 1), a1 + hstep, voffA);
            PG8_WAIT_L(8); PG8_BAR; PG8_WAIT_L(0); PG8_MMA(0, 0, At, B0); PG8_BAR; PG8_SCHED;
            PG8_LDB(B1, 0, 1); PG8_STAGE(PG8_SB(0, 0), b2, voffB);
            PG8_BAR; PG8_WAIT_L(0); PG8_MMA(0, 1, At, B1); PG8_BAR;
            PG8_LDA(At, 0, 1); PG8_STAGE(PG8_SA(0, 0), a2, voffA);
            PG8_BAR; PG8_WAIT_L(0); PG8_MMA(1, 0, At, B0); PG8_BAR; PG8_SCHED;
            PG8_STAGE(PG8_SB(0, 1), b2 + hstep, voffB);
            PG8_WAIT_V(6); PG8_BAR; PG8_MMA(1, 1, At, B1); PG8_BAR;
            PG8_LDB(B0, 1, 0); PG8_SCHED; PG8_LDA(At, 1, 0); PG8_STAGE(PG8_SA(0, 1), a2 + hstep, voffA);
            PG8_WAIT_L(8); PG8_BAR; PG8_WAIT_L(0); PG8_MMA(0, 0, At, B0); PG8_BAR; PG8_SCHED;
            PG8_LDB(B1, 1, 1); PG8_STAGE(PG8_SB(1, 0), b3, voffB);
            PG8_BAR; PG8_WAIT_L(0); PG8_MMA(0, 1, At, B1); PG8_BAR;
            PG8_LDA(At, 1, 1); PG8_STAGE(PG8_SA(1, 0), a3, voffA);
            PG8_BAR; PG8_WAIT_L(0); PG8_MMA(1, 0, At, B0); PG8_BAR; PG8_SCHED;
            PG8_STAGE(PG8_SB(1, 1), b3 + hstep, voffB);
            PG8_WAIT_V(6); PG8_BAR; PG8_MMA(1, 1, At, B1); PG8_BAR;
            }
        }
        if constexpr (ALIGN_EPI) { if (wr == 0) PG8_BAR; }
        if constexpr (!Epi::AFTER_DRAIN) { E(acc, cur, wr, wc, fr, fq); S.done(cur); }
        if (!has_next) break;
#pragma unroll
        for (int a = 0; a < 2; ++a)
#pragma unroll
            for (int b = 0; b < 2; ++b)
#pragma unroll
                for (int m = 0; m < 4; ++m)
#pragma unroll
                    for (int n = 0; n < 2; ++n) acc[a][b][m][n] = (f32x4){0.f, 0.f, 0.f, 0.f};
        cur = nxt; cA = nA; cB = nB; ++ui;
        if constexpr (ALIGN_EPI) { if (wr == 1) PG8_BAR; }
    }
    PG8_WAIT_V(0);
    if constexpr (!ALIGN_EPI) { if (wr == 0) PG8_BAR; }
    PG8_BAR;
    if constexpr (Epi::AFTER_DRAIN) { E.fused(acc, cur, wr, wc, fr, fq, lds, wid, lane); S.done(cur); }
#undef PG8_SA
#undef PG8_SB
#undef PG8_STAGE
#undef PG8_LDA
#undef PG8_LDB
#undef PG8_MMA
#undef PG8_WAIT_V
#undef PG8_WAIT_L
#undef PG8_BAR
#undef PG8_SCHED
}
}
namespace att {
using bf16x8 = __attribute__((ext_vector_type(8))) short;
using s16x4  = __attribute__((ext_vector_type(4))) short;
using f32x16 = __attribute__((ext_vector_type(16))) float;
using u32x4  = __attribute__((ext_vector_type(4))) unsigned;
using u32x2  = __attribute__((ext_vector_type(2))) unsigned;
constexpr int NW = 8, QBLK = 32, KVBLK = 64;
constexpr int SHM_V = 16384, SHM_K = 16384, SHM_ATTN = 3 * SHM_V + 3 * SHM_K + NW * 64 * 4;
#define KSWZ(row, colB) ((row) * 256 + ((colB) ^ (((row) & 7) << 4)))
#define SBAR() __builtin_amdgcn_sched_barrier(0)
__device__ __forceinline__ int crow(int r, int hi) { return (r & 3) + 8 * (r >> 2) + 4 * hi; }
__device__ __forceinline__ unsigned cvtpk(float lo, float hi) { unsigned r; asm volatile("v_cvt_pk_bf16_f32 %0, %1, %2" : "=v"(r) : "v"(lo), "v"(hi)); return r; }

#define MX3(a, b, c) __builtin_fmaxf(__builtin_fmaxf((a), (b)), (c))
template <bool FIRST>
__device__ __forceinline__ void partialSM(f32x16& p0, f32x16& p1, float& m_reg, f32x16& negm, float& alpha, const float thr) {
  float a = MX3(p0[0], p0[1], p1[0]), b = MX3(p0[2], p0[3], p1[1]); a = MX3(a, p1[2], p1[3]);
#pragma unroll
  for (int r = 4; r < 16; r += 4) { a = MX3(a, p0[r], p0[r + 1]); b = MX3(b, p0[r + 2], p0[r + 3]); a = MX3(a, p1[r], p1[r + 1]); b = MX3(b, p1[r + 2], p1[r + 3]); }
  float pmax = fmaxf(a, b);
  { auto rr = __builtin_amdgcn_permlane32_swap(__float_as_uint(pmax), __float_as_uint(pmax), false, false);
    pmax = fmaxf(__uint_as_float(rr[0]), __uint_as_float(rr[1])); }
  alpha = 1.f;
  if (FIRST || !__builtin_expect(__all(pmax <= thr), 1)) {
    const float dl = FIRST ? pmax : fmaxf(pmax, 0.f);
    alpha = __builtin_amdgcn_exp2f(-dl); m_reg += dl;
#pragma unroll
    for (int r = 0; r < 16; ++r) { p0[r] -= dl; p1[r] -= dl; }
#pragma unroll
    for (int r = 0; r < 16; ++r) negm[r] = -m_reg;
  }
#pragma unroll
  for (int r = 0; r < 16; ++r) p0[r] = __builtin_amdgcn_exp2f(p0[r]);
}
__device__ __forceinline__ void finishSM(f32x16& p0, f32x16& p1, bf16x8& pa0, bf16x8& pa1, bf16x8& pa2, bf16x8& pa3) {
#pragma unroll
  for (int r = 0; r < 16; ++r) p1[r] = __builtin_amdgcn_exp2f(p1[r]);
#define PK4(P, BASE, OUT) do { unsigned a0 = cvtpk(P[BASE + 0], P[BASE + 1]), a1 = cvtpk(P[BASE + 2], P[BASE + 3]);   \
    unsigned b0 = cvtpk(P[BASE + 4], P[BASE + 5]), b1 = cvtpk(P[BASE + 6], P[BASE + 7]);                              \
    auto r0 = __builtin_amdgcn_permlane32_swap(a0, b0, false, false); auto r1 = __builtin_amdgcn_permlane32_swap(a1, b1, false, false); \
    u32x4 w = {r0[0], r1[0], r0[1], r1[1]}; OUT = *reinterpret_cast<bf16x8*>(&w); } while (0)
  PK4(p0, 0, pa0); PK4(p0, 8, pa1); PK4(p1, 0, pa2); PK4(p1, 8, pa3);
#undef PK4
}
template <int DQK>
__device__ __forceinline__ void qkt(f32x16& p0, f32x16& p1, const char* Ks, const bf16x8* qr, const f32x16& negm, int r32, int hi) {
  p0 = negm; p1 = negm;
  __builtin_amdgcn_s_setprio(1);
#pragma unroll
  for (int d0 = 0; d0 < DQK / 16; ++d0) { int cb = (d0 * 16 + hi * 8) * 2;
    bf16x8 b0 = *reinterpret_cast<const bf16x8*>(Ks + KSWZ(r32, cb));
    bf16x8 b1 = *reinterpret_cast<const bf16x8*>(Ks + KSWZ(32 + r32, cb));
    p0 = __builtin_amdgcn_mfma_f32_32x32x16_bf16(b0, qr[d0], p0, 0, 0, 0);
    p1 = __builtin_amdgcn_mfma_f32_32x32x16_bf16(b1, qr[d0], p1, 0, 0, 0); }
  __builtin_amdgcn_s_setprio(0);
}
__device__ __forceinline__ int v_st(int k, int c) { const int kk = (k & ~0xC) | ((k & 4) << 1) | ((k & 8) >> 1); return ((kk >> 3) * 4 + (c >> 5)) * 512 + ((kk & 7) * 32 + (c & 31)) * 2; }
__device__ __forceinline__ int v_rd_base(int lane) { return ((lane & 3) << 3) | (((lane >> 2) & 3) << 6) | (((lane >> 4) & 1) << 5) | (((lane >> 5) & 1) << 8); }
constexpr int v_rd_off(int d0, int ks, int half) { return d0 * 512 + ks * 4096 + half * 2048; }
template <int OFF> __device__ __forceinline__ s16x4 tr_read(int vb) {
  s16x4 r; asm volatile("ds_read_b64_tr_b16 %0, %1 offset:%2" : "=&v"(r) : "v"(vb), "i"(OFF) : "memory"); return r;
}
struct VFrag { s16x4 l[4], h[4]; };
template <int D0> __device__ __forceinline__ void v_reads(VFrag& f, int vb) {
  f.l[0] = tr_read<v_rd_off(D0, 0, 0)>(vb); f.h[0] = tr_read<v_rd_off(D0, 0, 1)>(vb); f.l[1] = tr_read<v_rd_off(D0, 1, 0)>(vb); f.h[1] = tr_read<v_rd_off(D0, 1, 1)>(vb);
  f.l[2] = tr_read<v_rd_off(D0, 2, 0)>(vb); f.h[2] = tr_read<v_rd_off(D0, 2, 1)>(vb); f.l[3] = tr_read<v_rd_off(D0, 3, 0)>(vb); f.h[3] = tr_read<v_rd_off(D0, 3, 1)>(vb);
}
__device__ __forceinline__ void pv_mma(f32x16* o, f32x16& lacc, VFrag& f, int vb, bf16x8 pa0, bf16x8 pa1, bf16x8 pa2, bf16x8 pa3) {
  const bf16x8 ones = {0x3F80, 0x3F80, 0x3F80, 0x3F80, 0x3F80, 0x3F80, 0x3F80, 0x3F80};
  asm volatile("s_waitcnt lgkmcnt(0)" ::: "memory"); SBAR();
#define PK(L, H) (bf16x8){L[0], L[1], L[2], L[3], H[0], H[1], H[2], H[3]}
  o[0] = __builtin_amdgcn_mfma_f32_32x32x16_bf16(pa0, PK(f.l[0], f.h[0]), o[0], 0, 0, 0);
  o[0] = __builtin_amdgcn_mfma_f32_32x32x16_bf16(pa1, PK(f.l[1], f.h[1]), o[0], 0, 0, 0);
  o[0] = __builtin_amdgcn_mfma_f32_32x32x16_bf16(pa2, PK(f.l[2], f.h[2]), o[0], 0, 0, 0);
  o[0] = __builtin_amdgcn_mfma_f32_32x32x16_bf16(pa3, PK(f.l[3], f.h[3]), o[0], 0, 0, 0);
  SBAR(); v_reads<1>(f, vb); SBAR();
  lacc = __builtin_amdgcn_mfma_f32_32x32x16_bf16(pa0, ones, lacc, 0, 0, 0);
  lacc = __builtin_amdgcn_mfma_f32_32x32x16_bf16(pa1, ones, lacc, 0, 0, 0);
  lacc = __builtin_amdgcn_mfma_f32_32x32x16_bf16(pa2, ones, lacc, 0, 0, 0);
  lacc = __builtin_amdgcn_mfma_f32_32x32x16_bf16(pa3, ones, lacc, 0, 0, 0);
  asm volatile("s_waitcnt lgkmcnt(0)" ::: "memory"); SBAR();
  o[1] = __builtin_amdgcn_mfma_f32_32x32x16_bf16(pa0, PK(f.l[0], f.h[0]), o[1], 0, 0, 0);
  o[1] = __builtin_amdgcn_mfma_f32_32x32x16_bf16(pa1, PK(f.l[1], f.h[1]), o[1], 0, 0, 0);
  o[1] = __builtin_amdgcn_mfma_f32_32x32x16_bf16(pa2, PK(f.l[2], f.h[2]), o[1], 0, 0, 0);
  o[1] = __builtin_amdgcn_mfma_f32_32x32x16_bf16(pa3, PK(f.l[3], f.h[3]), o[1], 0, 0, 0);
#undef PK
}
struct Unit {
  const unsigned short* Q; const unsigned short* K; const unsigned short* KR; const unsigned short* V; unsigned short* O;
  int ldq, ldk, NT, kstart, q0;
  float C, thr_raw, sinkl2;
};
__device__ __forceinline__ void wmask(f32x16& p0, f32x16& p1, int tilepos, int qpos, int hi) {
#pragma unroll
  for (int r = 0; r < 16; ++r) { const int k0 = tilepos + crow(r, hi); int d0 = qpos - k0; d0 = d0 < 0 ? -d0 : d0; int d1 = qpos - (k0 + 32); d1 = d1 < 0 ? -d1 : d1;
    if (d0 > 128) p0[r] = -1e30f; if (d1 > 128) p1[r] = -1e30f; }
}
template <int DQK, bool WINDOW>
__device__ __forceinline__ void attn_unit(const Unit& U, char* lds) {
  const int tid = opaque_tid(), wid = __builtin_amdgcn_readfirstlane(tid >> 6), lane = tid & 63, r32 = lane & 31, hi = lane >> 5;
  char* V_lds = lds; char* K_lds = lds + 3 * SHM_V;
  float* ws = (float*)(lds + 3 * SHM_V + 3 * SHM_K) + wid * 64; float* li_l = ws; float* al_l = ws + 32;
  const float thr = 11.5415603f;
  float m_reg = 0.f; f32x16 o[2] = {}; f32x16 lacc = {}; f32x16 negm = {}; bf16x8 qr[DQK / 16];
  const unsigned short* Qw = U.Q + (long)(wid * QBLK + r32) * U.ldq + hi * 8;
#pragma unroll
  for (int d0 = 0; d0 < DQK / 16; ++d0) qr[d0] = *reinterpret_cast<const bf16x8*>(Qw + d0 * 16);
  const int sr = tid >> 3, sc = (tid & 7) * 8, vst0 = v_st(sr, sc), kst0 = KSWZ(sr, sc * 2);
  const int srr = (tid >> 2) & 63, scr = (tid & 3) * 8, kst1 = KSWZ(srr, (64 + scr) * 2);
  const bool do_r = (DQK == 96) && (tid < 256);
  const int vb0 = (int)(uintptr_t)V_lds + v_rd_base(lane);
  const int ldk = U.ldk, kstart = U.kstart;
  const int qpos = U.q0 + wid * QBLK + r32; const int qlo = U.q0 + wid * QBLK;
  struct { bf16x8 vs, ks, rs; } sr_[3];
#define KROW(j) ((long)(64 * (j) + ((j) >= 4 ? kstart : 0)))
#define SLOAD(i, j) do { const long kr_ = KROW(j); sr_[i].vs = *reinterpret_cast<const bf16x8*>(U.V + (kr_ + sr) * ldk + sc); \
    sr_[i].ks = *reinterpret_cast<const bf16x8*>(U.K + (kr_ + sr) * ldk + sc); \
    if (DQK == 96) { if (do_r) sr_[i].rs = *reinterpret_cast<const bf16x8*>(U.KR + (kr_ + srr) * 32 + scr); } } while (0)
#define SWRITE(soff, i) do { *(bf16x8*)(V_lds + (soff) + vst0) = sr_[i].vs; *(bf16x8*)(K_lds + (soff) + kst0) = sr_[i].ks; \
    if (DQK == 96) { if (do_r) *(bf16x8*)(K_lds + (soff) + kst1) = sr_[i].rs; } } while (0)
#define RESC(a) do { if (__any((a) < 1.f)) { if (hi == 0) al_l[r32] = (a); asm volatile("s_waitcnt lgkmcnt(0)" ::: "memory"); \
    _Pragma("unroll") for (int r = 0; r < 16; ++r) { const float f_ = al_l[crow(r, hi)]; o[0][r] *= f_; o[1][r] *= f_; lacc[r] *= f_; } } } while (0)
#define WMASK(P0, P1, j) do { if (WINDOW) { if ((j) >= 4) wmask(P0, P1, kstart + 64 * ((j) - 4), qpos, hi); } } while (0)
#define QKM(P0, P1, KP, j, SK) do { SK = false; \
    if (WINDOW && (j) >= 4) { const int tp_ = kstart + 64 * ((j) - 4); \
      if (tp_ + 63 < qlo - 128 || tp_ > qlo + 31 + 128) { SK = true; _Pragma("unroll") for (int r_ = 0; r_ < 16; ++r_) { P0[r_] = 0.f; P1[r_] = 0.f; } } \
      else { qkt<DQK>(P0, P1, KP, qr, negm, r32, hi); if (!(tp_ >= qlo + 31 - 128 && tp_ + 63 <= qlo + 128)) wmask(P0, P1, tp_, qpos, hi); } } \
    else qkt<DQK>(P0, P1, KP, qr, negm, r32, hi); } while (0)
#define LIVE(SK) (!(WINDOW && (SK)))
#define ROT() do { const int t_ = s_prev; s_prev = s_cur; s_cur = s_next; s_next = t_; } while (0)
  static_assert(SHM_V == SHM_K, "one slot offset serves both rings");
  f32x16 pA0, pA1, pB0, pB1; float alA, alB; bool skA = false, skB = false; bf16x8 pa0, pa1, pa2, pa3; const int NT = U.NT; VFrag vf;
  int s_prev = 2 * SHM_V, s_cur = 0, s_next = SHM_V;
  SLOAD(1, 0); SLOAD(2, 1); if (2 < NT) SLOAD(0, 2);
  SWRITE(0, 1); SWRITE(SHM_V, 2);
  __syncthreads();
  qkt<DQK>(pA0, pA1, K_lds, qr, negm, r32, hi); partialSM<true>(pA0, pA1, m_reg, negm, alA, thr);
  ROT();
  for (int j = 1; j + 1 < NT; j += 2) {
    SWRITE(s_next, 0); if (j + 2 < NT) SLOAD(0, j + 2);
    SBAR(); QKM(pB0, pB1, K_lds + s_cur, j, skB);
    if (LIVE(skA)) { v_reads<0>(vf, vb0 + s_prev); finishSM(pA0, pA1, pa0, pa1, pa2, pa3); pv_mma(o, lacc, vf, vb0 + s_prev, pa0, pa1, pa2, pa3); }
    if (LIVE(skB)) partialSM<false>(pB0, pB1, m_reg, negm, alB, thr); else alB = 1.f;
    __syncthreads(); RESC(alB); ROT();
    if (j + 2 < NT) SWRITE(s_next, 0); if (j + 3 < NT) SLOAD(0, j + 3);
    SBAR(); QKM(pA0, pA1, K_lds + s_cur, j + 1, skA);
    if (LIVE(skB)) { v_reads<0>(vf, vb0 + s_prev); finishSM(pB0, pB1, pa0, pa1, pa2, pa3); pv_mma(o, lacc, vf, vb0 + s_prev, pa0, pa1, pa2, pa3); }
    if (LIVE(skA)) partialSM<false>(pA0, pA1, m_reg, negm, alA, thr); else alA = 1.f;
    __syncthreads(); RESC(alA); ROT();
  }
  SBAR(); QKM(pB0, pB1, K_lds + s_cur, NT - 1, skB);
  if (LIVE(skA)) { v_reads<0>(vf, vb0 + s_prev); finishSM(pA0, pA1, pa0, pa1, pa2, pa3); pv_mma(o, lacc, vf, vb0 + s_prev, pa0, pa1, pa2, pa3); }
  if (LIVE(skB)) {
    partialSM<false>(pB0, pB1, m_reg, negm, alB, thr);
    RESC(alB);
    SBAR(); v_reads<0>(vf, vb0 + s_cur); SBAR();
    finishSM(pB0, pB1, pa0, pa1, pa2, pa3);
    pv_mma(o, lacc, vf, vb0 + s_cur, pa0, pa1, pa2, pa3);
  }
  if (hi == 0) li_l[r32] = __builtin_amdgcn_exp2f(fmaxf(U.sinkl2 - m_reg, -126.f));
  asm volatile("s_waitcnt lgkmcnt(0)" ::: "memory");
  float rli[16];
#pragma unroll
  for (int r = 0; r < 16; ++r) rli[r] = __builtin_amdgcn_rcpf(lacc[r] + li_l[crow(r, hi)]);
  unsigned short* Ow = U.O + (long)(wid * QBLK) * 1024;
#pragma unroll
  for (int r = 0; r < 16; ++r) { const int orow = crow(r, hi);
#pragma unroll
    for (int d0 = 0; d0 < 2; ++d0) { const float lo = o[d0][r] * rli[r]; const unsigned pk = cvtpk(lo, lo); Ow[(long)orow * 1024 + d0 * 32 + r32] = (unsigned short)(pk & 0xffffu); } }
  __syncthreads();
#undef KROW
#undef SLOAD
#undef SWRITE
#undef RESC
#undef WMASK
#undef QKM
#undef LIVE
#undef ROT
}
#undef SBAR
}
constexpr int DM = 1024, NP_ROWS = 4096, NS_ROWS = 16384, M_ROWS = 20480, EXT_ROWS = 21504, EXT_B = 4352, DFF = 4096;
constexpr float EPS_ = 1e-6f;
constexpr float LOG2_THETA = 13.287712379549449f;
constexpr float INV_2PI = 0.15915494309189535f;
typedef unsigned short bfu;
typedef float f32x4 __attribute__((ext_vector_type(4)));
typedef unsigned u32x4 __attribute__((ext_vector_type(4)));
typedef unsigned u32x2 __attribute__((ext_vector_type(2)));
__device__ __forceinline__ unsigned pkbf(float lo, float hi) { return pg8::cvt_pk_bf16(lo, hi); }
__device__ __forceinline__ void rope_cs(int pos, int i, float inv_den, float& c, float& s) {
    const float f = __builtin_amdgcn_exp2f(-(float)i * (LOG2_THETA * inv_den));
    const float rev = (float)pos * f * INV_2PI;
    c = __builtin_amdgcn_cosf(rev); s = __builtin_amdgcn_sinf(rev);
}
__device__ __forceinline__ int cond_of_row(int row) { return row < NP_ROWS ? 4 : ((row - NP_ROWS) >> 12); }
__device__ __forceinline__ int ext_of_row(int row) { return row < NP_ROWS ? row : (NP_ROWS + ((row - NP_ROWS) >> 12) * EXT_B + 256 + ((row - NP_ROWS) & 4095)); }

#define EPI_FENCE() asm volatile("" ::: "memory")
template <bool NORMC> struct EpiQKV {
    static constexpr bool PERM = false, AFTER_DRAIN = false;
    bfu* Q; bfu* Kb; bfu* Vb; float* stK; float* stV; const float* gq; const float* gk; int nstate;
    __device__ __forceinline__ void operator()(const f32x4 (&acc)[2][2][4][2], const pg8::Unit& u, int wr, int wc, int fr, int fq) const {
        asm volatile("" : "+v"(fr), "+v"(fq));
        const int pn = u.pn; const bool isQ = pn < 4, isK = pn == 4; const bool sample = u.pm >= 16;
        const bool dorope = sample && pn < 5;
        float frq[4];
#pragma unroll
        for (int j = 0; j < 4; ++j) frq[j] = __builtin_amdgcn_exp2f(-(float)(4 * fq + j) * (LOG2_THETA / 16.0f)) * INV_2PI;
        const unsigned cq = 64 * wc + 4 * fq;
#pragma unroll
        for (int ai = 0; ai < 2; ++ai)
#pragma unroll
            for (int m = 0; m < 4; ++m) {
                unsigned row = u.pm * 256 + ai * 128 + wr * 64 + m * 16 + fr; asm volatile("" : "+v"(row));
                f32x4 v[2][2];
#pragma unroll
                for (int bj = 0; bj < 2; ++bj)
#pragma unroll
                    for (int n = 0; n < 2; ++n) v[bj][n] = acc[ai][bj][m][n];
                if (NORMC && pn < 5) {
                    float ss = 0.f;
#pragma unroll
                    for (int bj = 0; bj < 2; ++bj)
#pragma unroll
                        for (int n = 0; n < 2; ++n) ss += (v[bj][n][0] * v[bj][n][0] + v[bj][n][1] * v[bj][n][1]) + (v[bj][n][2] * v[bj][n][2] + v[bj][n][3] * v[bj][n][3]);
                    ss += __shfl_xor(ss, 16); ss += __shfl_xor(ss, 32);
                    const float rstd = 1.0f / sqrtf(ss * (1.0f / 64.0f) + EPS_);
                    const float* g = (isQ ? gq : gk) + 4 * fq;
#pragma unroll
                    for (int bj = 0; bj < 2; ++bj)
#pragma unroll
                        for (int n = 0; n < 2; ++n) { const f32x4 gv = *(const f32x4*)(g + 32 * bj + 16 * n); v[bj][n] = v[bj][n] * rstd * gv; }
                }
                const unsigned t = (row - NP_ROWS) & 4095u;
                if (dorope) {
#pragma unroll
                    for (int bj = 0; bj < 2; ++bj) { const float pos = (float)(bj == 0 ? (t >> 6) : (t & 63u));
#pragma unroll
                        for (int j = 0; j < 4; ++j) { const float rev = pos * frq[j]; const float c = __builtin_amdgcn_cosf(rev), s = __builtin_amdgcn_sinf(rev); const float x1 = v[bj][0][j], x2 = v[bj][1][j];
                            v[bj][0][j] = x1 * c - x2 * s; v[bj][1][j] = x1 * s + x2 * c; } }
                }
                if (isQ) { bfu* p = Q + (row * 1024u + 256u * pn + cq);
#pragma unroll
                    for (int bj = 0; bj < 2; ++bj)
#pragma unroll
                        for (int n = 0; n < 2; ++n) { const f32x4 x = v[bj][n] * (0.125f * 1.4426950408889634f);     u32x2 w; w.x = pkbf(x[0], x[1]); w.y = pkbf(x[2], x[3]); *(u32x2*)(p + 32 * bj + 16 * n) = w; }
                } else {
                    const unsigned e = sample ? (NP_ROWS + ((row - NP_ROWS) >> 12) * EXT_B + 256u + t) : row;
                    bfu* p = (isK ? Kb : Vb) + (e * 256u + cq);
#pragma unroll
                    for (int bj = 0; bj < 2; ++bj)
#pragma unroll
                        for (int n = 0; n < 2; ++n) { const f32x4 x = v[bj][n]; u32x2 w; w.x = pkbf(x[0], x[1]); w.y = pkbf(x[2], x[3]); *(u32x2*)(p + 32 * bj + 16 * n) = w; }
                    if (!sample) { float* st = (isK ? stK : stV) + ((((row >> 8) * nstate) * 256u + (row & 255u)) * 256u + cq);
#pragma unroll
                        for (int bj = 0; bj < 2; ++bj)
#pragma unroll
                            for (int n = 0; n < 2; ++n) *(f32x4*)(st + 32 * bj + 16 * n) = v[bj][n]; }
                }
                EPI_FENCE();
            }
    }
};
struct EpiResid {
    static constexpr bool PERM = true, AFTER_DRAIN = false;
    float* x; const float* gate; bfu* P; const float* xin;
    __device__ __forceinline__ void operator()(const f32x4 (&acc)[2][2][4][2], const pg8::Unit& u, int wr, int wc, int fr, int fq) const {
        asm volatile("" : "+v"(fr), "+v"(fq));
        const int cond = cond_of_row(u.pm * 256); const unsigned c0 = u.pn * 256 + wc * 32 + 8 * fq; const float* g = gate + cond * 6144 + c0;
#pragma unroll
        for (int ai = 0; ai < 2; ++ai)
#pragma unroll
            for (int m = 0; m < 4; ++m) { const unsigned row = u.pm * 256 + ai * 128 + wr * 64 + m * 16 + fr; const unsigned off = row * 1024u + c0;
#pragma unroll
                for (int bj = 0; bj < 2; ++bj) { const f32x4 g0 = *(const f32x4*)(g + bj * 128), g1 = *(const f32x4*)(g + bj * 128 + 4);
                    const f32x4 y0 = g0 * acc[ai][bj][m][0], y1 = g1 * acc[ai][bj][m][1]; const unsigned o2 = off + bj * 128;
                    if (u.split) { u32x4 w; w.x = pkbf(y0[0], y0[1]); w.y = pkbf(y0[2], y0[3]); w.z = pkbf(y1[0], y1[1]); w.w = pkbf(y1[2], y1[3]); *(u32x4*)(P + ((size_t)(u.split - 1) * 4096 * 1024 + o2)) = w; }
                    else { const f32x4 b0 = *(const f32x4*)(xin + o2), b1 = *(const f32x4*)(xin + o2 + 4); *(f32x4*)(x + o2) = b0 + y0; *(f32x4*)(x + o2 + 4) = b1 + y1; } }
                EPI_FENCE(); }
    }
};
struct EpiSqRelu {
    static constexpr bool PERM = true, AFTER_DRAIN = false;
    bfu* O; int ldc;
    __device__ __forceinline__ void operator()(const f32x4 (&acc)[2][2][4][2], const pg8::Unit& u, int wr, int wc, int fr, int fq) const {
        asm volatile("" : "+v"(fr), "+v"(fq));
#pragma unroll
        for (int ai = 0; ai < 2; ++ai)
#pragma unroll
            for (int m = 0; m < 4; ++m) { const unsigned row = u.pm * 256 + ai * 128 + wr * 64 + m * 16 + fr; bfu* p = O + ((size_t)row * ldc + u.pn * 256 + wc * 32 + 8 * fq);
#pragma unroll
                for (int bj = 0; bj < 2; ++bj) { f32x4 v0 = acc[ai][bj][m][0], v1 = acc[ai][bj][m][1];
#pragma unroll
                    for (int j = 0; j < 4; ++j) { const float a = fmaxf(v0[j], 0.f), b = fmaxf(v1[j], 0.f); v0[j] = a * a; v1[j] = b * b; }
                    u32x4 w; w.x = pkbf(v0[0], v0[1]); w.y = pkbf(v0[2], v0[3]); w.z = pkbf(v1[0], v1[1]); w.w = pkbf(v1[2], v1[3]);
                    *(u32x4*)(p + bj * 128) = w; }
                EPI_FENCE(); }
    }
};
struct EpiUKV {
    static constexpr bool PERM = true, AFTER_DRAIN = false;
    bfu* Kn; bfu* Vb;
    __device__ __forceinline__ void operator()(const f32x4 (&acc)[2][2][4][2], const pg8::Unit& u, int wr, int wc, int fr, int fq) const {
        asm volatile("" : "+v"(fr), "+v"(fq));
        bfu* base = (wc < 2 ? Kn : Vb) + (2 * u.pn * 64 + 32 * (wc & 1) + 8 * fq);
#pragma unroll
        for (int ai = 0; ai < 2; ++ai)
#pragma unroll
            for (int m = 0; m < 4; ++m) { const unsigned row = u.pm * 256 + ai * 128 + wr * 64 + m * 16 + fr; bfu* p = base + row * 1024u;
#pragma unroll
                for (int bj = 0; bj < 2; ++bj) { const f32x4 v0 = acc[ai][bj][m][0], v1 = acc[ai][bj][m][1];
                    u32x4 w; w.x = pkbf(v0[0], v0[1]); w.y = pkbf(v0[2], v0[3]); w.z = pkbf(v1[0], v1[1]); w.w = pkbf(v1[2], v1[3]);
                    *(u32x4*)(p + bj * 64) = w; }
                EPI_FENCE(); }
    }
};
struct EpiF32 {
    static constexpr bool PERM = true, AFTER_DRAIN = false;
    bfu* T; int ldc;
    __device__ __forceinline__ void operator()(const f32x4 (&acc)[2][2][4][2], const pg8::Unit& u, int wr, int wc, int fr, int fq) const {
        asm volatile("" : "+v"(fr), "+v"(fq));
#pragma unroll
        for (int ai = 0; ai < 2; ++ai)
#pragma unroll
            for (int m = 0; m < 4; ++m) { const unsigned row = u.pm * 256 + ai * 128 + wr * 64 + m * 16 + fr; bfu* p = T + ((size_t)row * ldc + u.pn * 256 + wc * 32 + 8 * fq);
#pragma unroll
                for (int bj = 0; bj < 2; ++bj) { const f32x4 v0 = acc[ai][bj][m][0], v1 = acc[ai][bj][m][1];
                    u32x4 w; w.x = pkbf(v0[0], v0[1]); w.y = pkbf(v0[2], v0[3]); w.z = pkbf(v1[0], v1[1]); w.w = pkbf(v1[2], v1[3]); *(u32x4*)(p + bj * 128) = w; }
                EPI_FENCE(); }
    }
};
struct EpiUQ {
    static constexpr bool PERM = false, AFTER_DRAIN = false;
    bfu* Q;
    __device__ __forceinline__ void operator()(const f32x4 (&acc)[2][2][4][2], const pg8::Unit& u, int wr, int wc, int fr, int fq) const {
        asm volatile("" : "+v"(fr), "+v"(fq));
        const bool sample = u.pm >= 16;
        float frq[4];
#pragma unroll
        for (int j = 0; j < 4; ++j) frq[j] = __builtin_amdgcn_exp2f(-(float)(4 * (fq & 1) + j) * (LOG2_THETA / 8.0f)) * INV_2PI;
        const bool lowhalf = fq < 2;
#pragma unroll
        for (int ai = 0; ai < 2; ++ai)
#pragma unroll
            for (int m = 0; m < 4; ++m) { unsigned row = u.pm * 256 + ai * 128 + wr * 64 + m * 16 + fr; asm volatile("" : "+v"(row)); const unsigned t = (row - NP_ROWS) & 4095u;
                bfu* p = Q + (row * 1536u + u.pn * 256 + wc * 32 + 4 * fq);
#pragma unroll
                for (int bj = 0; bj < 2; ++bj) {
                    const int g32 = (u.pn * 256 + bj * 128 + wc * 32) >> 5; const bool ropeg = (g32 % 3) == 2;
#pragma unroll
                    for (int n = 0; n < 2; ++n) { f32x4 v = acc[ai][bj][m][n];
                        if (sample && ropeg) { const float pos = (float)(n == 0 ? (t >> 6) : (t & 63u));
#pragma unroll
                            for (int j = 0; j < 4; ++j) { const float other = __shfl_xor(v[j], 32); const float rev = pos * frq[j]; const float c = __builtin_amdgcn_cosf(rev), s = __builtin_amdgcn_sinf(rev);
                                v[j] = lowhalf ? (v[j] * c - other * s) : (other * s + v[j] * c); } }
                        v = v * (0.10206207261596577f * 1.4426950408889634f);
                        u32x2 w; w.x = pkbf(v[0], v[1]); w.y = pkbf(v[2], v[3]);
                        *(u32x2*)(p + bj * 128 + n * 16) = w; } }
                EPI_FENCE(); }
    }
};
#define XB_TMO      128
#define XB_XCNT(j)  (256  + 64 * (j))
#define XB_XSUB(j)  (1280 + 64 * (j))
#define XB_XGEN(j)  (2304 + 64 * (j))
#define XB_TOP      3328
#define XB_TOPGEN   3392
#define XCD_BAR_WORDS 3456
#define XB_SPIN_CAP (1u << 18)

__device__ __forceinline__ unsigned xb_ld(unsigned* p)              { return __hip_atomic_load(p, __ATOMIC_RELAXED, __HIP_MEMORY_SCOPE_AGENT); }
__device__ __forceinline__ unsigned xb_add(unsigned* p, unsigned v) { return __hip_atomic_fetch_add(p, v, __ATOMIC_RELAXED, __HIP_MEMORY_SCOPE_AGENT); }
__device__ __forceinline__ unsigned xb_xcc_id() { return (unsigned)__builtin_amdgcn_s_getreg((3 << 11) | 20) & 0xFu; }
#define XB_SPIN(cond, bar) do { unsigned _sp = 0; while (cond) { __builtin_amdgcn_s_sleep(1); \
    if ((++_sp & 255u) == 0u) { if (xb_ld(&(bar)[XB_TMO])) break; if (_sp > XB_SPIN_CAP) { atomicAdd(&(bar)[XB_TMO], 1u); break; } } } } while (0)

struct XcdBarrier {
    unsigned* bar; unsigned x;
    volatile LAS unsigned* st;
};

__device__ __forceinline__ XcdBarrier xcd_barrier_post(unsigned* bar, volatile LAS unsigned* st) {
    XcdBarrier b; b.bar = bar; b.x = xb_xcc_id(); b.st = st;
    if (threadIdx.x == 0) (void)xb_add(&bar[XB_XCNT(b.x)], 1u);
    return b;
}
__device__ __forceinline__ void xcd_barrier_complete(unsigned* bar, unsigned x, unsigned& nloc, unsigned& nx) {
    const unsigned G = gridDim.x * gridDim.y * gridDim.z;
    unsigned sum, cnt, mine, sp = 0u;
    for (;;) {
        sum = 0u; cnt = 0u; mine = 0u;
#pragma unroll
        for (unsigned j = 0; j < 16; ++j) { const unsigned c = xb_ld(&bar[XB_XCNT(j)]); sum += c; cnt += (c > 0u) ? 1u : 0u; mine = (j == x) ? c : mine; }
        if (sum == G) break;
        __builtin_amdgcn_s_sleep(1);
        if ((++sp & 255u) == 0u) { if (xb_ld(&bar[XB_TMO])) break; if (sp > XB_SPIN_CAP) { atomicAdd(&bar[XB_TMO], 1u); break; } }
    }
    nloc = mine > 0u ? mine : 1u; nx = cnt > 0u ? cnt : 1u;
}

__device__ __forceinline__ void xcd_barrier(const XcdBarrier& b) {
    asm volatile("s_waitcnt vmcnt(0)" ::: "memory");
    __syncthreads();
    if (threadIdx.x == 0) {
        unsigned* bar = b.bar;
        __builtin_amdgcn_s_waitcnt(0);
        unsigned nloc = b.st[0], nx = b.st[1];
        if (nloc == 0u) { xcd_barrier_complete(bar, b.x, nloc, nx); b.st[0] = nloc; b.st[1] = nx; }
        const unsigned old = xb_add(&bar[XB_XSUB(b.x)], 1u);
        const unsigned gen = old / nloc;
        if (old + 1u == (gen + 1u) * nloc) {
            __builtin_amdgcn_fence(__ATOMIC_RELEASE, "agent");
            asm volatile("s_waitcnt vmcnt(0)" ::: "memory");
            const unsigned og = xb_add(&bar[XB_TOP], 1u);
            const unsigned tg = og / nx;
            if (og + 1u == (tg + 1u) * nx) xb_add(&bar[XB_TOPGEN], 1u);
            else XB_SPIN(xb_ld(&bar[XB_TOPGEN]) == tg, bar);
            __builtin_amdgcn_fence(__ATOMIC_ACQUIRE, "agent");
            xb_add(&bar[XB_XGEN(b.x)], 1u);
            asm volatile("s_waitcnt vmcnt(0)" ::: "memory");
        } else {
            XB_SPIN(xb_ld(&bar[XB_XGEN(b.x)]) == gen, bar);
            __builtin_amdgcn_fence(__ATOMIC_ACQUIRE, "agent");
            asm volatile("s_waitcnt vmcnt(0)" ::: "memory");
        }
    }
    __syncthreads();
}

constexpr size_t MiB = 1u << 20;
constexpr size_t WT_MLP_IN = 0;
constexpr size_t WT_MLP_OUT = 4 * (size_t)DM * DFF;
constexpr size_t WT_A_QKV = 8 * (size_t)DM * DFF;
constexpr size_t WT_A_O = WT_A_QKV + 2 * 1536 * 1024;
constexpr size_t WT_C_QKV = WT_A_O + 2 * 1024 * 1024;
constexpr size_t WT_C_O = WT_C_QKV + 1536 * 1024;
constexpr size_t WT_B_DQKV = WT_C_O + 1024 * 1024;
constexpr size_t WT_B_UQ = WT_B_DQKV + 768 * 1024;
constexpr size_t WT_B_UKV = WT_B_UQ + 1536 * 384;
constexpr size_t WT_B_O = WT_B_UKV + 2048 * 256;
constexpr size_t WT_END = WT_B_O + 1024 * 1024;
static_assert(WT_END * 2 <= 88 * MiB, "WT region");
constexpr size_t WS_WT = 0, WS_MODS = 88 * MiB, WS_KR = 89 * MiB, WS_CKVN = 91 * MiB, WS_DQN = 102 * MiB, WS_H = 117 * MiB, WS_R1 = 157 * MiB;
constexpr size_t WS_Q = WS_R1, WS_K = WS_R1 + 60 * MiB, WS_V = WS_K + 42 * MiB, WS_T = WS_R1, WS_HID = WS_R1, WS_CTL = WS_R1 + 160 * MiB, WS_P = WS_CTL + 1 * MiB, WS_END = WS_P + 64 * MiB;

#define GAS1 __attribute__((address_space(1)))
struct Args { const GAS1 float* in[30]; GAS1 float* out; GAS1 unsigned char* ws; int ph_lo, ph_hi; };
struct ArgsH { const float* in[30]; float* out; unsigned char* ws; int ph_lo, ph_hi; };
static_assert(sizeof(Args) == sizeof(ArgsH), "Args layout");

__device__ __forceinline__ float wave_sum(float v) {
#pragma unroll
    for (int o = 1; o < 64; o <<= 1) v += __shfl_xor(v, o);
    return v;
}
template <int MAP>
__device__ __forceinline__ void transpose_item(const float* W, int K, int N, bfu* WT, int row_off, LAS float* scr, int item, int lane) {
    const int nblk = N / 32, kb = item / nblk, nb = item % nblk, k0 = 64 * kb, n0 = 32 * nb;
#pragma unroll 8
    for (int i = 0; i < 32; ++i) { const int kk = 2 * i + (lane >> 5); scr[kk * 33 + (lane & 31)] = W[(size_t)(k0 + kk) * N + n0 + (lane & 31)]; }
    asm volatile("s_waitcnt lgkmcnt(0)" ::: "memory");
    const int c = lane & 7;
#pragma unroll
    for (int j = 0; j < 4; ++j) { const int n = (lane >> 3) + 8 * j; const LAS float* s = scr + (8 * c) * 33 + n;
        u32x4 o; o.x = pkbf(s[0 * 33], s[1 * 33]); o.y = pkbf(s[2 * 33], s[3 * 33]); o.z = pkbf(s[4 * 33], s[5 * 33]); o.w = pkbf(s[6 * 33], s[7 * 33]);
        int src = n0 + n, dst;
        if (MAP == 1) { const int tile = src >> 8, loc = src & 255, hl = loc >> 6, d = loc & 63; dst = tile * 256 + (d >> 5) * 128 + hl * 32 + (d & 31); } else dst = row_off + src;
        *(u32x4*)(WT + (size_t)dst * K + k0 + 8 * c) = o; }
    asm volatile("s_waitcnt lgkmcnt(0)" ::: "memory");
}
__device__ __forceinline__ void norm_row(const float* xin, float* xrow, const bfu* prow, const float* g, const float* shift, const float* scale, bfu* orow, int lane) {
    f32x4 v[4]; float s = 0.f;
#pragma unroll
    for (int j = 0; j < 4; ++j) { v[j] = *((const f32x4*)xin + lane + 64 * j);
        if (prow) { const u32x2* pp = (const u32x2*)prow + lane + 64 * j;
#pragma unroll
            for (int q = 0; q < 4; ++q) { const u32x2 w = pp[(size_t)q * 1048576]; v[j][0] += __uint_as_float(w.x << 16); v[j][1] += __uint_as_float(w.x & 0xffff0000u); v[j][2] += __uint_as_float(w.y << 16); v[j][3] += __uint_as_float(w.y & 0xffff0000u); }
            *((f32x4*)xrow + lane + 64 * j) = v[j]; } s += (v[j][0] * v[j][0] + v[j][1] * v[j][1]) + (v[j][2] * v[j][2] + v[j][3] * v[j][3]); }
    const float rstd = 1.0f / sqrtf(wave_sum(s) * (1.0f / 1024.0f) + EPS_);
#pragma unroll
    for (int j = 0; j < 4; ++j) { const int c = 4 * lane + 256 * j; const f32x4 gv = *(const f32x4*)(g + c), sh = *(const f32x4*)(shift + c), sc = *(const f32x4*)(scale + c);
        const f32x4 y = v[j] * rstd * gv * (sc + 1.0f) + sh; u32x2 w; w.x = pkbf(y[0], y[1]); w.y = pkbf(y[2], y[3]); *((u32x2*)orow + lane + 64 * j) = w; }
}
__device__ __forceinline__ void cvt_rows(const float* src, size_t src_stride, bfu* dst, size_t dst_stride, int nrows, int ncols, int gtid, int gthreads) {
    const int cpr = ncols / 8;
    for (long i = gtid; i < (long)nrows * cpr; i += gthreads) { const int r = (int)(i / cpr), c = (int)(i % cpr) * 8;
        const f32x4 a = *(const f32x4*)(src + (size_t)r * src_stride + c), b = *(const f32x4*)(src + (size_t)r * src_stride + c + 4);
        u32x4 w; w.x = pkbf(a[0], a[1]); w.y = pkbf(a[2], a[3]); w.z = pkbf(b[0], b[1]); w.w = pkbf(b[2], b[3]); *(u32x4*)(dst + (size_t)r * dst_stride + c) = w; }
}

#ifndef G_ALIGN
#define G_ALIGN true
#endif
#ifndef G_SP2
#define G_SP2 true
#endif
#ifndef QKV_SP2
#define QKV_SP2 true
#endif
struct LdsOrder {
    const LAS int* ul;
    __device__ __forceinline__ bool next(int i, pg8::Unit& u) const {
        if (i >= 16) return false;
        const LAS int* p = ul + i * 8;
        const int ok = __builtin_amdgcn_readfirstlane(p[0]); if (!ok) return false;
        u.pm = __builtin_amdgcn_readfirstlane(p[1]); u.pn = __builtin_amdgcn_readfirstlane(p[2]); u.kt0 = __builtin_amdgcn_readfirstlane(p[3]);
        u.nt = __builtin_amdgcn_readfirstlane(p[4]); u.split = __builtin_amdgcn_readfirstlane(p[5]); return true;
    }
    __device__ __forceinline__ void a_ready(const pg8::Unit&) const {}
    __device__ __forceinline__ void done(const pg8::Unit&) const {}
};
constexpr int LDS_UNITS = 131072;
template <class Epi, bool SP2 = G_SP2, bool SPLIT = false>
__device__ __forceinline__ void run_gemm(LAS unsigned char* lds, const bfu* A, const bfu* Bt, int M, int N, int K, const Epi& E) {
    int Kv = K; asm volatile("" : "+s"(Kv));
    LAS int* ul = (LAS int*)(lds + LDS_UNITS);
    { const int t = opaque_tid();
      if (t < 16) { int G_ = gridDim.x, bx_ = blockIdx.x; pg8::StaticOrder S; S.init(M, N, G_, bx_, Kv / 64, SPLIT); const pg8::Unit u = S.get(t);
          ul[t * 8 + 0] = u.nt > 0 ? 1 : 0; ul[t * 8 + 1] = u.pm; ul[t * 8 + 2] = u.pn; ul[t * 8 + 3] = u.kt0; ul[t * 8 + 4] = u.nt; ul[t * 8 + 5] = u.split; }
      __syncthreads(); }
    pg8::Gemm g{A, Bt, M, N, Kv}; LdsOrder S{ul};
    pg8::gemm_phase<Epi, LdsOrder, G_ALIGN, SP2>(lds, g, S, E);
    __syncthreads();
}

constexpr int LDS_BYTES = 147456, LDS_MISC = 147456 - 64;
constexpr int N_PHASES = 32;
#ifndef REP_ATT
#define REP_ATT 1
#endif
#ifndef REP_UP
#define REP_UP 1
#endif
#ifndef REP_RES
#define REP_RES 1
#endif
#ifndef REP_NORM
#define REP_NORM 1
#endif
#ifndef REP_P0
#define REP_P0 1
#endif
#ifndef PH_MASK
#define PH_MASK 0xffff
#endif
#define EN(k) (((PH_MASK) >> (k)) & 1)

typedef const __attribute__((address_space(4))) Args* KArgsP;
__device__ __forceinline__ KArgsP ka() { KArgsP p = (KArgsP)__builtin_amdgcn_kernarg_segment_ptr(); asm volatile("" : "+s"(p)); return p; }
__global__ void __launch_bounds__(512, 2) mega_fwd(Args args) {
    extern __shared__ __attribute__((aligned(16))) unsigned char lds[];
    cg::grid_group grid = cg::this_grid();
    const int lo = args.ph_lo, hi = args.ph_hi; int ph = 0;
    XcdBarrier xbar; xbar.bar = nullptr; xbar.x = 0; xbar.st = nullptr;
    if (hi - lo > 1) {
        volatile LAS unsigned* misc = (volatile LAS unsigned*)((LAS unsigned char*)lds + LDS_MISC);
        if (threadIdx.x < 16) misc[threadIdx.x] = 0u;
        __syncthreads();
        xbar = xcd_barrier_post((unsigned*)((unsigned char*)args.ws + WS_CTL), misc + 8);
    }
#define INP(i) ((const float*)A->in[i])
#define PHASE_LOCALS KArgsP A = ka(); const int tid = opaque_tid(), lane = tid & 63, wave = __builtin_amdgcn_readfirstlane(tid >> 6); \
    int G = gridDim.x, bx = blockIdx.x; asm volatile("" : "+s"(G), "+s"(bx)); const int vcu = (G % 8 == 0) ? (bx % 8) * (G / 8) + bx / 8 : bx; \
    const int gw = bx * 8 + wave, NGW = G * 8, gtid = bx * 512 + tid, GT = G * 512; (void)lane; (void)vcu; (void)gw; (void)NGW; (void)gtid; (void)GT; \
    LAS unsigned char* const ldsl = (LAS unsigned char*)lds; (void)ldsl; unsigned char* const ws = (unsigned char*)A->ws; float* const X = (float*)A->out; \
    bfu* const WT = (bfu*)(ws + WS_WT); float* const mods = (float*)(ws + WS_MODS); bfu* const KR = (bfu*)(ws + WS_KR); bfu* const CKVN = (bfu*)(ws + WS_CKVN); bfu* const DQN = (bfu*)(ws + WS_DQN); \
    bfu* const HB = (bfu*)(ws + WS_H); bfu* const QB = (bfu*)(ws + WS_Q); bfu* const KB = (bfu*)(ws + WS_K); bfu* const VB = (bfu*)(ws + WS_V); float* const TB = (float*)(ws + WS_T); bfu* const HID = (bfu*)(ws + WS_HID); \
    float* const st_a_k = X + 20971520; float* const st_a_v = X + 23068672; float* const st_b_ckv = X + 25165824; float* const st_b_kr = X + 26214400; float* const st_c_k = X + 26345472; float* const st_c_v = X + 27394048; \
    const float* const modl = mods + (size_t)layer * 5 * 6144; const float* const ng = INP(12) + (size_t)layer * 2 * 1024; \
    (void)WT; (void)KR; (void)CKVN; (void)DQN; (void)HB; (void)QB; (void)KB; (void)VB; (void)TB; (void)HID; (void)st_a_k; (void)st_a_v; (void)st_b_ckv; (void)st_b_kr; (void)st_c_k; (void)st_c_v; (void)modl; (void)ng;
#define PH_BEGIN if (ph >= lo && ph < hi) { PHASE_LOCALS
#ifndef REP_SYNC
#define REP_SYNC 1
#endif
#define PH_END if (ph + 1 < hi) { for (int rs_ = 0; rs_ < REP_SYNC; ++rs_) { if (ph == 0) grid.sync(); else xcd_barrier(xbar); } } } ++ph;

    { const int layer = 0;
    PH_BEGIN
    if constexpr (EN(0)) for (int rep_ = 0; rep_ < REP_P0; ++rep_) {
        if (rep_) __syncthreads();
        LAS float* scr = (LAS float*)(ldsl + wave * 16384);
        for (int seg = 0; seg < 20; ++seg) {
            const float* W; int K, N, map = 0, roff = 0; size_t dsto;
            if (seg < 4)       { W = INP(13) + (size_t)seg * DM * DFF; K = DM; N = DFF; dsto = WT_MLP_IN + (size_t)seg * DM * DFF; }
            else if (seg < 8)  { W = INP(14) + (size_t)(seg - 4) * DM * DFF; K = DFF; N = DM; dsto = WT_MLP_OUT + (size_t)(seg - 4) * DM * DFF; }
            else if (seg < 10) { W = INP(15) + (size_t)(seg - 8) * 1024 * 1536; K = 1024; N = 1536; dsto = WT_A_QKV + (size_t)(seg - 8) * 1536 * 1024; map = 1; }
            else if (seg < 12) { W = INP(17) + (size_t)(seg - 10) * 1024 * 1024; K = 1024; N = 1024; dsto = WT_A_O + (size_t)(seg - 10) * 1024 * 1024; }
            else if (seg == 12) { W = INP(25); K = 1024; N = 1536; dsto = WT_C_QKV; map = 1; }
            else if (seg == 13) { W = INP(28); K = 1024; N = 1024; dsto = WT_C_O; }
            else if (seg == 14) { W = INP(18); K = 1024; N = 384; dsto = WT_B_DQKV; }
            else if (seg == 15) { W = INP(21); K = 1024; N = 288; dsto = WT_B_DQKV; roff = 384; }
            else if (seg == 16) { W = INP(20); K = 384; N = 1536; dsto = WT_B_UQ; }
            else if (seg == 17) { W = INP(23); K = 256; N = 2048; dsto = WT_B_UKV; }
            else if (seg == 18) { W = INP(24); K = 1024; N = 1024; dsto = WT_B_O; }
            else break;
            const int nitems = (K / 64) * (N / 32);
            if (map == 1) { for (int it = gw; it < nitems; it += NGW) transpose_item<1>(W, K, N, WT + dsto, 0, scr, it, lane); }
            else          { for (int it = gw; it < nitems; it += NGW) transpose_item<0>(W, K, N, WT + dsto, roff, scr, it, lane); }
        }
        for (int i = gtid; i < 96 * 1024 / 8; i += GT) *(u32x4*)(WT + WT_B_DQKV + (size_t)672 * 1024 + (size_t)i * 8) = (u32x4){0u, 0u, 0u, 0u};
        __syncthreads();
        LAS float* sc = (LAS float*)ldsl;
        LAS float* part = (LAS float*)(ldsl + 20480);
        for (int i = tid; i < 5 * 1024; i += 512) { const int cnd = i >> 10, k = i & 1023; const float v = cnd < 4 ? INP(2)[cnd * 1024 + k] : INP(9)[k]; sc[i] = v / (1.0f + __expf(-v)); }
        __syncthreads();
        for (int item = bx; item < 4 * 192; item += G) {
            const int l = item / 192, cb = item % 192, col = cb * 32 + (lane & 31), kh = (lane >> 5) * 64; const float* Wl = INP(10) + (size_t)l * 1024 * 6144;
            float a0 = 0.f, a1 = 0.f, a2 = 0.f, a3 = 0.f, a4 = 0.f;
#pragma unroll 8
            for (int kk = 0; kk < 64; ++kk) { const int k = wave * 128 + kh + kk; const float w = Wl[(size_t)k * 6144 + col];
                a0 += sc[k] * w; a1 += sc[1024 + k] * w; a2 += sc[2048 + k] * w; a3 += sc[3072 + k] * w; a4 += sc[4096 + k] * w; }
            a0 += __shfl_xor(a0, 32); a1 += __shfl_xor(a1, 32); a2 += __shfl_xor(a2, 32); a3 += __shfl_xor(a3, 32); a4 += __shfl_xor(a4, 32);
            if (lane < 32) { part[(wave * 5 + 0) * 32 + lane] = a0; part[(wave * 5 + 1) * 32 + lane] = a1; part[(wave * 5 + 2) * 32 + lane] = a2; part[(wave * 5 + 3) * 32 + lane] = a3; part[(wave * 5 + 4) * 32 + lane] = a4; }
            __syncthreads();
            if (tid < 160) { const int cnd = tid >> 5, ln = tid & 31; float s = INP(11)[l * 6144 + cb * 32 + ln];
#pragma unroll
                for (int w8 = 0; w8 < 8; ++w8) s += part[(w8 * 5 + cnd) * 32 + ln];
                mods[((size_t)l * 5 + cnd) * 6144 + cb * 32 + ln] = s; }
            __syncthreads();
        }
    }
    PH_END
    }

    for (int layer = 0; layer < 4; ++layer) {
        const int kind = layer % 3, jj = layer / 3;
        PH_BEGIN
        if constexpr (EN(1))
        for (int rep_ = 0; rep_ < REP_NORM; ++rep_)
        for (int r = gw; r < M_ROWS; r += NGW) { const float* mc = modl + cond_of_row(r) * 6144; const bfu* pr = (G == 256 && layer > 0 && r < NP_ROWS) ? (const bfu*)(ws + WS_P) + (size_t)r * 1024 : nullptr; const float* xi = layer > 0 ? X + (size_t)r * 1024 : (r < NP_ROWS ? INP(0) + (size_t)r * 1024 : INP(1) + (size_t)(r - NP_ROWS) * 1024); norm_row(xi, X + (size_t)r * 1024, pr, ng, mc, mc + 1024, HB + (size_t)r * 1024, lane); }
        if constexpr (EN(1))
        for (int b = 0; b < 4; ++b) {
            const size_t e0 = NP_ROWS + (size_t)b * EXT_B;
            if (kind == 0)      { cvt_rows(INP(3) + (size_t)(b * 2 + jj) * 65536, 256, KB + e0 * 256, 256, 256, 256, gtid, GT); cvt_rows(INP(4) + (size_t)(b * 2 + jj) * 65536, 256, VB + e0 * 256, 256, 256, 256, gtid, GT); }
            else if (kind == 2) { cvt_rows(INP(7) + (size_t)b * 65536, 256, KB + e0 * 256, 256, 256, 256, gtid, GT); cvt_rows(INP(8) + (size_t)b * 65536, 256, VB + e0 * 256, 256, 256, 256, gtid, GT); }
            else                { cvt_rows(INP(5) + (size_t)b * 65536, 256, CKVN + e0 * 256, 256, 256, 256, gtid, GT); cvt_rows(INP(6) + (size_t)b * 8192, 32, KR + e0 * 32, 32, 256, 32, gtid, GT); }
        }
        PH_END
        if (kind == 1) {
            PH_BEGIN
            if constexpr (EN(2)) { EpiF32 E{(bfu*)TB, 1024}; run_gemm(ldsl, HB, WT + WT_B_DQKV, M_ROWS, 768, 1024, E); }
            PH_END
            PH_BEGIN
            if constexpr (EN(3))
            for (int r = gw; r < M_ROWS; r += NGW) {
                const bfu* tr = (const bfu*)TB + (size_t)r * 1024; f32x4 v[3];
#pragma unroll
                for (int k = 0; k < 3; ++k) { const u32x2 w = *(const u32x2*)(tr + 4 * lane + 256 * k); v[k][0] = __uint_as_float(w.x << 16); v[k][1] = __uint_as_float(w.x & 0xffff0000u); v[k][2] = __uint_as_float(w.y << 16); v[k][3] = __uint_as_float(w.y & 0xffff0000u); }
                float sq = (v[0][0] * v[0][0] + v[0][1] * v[0][1]) + (v[0][2] * v[0][2] + v[0][3] * v[0][3]);
                const float s1 = (v[1][0] * v[1][0] + v[1][1] * v[1][1]) + (v[1][2] * v[1][2] + v[1][3] * v[1][3]);
                const float s2 = (v[2][0] * v[2][0] + v[2][1] * v[2][1]) + (v[2][2] * v[2][2] + v[2][3] * v[2][3]);
                float skv = 0.f;
                if (lane < 32) { sq += s1; skv = s2; } else { skv = s1; }
                sq = wave_sum(sq); skv = wave_sum(skv);
                const float rq = 1.0f / sqrtf(sq * (1.0f / 384.0f) + EPS_), rkv = 1.0f / sqrtf(skv * (1.0f / 256.0f) + EPS_);
                const bool sample = r >= NP_ROWS; const int e = ext_of_row(r); const int t = (r - NP_ROWS) & 4095;
                { const f32x4 g = *(const f32x4*)(INP(19) + 4 * lane); const f32x4 y = v[0] * rq * g; u32x2 w; w.x = pkbf(y[0], y[1]); w.y = pkbf(y[2], y[3]); *(u32x2*)(DQN + (size_t)r * 384 + 4 * lane) = w; }
                if (lane < 32) {
                    { const f32x4 g = *(const f32x4*)(INP(19) + 256 + 4 * lane); const f32x4 y = v[1] * rq * g; u32x2 w; w.x = pkbf(y[0], y[1]); w.y = pkbf(y[2], y[3]); *(u32x2*)(DQN + (size_t)r * 384 + 256 + 4 * lane) = w; }
                    { const int c = 128 + 4 * lane; const f32x4 g = *(const f32x4*)(INP(22) + c); const f32x4 y = v[2] * rkv * g; u32x2 w; w.x = pkbf(y[0], y[1]); w.y = pkbf(y[2], y[3]); *(u32x2*)(CKVN + (size_t)e * 256 + c) = w;
                      if (!sample) *(f32x4*)(st_b_ckv + (size_t)r * 256 + c) = y; }
                } else {
                    { const int c = 4 * (lane - 32); const f32x4 g = *(const f32x4*)(INP(22) + c); const f32x4 y = v[1] * rkv * g; u32x2 w; w.x = pkbf(y[0], y[1]); w.y = pkbf(y[2], y[3]); *(u32x2*)(CKVN + (size_t)e * 256 + c) = w;
                      if (!sample) *(f32x4*)(st_b_ckv + (size_t)r * 256 + c) = y; }
                }
                { f32x4 y = v[2]; const int l8 = lane - 32;
                  f32x4 oth; oth[0] = __shfl_xor(y[0], 2); oth[1] = __shfl_xor(y[1], 2); oth[2] = __shfl_xor(y[2], 2); oth[3] = __shfl_xor(y[3], 2);
                  if (lane >= 32 && lane < 40) {
                      if (sample) { const int pos = l8 < 4 ? (t >> 6) : (t & 63); const bool first = (l8 & 2) == 0;
#pragma unroll
                          for (int j = 0; j < 4; ++j) { float c, s; rope_cs(pos, 4 * (l8 & 1) + j, 1.0f / 8.0f, c, s); y[j] = first ? (y[j] * c - oth[j] * s) : (oth[j] * s + y[j] * c); } }
                      else *(f32x4*)(st_b_kr + (size_t)r * 32 + 4 * l8) = y;
                      u32x2 w; w.x = pkbf(y[0], y[1]); w.y = pkbf(y[2], y[3]); *(u32x2*)(KR + (size_t)e * 32 + 4 * l8) = w; } }
            }
            PH_END
            PH_BEGIN
            if constexpr (EN(4)) { EpiUQ E{QB}; run_gemm(ldsl, DQN, WT + WT_B_UQ, M_ROWS, 1536, 384, E); }
            if constexpr (EN(5)) { EpiUKV E{KB, VB}; run_gemm(ldsl, CKVN, WT + WT_B_UKV, EXT_ROWS, 2048, 256, E); }
            PH_END
        } else if (kind == 0) {
            PH_BEGIN
            if constexpr (EN(6)) { EpiQKV<false> E{QB, KB, VB, st_a_k + (size_t)jj * 65536, st_a_v + (size_t)jj * 65536, nullptr, nullptr, 2}; run_gemm(ldsl, HB, WT + WT_A_QKV + (size_t)jj * 1536 * 1024, M_ROWS, 1536, 1024, E); }
            PH_END
        } else {
            PH_BEGIN
            if constexpr (EN(7)) { EpiQKV<true> E{QB, KB, VB, st_c_k, st_c_v, INP(26), INP(27), 1}; run_gemm<EpiQKV<true>, QKV_SP2>(ldsl, HB, WT + WT_C_QKV, M_ROWS, 1536, 1024, E); }
            PH_END
        }
        PH_BEGIN
        for (int rep_ = 0; rep_ < REP_ATT; ++rep_)
        for (int i = 0; i < 5; ++i) {
            const int ui = i * G + vcu; if (ui >= 1280) break;
            att::Unit U; int b, h, qb; bool prompt = ui >= 1024;
            if (!prompt) { if (kind == 1) { qb = ui & 15; h = (ui >> 4) & 15; b = ui >> 8; } else { qb = ui & 15; const int g4 = (ui >> 4) & 3, kvh = (ui >> 6) & 3; b = ui >> 8; h = kvh * 4 + g4; } }
            else { const int u2 = ui - 1024; qb = 0; h = u2 & 15; b = u2 >> 4; if (kind != 1) { h = ((u2 >> 2) & 3) * 4 + (u2 & 3); } }
            const int r0 = prompt ? b * 256 : NP_ROWS + b * 4096 + qb * 256; const size_t ebase = prompt ? (size_t)b * 256 : NP_ROWS + (size_t)b * EXT_B;
            U.O = HB + (size_t)r0 * 1024 + h * 64; U.q0 = qb * 256; U.kstart = 0; U.sinkl2 = -1e30f;
            if (kind == 1) { U.Q = QB + (size_t)r0 * 1536 + h * 96; U.ldq = 1536; U.K = KB + ebase * 1024 + h * 64; U.V = VB + ebase * 1024 + h * 64; U.KR = KR + ebase * 32; U.ldk = 1024;
                U.NT = prompt ? 4 : 68; U.C = 0.10206207261596577f * 1.4426950408889634f; U.thr_raw = 8.0f / 0.10206207261596577f; }
            else { const int kvh = h >> 2; U.Q = QB + (size_t)r0 * 1024 + h * 64; U.ldq = 1024; U.K = KB + ebase * 256 + kvh * 64; U.V = VB + ebase * 256 + kvh * 64; U.KR = nullptr; U.ldk = 256;
                U.NT = prompt ? 4 : 68; U.C = 0.125f * 1.4426950408889634f; U.thr_raw = 64.0f;
                if (kind == 0) { U.sinkl2 = INP(16)[jj * 16 + h] * 1.4426950408889634f;
                    if (!prompt) { const int q0 = qb * 256; const int ks = q0 - 128 < 0 ? 0 : q0 - 128; const int ke = q0 + 384 > 4096 ? 4096 : q0 + 384; U.kstart = ks; U.NT = 4 + (ke - ks) / 64; } } }
            if (kind == 1) { if constexpr (EN(8)) att::attn_unit<96, false>(U, (char*)lds); }
            else if (kind == 0) { if constexpr (EN(9)) att::attn_unit<64, true>(U, (char*)lds); }
            else { if constexpr (EN(10)) att::attn_unit<64, false>(U, (char*)lds); }
        }
        PH_END
        PH_BEGIN
        if constexpr (EN(11)) { const bfu* wo = WT + (kind == 0 ? WT_A_O + (size_t)jj * 1024 * 1024 : kind == 1 ? WT_B_O : WT_C_O); EpiResid E{X, modl + 2048, (bfu*)(ws + WS_P), layer == 0 ? INP(1) - (size_t)NP_ROWS * 1024 : (const float*)X}; run_gemm<EpiResid, G_SP2, true>(ldsl, HB, wo, M_ROWS, 1024, 1024, E); }
        PH_END
        PH_BEGIN
        if constexpr (EN(1))
        for (int rep_ = 0; rep_ < REP_NORM; ++rep_)
        for (int r = gw; r < M_ROWS; r += NGW) { const float* mc = modl + cond_of_row(r) * 6144; const bfu* pr = (G == 256 && r < NP_ROWS) ? (const bfu*)(ws + WS_P) + (size_t)r * 1024 : nullptr; const float* xi = (layer == 0 && r < NP_ROWS) ? INP(0) + (size_t)r * 1024 : X + (size_t)r * 1024; norm_row(xi, X + (size_t)r * 1024, pr, ng + 1024, mc + 3072, mc + 4096, HB + (size_t)r * 1024, lane); }
        PH_END
        PH_BEGIN
        for (int rep_ = 0; rep_ < REP_UP; ++rep_)
        if constexpr (EN(12)) { EpiSqRelu E{HID, DFF}; run_gemm(ldsl, HB, WT + WT_MLP_IN + (size_t)layer * DM * DFF, M_ROWS, DFF, DM, E); }
        PH_END
        PH_BEGIN
        if constexpr (EN(11)) { EpiResid E{X, modl + 5120, (bfu*)(ws + WS_P), (const float*)X}; run_gemm<EpiResid, G_SP2, true>(ldsl, HID, WT + WT_MLP_OUT + (size_t)layer * DM * DFF, M_ROWS, DM, DFF, E); }
        PH_END
    }
    { const int layer = 0;
    PH_BEGIN
    if constexpr (EN(1))
    for (int r = gw; r < M_ROWS; r += NGW) {
        float* xr = X + (size_t)r * 1024; f32x4 v[4]; float s = 0.f;
#pragma unroll
        for (int j = 0; j < 4; ++j) { v[j] = *((const f32x4*)xr + lane + 64 * j);
            if (G == 256 && r < NP_ROWS) { const u32x2* pp = (const u32x2*)((const bfu*)(ws + WS_P) + (size_t)r * 1024) + lane + 64 * j;
#pragma unroll
                for (int q = 0; q < 4; ++q) { const u32x2 w = pp[(size_t)q * 1048576]; v[j][0] += __uint_as_float(w.x << 16); v[j][1] += __uint_as_float(w.x & 0xffff0000u); v[j][2] += __uint_as_float(w.y << 16); v[j][3] += __uint_as_float(w.y & 0xffff0000u); } }
            s += (v[j][0] * v[j][0] + v[j][1] * v[j][1]) + (v[j][2] * v[j][2] + v[j][3] * v[j][3]); }
        const float rstd = 1.0f / sqrtf(wave_sum(s) * (1.0f / 1024.0f) + EPS_);
#pragma unroll
        for (int j = 0; j < 4; ++j) { const f32x4 g = *(const f32x4*)(INP(29) + 4 * lane + 256 * j); *((f32x4*)xr + lane + 64 * j) = v[j] * rstd * g; }
    }
    PH_END
    }
#undef PH_BEGIN
#undef PH_END
}

#ifndef MK_MULTI
#define MK_MULTI 0
#endif
extern "C" void kernel_launch(void* const* d_in, const int* in_sizes, int n_in, void* d_out, int out_size, void* d_ws, size_t ws_size, hipStream_t stream) {
    static int grid = 0;
    if (grid == 0) {
        if (n_in != 30 || ws_size < WS_END) { fprintf(stderr, "kernel_launch: n_in %d ws %zu (need %zu)\n", n_in, ws_size, (size_t)WS_END); grid = -1; return; }
        int dev = 0, cus = 0, per_cu = 0;
        hipGetDevice(&dev); hipDeviceGetAttribute(&cus, hipDeviceAttributeMultiprocessorCount, dev);
        if (hipFuncSetAttribute((const void*)mega_fwd, hipFuncAttributeMaxDynamicSharedMemorySize, LDS_BYTES) != hipSuccess) { fprintf(stderr, "kernel_launch: hipFuncSetAttribute failed\n"); grid = -1; return; }
        hipOccupancyMaxActiveBlocksPerMultiprocessor(&per_cu, (const void*)mega_fwd, 512, LDS_BYTES);
        if (per_cu < 1) { fprintf(stderr, "kernel_launch: occupancy query says %d\n", per_cu); per_cu = 1; }
        (void)hipGetLastError();
        grid = cus * 1;
        if (cus != 256) { fprintf(stderr, "kernel_launch: the phase program is laid out for the 256 CUs of MI355X, got %d\n", cus); grid = -1; return; }
    }
    if (grid < 0) return;
    ArgsH a{};
    for (int i = 0; i < 30; ++i) a.in[i] = (const float*)d_in[i];
    a.out = (float*)d_out; a.ws = (unsigned char*)d_ws;
    if (hipMemsetAsync((char*)d_ws + WS_CTL, 0, 16384, stream) != hipSuccess) { fprintf(stderr, "memset failed\n"); return; }
#if MK_MULTI
    for (int p = 0; p < N_PHASES; ++p) { a.ph_lo = p; a.ph_hi = p + 1; void* kargs[] = {&a}; hipError_t e = hipLaunchKernel((const void*)mega_fwd, dim3(grid), dim3(512), kargs, LDS_BYTES, stream); if (e != hipSuccess) { fprintf(stderr, "launch %d failed: %s\n", p, hipGetErrorString(e)); break; } }
#else
    a.ph_lo = 0; a.ph_hi = N_PHASES;
    void* kargs[] = {&a};
    hipError_t e = hipLaunchCooperativeKernel((const void*)mega_fwd, dim3(grid), dim3(512), kargs, LDS_BYTES, stream);
    if (e != hipSuccess) fprintf(stderr, "cooperative launch failed: %s (grid %d)\n", hipGetErrorString(e), grid);
#endif
}
```

```cpp
#include <hip/hip_runtime.h>
#include <hip/hip_cooperative_groups.h>
#include <cstdio>
#include <cstdint>
namespace cg = cooperative_groups;
#define LAS __attribute__((address_space(3)))
__device__ __forceinline__ int opaque_tid() { int t = threadIdx.x; asm volatile("" : "+v"(t)); return t; }
namespace pg8 {
#define PG8_LAS __attribute__((address_space(3)))
typedef unsigned short bf16_t;
typedef short bf16x8 __attribute__((ext_vector_type(8)));
typedef float f32x4 __attribute__((ext_vector_type(4)));
typedef unsigned u32x4 __attribute__((ext_vector_type(4)));
constexpr int BM = 256, BK = 64, HALF = 128, HTB = HALF * BK * 2  , STAGE_BYTES = 8 * HTB, NXCD = 8, WGM = 8;

__host__ __device__ __forceinline__ int lds_byte(int r, int c) { const int st = (r >> 4) * 2 + (c >> 5), rr = r & 15, cc = c & 31, ob = rr * 64 + cc * 2; return st * 1024 + (ob ^ (((ob >> 9) & 1) << 5)); }
__host__ __device__ __forceinline__ void stage_rc(int b, int& R, int& C) { const int st = b / 1024, sb = b % 1024, swz = sb ^ (((sb >> 9) & 1) << 5); R = (st >> 1) * 16 + swz / 64; C = (st & 1) * 32 + (swz % 64) / 2; }
__host__ __device__ __forceinline__ int perm32(int rho) { const int n = rho >> 4, i = rho & 15; return 8 * (i >> 2) + 4 * n + (i & 3); }

struct Unit { int pm, pn, kt0, nt, split; };
struct Gemm { const bf16_t* A; const bf16_t* Bt; int M, N, K; };

struct StaticOrder {
    int nM, nN, nwg, G, c, ntk, rounds, rem, sp;
    __host__ __device__ void init(int M, int N, int G_, int c_, int ntk_ = 0, bool SPLIT = false) { nM = M / BM; nN = N / BM; nwg = nM * nN; G = G_; c = c_; ntk = ntk_;
        rounds = 0; rem = 0; sp = (SPLIT && G == 256 && nM == 80 && nN == 4 && (ntk & 7) == 0) ? 4 : 1; }
    __host__ __device__ Unit get(int i) const {
        Unit u; u.pm = 0; u.pn = 0; u.kt0 = 0; u.nt = 0; u.split = 0;
        if (sp == 4) {
            if (i == 0) { const int id = (c & 7) * 32 + (c >> 3); u.pm = 16 + (id >> 2); u.pn = id & 3; u.nt = ntk; }
            else if (i == 1) { const int t = c >> 2, part = c & 3; u.pm = t >> 2; u.pn = t & 3; u.nt = ntk >> 2; u.kt0 = part * u.nt; u.split = 1 + part; }
            return u; }
        const long LL = (long)i * G + c;
        if (LL < nwg) {
            int wgid = (int)LL; { const int q = nwg / NXCD, r = nwg % NXCD, xcd = wgid % NXCD, off = wgid / NXCD; wgid = (xcd < r ? xcd * (q + 1) : r * (q + 1) + (xcd - r) * q) + off; }
            const int nig = WGM * nN, gid = wgid / nig, fm = gid * WGM, gsz = (nM - fm) < WGM ? (nM - fm) : WGM;
            u.pm = fm + ((wgid % nig) % gsz); u.pn = (wgid % nig) / gsz; u.nt = ntk; }
        return u; }
    __host__ __device__ bool next(int i, Unit& u) const { u = get(i); return u.nt > 0; }
    __device__ __forceinline__ void a_ready(const Unit&) const {}
    __device__ __forceinline__ void done(const Unit&) const {}
};

__device__ __forceinline__ unsigned cvt_pk_bf16(float lo, float hi) { unsigned r; asm volatile("v_cvt_pk_bf16_f32 %0, %1, %2" : "=v"(r) : "v"(lo), "v"(hi)); return r; }
template <class Epi, class Sched, bool ALIGN_EPI = false, bool SP2 = false>
__device__ __forceinline__ void gemm_phase(PG8_LAS unsigned char* lds, const Gemm g, const Sched& S, const Epi& E) {
    const int tid = opaque_tid(), wid = __builtin_amdgcn_readfirstlane(tid >> 6), lane = tid & 63, wr = wid >> 2, wc = wid & 3, fr = lane & 15, fq = lane >> 4;
    const int K = g.K;
    unsigned voffA[2], voffB[2];
#pragma unroll
    for (int i = 0; i < 2; ++i) { int R, C; stage_rc(tid * 16 + i * 8192, R, C); const int Rb = Epi::PERM ? ((R & ~31) + perm32(R & 31)) : R;
        voffA[i] = (unsigned)(R * K + C) * 2u; voffB[i] = (unsigned)(Rb * K + C) * 2u; }
    const size_t kstep = (size_t)(BK * 2);
    const size_t hstep = (size_t)HALF * K * 2;
    const size_t tstep = 2 * hstep;
    const unsigned ldsw = (unsigned)wid * 1024u;
    const int aoff = lds_byte(wr * 64 + fr, fq * 8), boff = lds_byte(wc * 32 + fr, fq * 8);
#define PG8_SA(b, h) (((b) * 2 + (h)) * HTB)
#define PG8_SB(b, h) ((4 + (b) * 2 + (h)) * HTB)
#define PG8_STAGE(bufoff, gbase, voff) do { _Pragma("unroll") for (int _i = 0; _i < 2; ++_i) \
        __builtin_amdgcn_global_load_lds((const unsigned*)((const char*)(gbase) + (voff)[_i]), (PG8_LAS unsigned*)(lds + (bufoff) + ldsw + _i * 8192), 16, 0, 0); } while (0)
#define PG8_LDA(dst, b, h) do { _Pragma("unroll") for (int m = 0; m < 4; ++m) _Pragma("unroll") for (int k = 0; k < 2; ++k) dst[m][k] = *(const PG8_LAS bf16x8*)(lds + PG8_SA(b, h) + aoff + m * 2048 + k * 1024); } while (0)
#define PG8_LDB(dst, b, h) do { _Pragma("unroll") for (int n = 0; n < 2; ++n) _Pragma("unroll") for (int k = 0; k < 2; ++k) dst[n][k] = *(const PG8_LAS bf16x8*)(lds + PG8_SB(b, h) + boff + n * 2048 + k * 1024); } while (0)
#define PG8_MMA(ai, bj, At, Bt) do { __builtin_amdgcn_s_setprio(1); _Pragma("unroll") for (int m = 0; m < 4; ++m) _Pragma("unroll") for (int n = 0; n < 2; ++n) _Pragma("unroll") for (int k = 0; k < 2; ++k) \
        acc[ai][bj][m][n] = __builtin_amdgcn_mfma_f32_16x16x32_bf16(Bt[n][k], At[m][k], acc[ai][bj][m][n], 0, 0, 0); __builtin_amdgcn_s_setprio(0); } while (0)
#define PG8_WAIT_V(n) asm volatile("s_waitcnt vmcnt(" #n ")" ::: "memory")
#define PG8_WAIT_L(n) asm volatile("s_waitcnt lgkmcnt(" #n ")" ::: "memory")
#define PG8_BAR __builtin_amdgcn_s_barrier()
#define PG8_SCHED __builtin_amdgcn_sched_barrier(0)
    Unit cur, nxt; int ui = 0;
    if (!S.next(0, cur)) return;
    f32x4 acc[2][2][4][2];
#pragma unroll
    for (int a = 0; a < 2; ++a)
#pragma unroll
        for (int b = 0; b < 2; ++b)
#pragma unroll
            for (int m = 0; m < 4; ++m)
#pragma unroll
                for (int n = 0; n < 2; ++n) acc[a][b][m][n] = (f32x4){0.f, 0.f, 0.f, 0.f};
    bf16x8 At[4][2], B0[2][2], B1[2][2];
    const char* cA = (const char*)g.A + (size_t)cur.pm * tstep + (size_t)cur.kt0 * kstep; const char* cB = (const char*)g.Bt + (size_t)cur.pn * tstep + (size_t)cur.kt0 * kstep;
    S.a_ready(cur);
    if constexpr (SP2) {
        PG8_STAGE(PG8_SB(0, 0), cB, voffB); PG8_STAGE(PG8_SB(0, 1), cB + hstep, voffB); PG8_STAGE(PG8_SA(0, 0), cA, voffA); PG8_STAGE(PG8_SA(0, 1), cA + hstep, voffA);
        if (wr == 1) PG8_BAR;
        PG8_WAIT_V(2); PG8_BAR;
        PG8_STAGE(PG8_SB(1, 0), cB + kstep, voffB); PG8_STAGE(PG8_SA(1, 0), cA + kstep, voffA); PG8_STAGE(PG8_SB(1, 1), cB + hstep + kstep, voffB);
        PG8_WAIT_V(6); PG8_BAR;
    } else {
        PG8_STAGE(PG8_SB(0, 0), cB, voffB); PG8_STAGE(PG8_SA(0, 0), cA, voffA); PG8_STAGE(PG8_SB(0, 1), cB + hstep, voffB); PG8_STAGE(PG8_SA(0, 1), cA + hstep, voffA);
        if (wr == 1) PG8_BAR;
        PG8_WAIT_V(4); PG8_BAR;
        PG8_STAGE(PG8_SB(1, 0), cB + kstep, voffB); PG8_STAGE(PG8_SA(1, 0), cA + kstep, voffA); PG8_STAGE(PG8_SB(1, 1), cB + hstep + kstep, voffB);
        PG8_WAIT_V(6); PG8_BAR;
    }
    for (;;) {
        const bool has_next = S.next(ui + 1, nxt);
        const char* nA = has_next ? (const char*)g.A + (size_t)nxt.pm * tstep + (size_t)nxt.kt0 * kstep : cA; const char* nB = has_next ? (const char*)g.Bt + (size_t)nxt.pn * tstep + (size_t)nxt.kt0 * kstep : cB;
        const int nt = cur.nt;
        for (int t = 0; t < nt; t += 2) {
            asm volatile("" : "+v"(voffA[0]), "+v"(voffA[1]), "+v"(voffB[0]), "+v"(voffB[1]));
            const bool last = (t == nt - 2);
            const char* a1 = cA + (size_t)(t + 1) * kstep;
            const char* a2 = last ? nA : cA + (size_t)(t + 2) * kstep; const char* b2 = last ? nB : cB + (size_t)(t + 2) * kstep;
            const char* a3 = a2 + kstep; const char* b3 = b2 + kstep;
            if (last && has_next) S.a_ready(nxt);
            if constexpr (SP2) {
            PG8_LDB(B0, 0, 0); PG8_LDB(B1, 0, 1); PG8_SCHED; PG8_LDA(At, 0, 0); PG8_STAGE(PG8_SA(1, 1), a1 + hstep, voffA);
            PG8_WAIT_V(8); PG8_WAIT_L(0); PG8_BAR; PG8_MMA(0, 0, At, B0); PG8_MMA(0, 1, At, B1); PG8_BAR; PG8_SCHED;
            PG8_LDA(At, 0, 1); PG8_STAGE(PG8_SB(0, 0), b2, voffB); PG8_STAGE(PG8_SB(0, 1), b2 + hstep, voffB); PG8_STAGE(PG8_SA(0, 0), a2, voffA);
            PG8_WAIT_V(8); PG8_WAIT_L(0); PG8_BAR; PG8_MMA(1, 0, At, B0); PG8_MMA(1, 1, At, B1); PG8_BAR; PG8_SCHED;
            PG8_LDB(B0, 1, 0); PG8_LDB(B1, 1, 1); PG8_SCHED; PG8_LDA(At, 1, 0); PG8_STAGE(PG8_SA(0, 1), a2 + hstep, voffA);
            PG8_WAIT_V(8); PG8_WAIT_L(0); PG8_BAR; PG8_MMA(0, 0, At, B0); PG8_MMA(0, 1, At, B1); PG8_BAR; PG8_SCHED;
            PG8_LDA(At, 1, 1); PG8_STAGE(PG8_SB(1, 0), b3, voffB); PG8_STAGE(PG8_SB(1, 1), b3 + hstep, voffB); PG8_STAGE(PG8_SA(1, 0), a3, voffA);
            PG8_WAIT_V(8); PG8_WAIT_L(0); PG8_BAR; PG8_MMA(1, 0, At, B0); PG8_MMA(1, 1, At, B1); PG8_BAR; PG8_SCHED;
            } else {
            PG8_LDB(B0, 0, 0); PG8_SCHED; PG8_LDA(At, 0, 0); PG8_STAGE(PG8_SA(1, 1), a1 + hstep, voffA);
            PG8_WAIT_L(8); PG8_BAR; PG8_WAIT_L(0); PG8_MMA(0, 0, At, B0); PG8_BAR; PG8_SCHED;
            PG8_LDB(B1, 0, 1); PG8_STAGE(PG8_SB(0, 0), b2, voffB);
            PG8_BAR; PG8_WAIT_L(0); PG8_MMA(0, 1, At, B1); PG8_BAR;
            PG8_LDA(At, 0, 1); PG8_STAGE(PG8_SA(0, 0), a2, voffA);
            PG8_BAR; PG8_WAIT_L(0); PG8_MMA(1, 0, At, B0); PG8_BAR; PG8_SCHED;
            PG8_STAGE(PG8_SB(0, 1), b2 + hstep, voffB);
            PG8_WAIT_V(6); PG8_BAR; PG8_MMA(1, 1, At, B1); PG8_BAR;
            PG8_LDB(B0, 1, 0); PG8_SCHED; PG8_LDA(At, 1, 0); PG8_STAGE(PG8_SA(0, 1), a2 + hstep, voffA);
            PG8_WAIT_L(8); PG8_BAR; PG8_WAIT_L(0); PG8_MMA(0, 0, At, B0); PG8_BAR; PG8_SCHED;
            PG8_LDB(B1, 1, 1); PG8_STAGE(PG8_SB(1, 0), b3, voffB);
            PG8_BAR; PG8_WAIT_L(0); PG8_MMA(0, 1, At, B1); PG8_BAR;
            PG8_LDA(At, 1, 1); PG8_STAGE(PG8_SA(1, 0), a3, voffA);
            PG8_BAR; PG8_WAIT_L(0); PG8_MMA(1, 0, At, B0); PG8_BAR; PG8_SCHED;
            PG8_STAGE(PG8_SB(1, 1), b3 + hstep, voffB);
            PG8_WAIT_V(6); PG8_BAR; PG8_MMA(1, 1, At, B1); PG8_BAR;
            }
        }
        if constexpr (ALIGN_EPI) { if (wr == 0) PG8_BAR; }
        if constexpr (!Epi::AFTER_DRAIN) { E(acc, cur, wr, wc, fr, fq); S.done(cur); }
        if (!has_next) break;
#pragma unroll
        for (int a = 0; a < 2; ++a)
#pragma unroll
            for (int b = 0; b < 2; ++b)
#pragma unroll
                for (int m = 0; m < 4; ++m)
#pragma unroll
                    for (int n = 0; n < 2; ++n) acc[a][b][m][n] = (f32x4){0.f, 0.f, 0.f, 0.f};
        cur = nxt; cA = nA; cB = nB; ++ui;
        if constexpr (ALIGN_EPI) { if (wr == 1) PG8_BAR; }
    }
    PG8_WAIT_V(0);
    if constexpr (!ALIGN_EPI) { if (wr == 0) PG8_BAR; }
    PG8_BAR;
    if constexpr (Epi::AFTER_DRAIN) { E.fused(acc, cur, wr, wc, fr, fq, lds, wid, lane); S.done(cur); }
#undef PG8_SA
#undef PG8_SB
#undef PG8_STAGE
#undef PG8_LDA
#undef PG8_LDB
#undef PG8_MMA
#undef PG8_WAIT_V
#undef PG8_WAIT_L
#undef PG8_BAR
#undef PG8_SCHED
}
}
namespace att {
using bf16x8 = __attribute__((ext_vector_type(8))) short;
using s16x4  = __attribute__((ext_vector_type(4))) short;
using f32x16 = __attribute__((ext_vector_type(16))) float;
using u32x4  = __attribute__((ext_vector_type(4))) unsigned;
using u32x2  = __attribute__((ext_vector_type(2))) unsigned;
constexpr int NW = 8, QBLK = 32, KVBLK = 64;
constexpr int SHM_V = 16384, SHM_K = 16384, SHM_ATTN = 3 * SHM_V + 3 * SHM_K + NW * 64 * 4;
#define KSWZ(row, colB) ((row) * 256 + ((colB) ^ (((row) & 7) << 4)))
#define SBAR() __builtin_amdgcn_sched_barrier(0)
__device__ __forceinline__ int crow(int r, int hi) { return (r & 3) + 8 * (r >> 2) + 4 * hi; }
__device__ __forceinline__ unsigned cvtpk(float lo, float hi) { unsigned r; asm volatile("v_cvt_pk_bf16_f32 %0, %1, %2" : "=v"(r) : "v"(lo), "v"(hi)); return r; }

#define MX3(a, b, c) __builtin_fmaxf(__builtin_fmaxf((a), (b)), (c))
template <bool FIRST>
__device__ __forceinline__ void partialSM(f32x16& p0, f32x16& p1, float& m_reg, f32x16& negm, float& alpha, const float thr) {
  float a = MX3(p0[0], p0[1], p1[0]), b = MX3(p0[2], p0[3], p1[1]); a = MX3(a, p1[2], p1[3]);
#pragma unroll
  for (int r = 4; r < 16; r += 4) { a = MX3(a, p0[r], p0[r + 1]); b = MX3(b, p0[r + 2], p0[r + 3]); a = MX3(a, p1[r], p1[r + 1]); b = MX3(b, p1[r + 2], p1[r + 3]); }
  float pmax = fmaxf(a, b);
  { auto rr = __builtin_amdgcn_permlane32_swap(__float_as_uint(pmax), __float_as_uint(pmax), false, false);
    pmax = fmaxf(__uint_as_float(rr[0]), __uint_as_float(rr[1])); }
  alpha = 1.f;
  if (FIRST || !__builtin_expect(__all(pmax <= thr), 1)) {
    const float dl = FIRST ? pmax : fmaxf(pmax, 0.f);
    alpha = __builtin_amdgcn_exp2f(-dl); m_reg += dl;
#pragma unroll
    for (int r = 0; r < 16; ++r) { p0[r] -= dl; p1[r] -= dl; }
#pragma unroll
    for (int r = 0; r < 16; ++r) negm[r] = -m_reg;
  }
#pragma unroll
  for (int r = 0; r < 16; ++r) p0[r] = __builtin_amdgcn_exp2f(p0[r]);
}
__device__ __forceinline__ void finishSM(f32x16& p0, f32x16& p1, bf16x8& pa0, bf16x8& pa1, bf16x8& pa2, bf16x8& pa3) {
#pragma unroll
  for (int r = 0; r < 16; ++r) p1[r] = __builtin_amdgcn_exp2f(p1[r]);
#define PK4(P, BASE, OUT) do { unsigned a0 = cvtpk(P[BASE + 0], P[BASE + 1]), a1 = cvtpk(P[BASE + 2], P[BASE + 3]);   \
    unsigned b0 = cvtpk(P[BASE + 4], P[BASE + 5]), b1 = cvtpk(P[BASE + 6], P[BASE + 7]);                              \
    auto r0 = __builtin_amdgcn_permlane32_swap(a0, b0, false, false); auto r1 = __builtin_amdgcn_permlane32_swap(a1, b1, false, false); \
    u32x4 w = {r0[0], r1[0], r0[1], r1[1]}; OUT = *reinterpret_cast<bf16x8*>(&w); } while (0)
  PK4(p0, 0, pa0); PK4(p0, 8, pa1); PK4(p1, 0, pa2); PK4(p1, 8, pa3);
#undef PK4
}
template <int DQK>
__device__ __forceinline__ void qkt(f32x16& p0, f32x16& p1, const char* Ks, const bf16x8* qr, const f32x16& negm, int r32, int hi) {
  p0 = negm; p1 = negm;
  __builtin_amdgcn_s_setprio(1);
#pragma unroll
  for (int d0 = 0; d0 < DQK / 16; ++d0) { int cb = (d0 * 16 + hi * 8) * 2;
    bf16x8 b0 = *reinterpret_cast<const bf16x8*>(Ks + KSWZ(r32, cb));
    bf16x8 b1 = *reinterpret_cast<const bf16x8*>(Ks + KSWZ(32 + r32, cb));
    p0 = __builtin_amdgcn_mfma_f32_32x32x16_bf16(b0, qr[d0], p0, 0, 0, 0);
    p1 = __builtin_amdgcn_mfma_f32_32x32x16_bf16(b1, qr[d0], p1, 0, 0, 0); }
  __builtin_amdgcn_s_setprio(0);
}
__device__ __forceinline__ int v_st(int k, int c) { const int kk = (k & ~0xC) | ((k & 4) << 1) | ((k & 8) >> 1); return ((kk >> 3) * 4 + (c >> 5)) * 512 + ((kk & 7) * 32 + (c & 31)) * 2; }
__device__ __forceinline__ int v_rd_base(int lane) { return ((lane & 3) << 3) | (((lane >> 2) & 3) << 6) | (((lane >> 4) & 1) << 5) | (((lane >> 5) & 1) << 8); }
constexpr int v_rd_off(int d0, int ks, int half) { return d0 * 512 + ks * 4096 + half * 2048; }
template <int OFF> __device__ __forceinline__ s16x4 tr_read(int vb) {
  s16x4 r; asm volatile("ds_read_b64_tr_b16 %0, %1 offset:%2" : "=&v"(r) : "v"(vb), "i"(OFF) : "memory"); return r;
}
struct VFrag { s16x4 l[4], h[4]; };
template <int D0> __device__ __forceinline__ void v_reads(VFrag& f, int vb) {
  f.l[0] = tr_read<v_rd_off(D0, 0, 0)>(vb); f.h[0] = tr_read<v_rd_off(D0, 0, 1)>(vb); f.l[1] = tr_read<v_rd_off(D0, 1, 0)>(vb); f.h[1] = tr_read<v_rd_off(D0, 1, 1)>(vb);
  f.l[2] = tr_read<v_rd_off(D0, 2, 0)>(vb); f.h[2] = tr_read<v_rd_off(D0, 2, 1)>(vb); f.l[3] = tr_read<v_rd_off(D0, 3, 0)>(vb); f.h[3] = tr_read<v_rd_off(D0, 3, 1)>(vb);
}
__device__ __forceinline__ void pv_mma(f32x16* o, f32x16& lacc, VFrag& f, int vb, bf16x8 pa0, bf16x8 pa1, bf16x8 pa2, bf16x8 pa3) {
  const bf16x8 ones = {0x3F80, 0x3F80, 0x3F80, 0x3F80, 0x3F80, 0x3F80, 0x3F80, 0x3F80};
  asm volatile("s_waitcnt lgkmcnt(0)" ::: "memory"); SBAR();
#define PK(L, H) (bf16x8){L[0], L[1], L[2], L[3], H[0], H[1], H[2], H[3]}
  o[0] = __builtin_amdgcn_mfma_f32_32x32x16_bf16(pa0, PK(f.l[0], f.h[0]), o[0], 0, 0, 0);
  o[0] = __builtin_amdgcn_mfma_f32_32x32x16_bf16(pa1, PK(f.l[1], f.h[1]), o[0], 0, 0, 0);
  o[0] = __builtin_amdgcn_mfma_f32_32x32x16_bf16(pa2, PK(f.l[2], f.h[2]), o[0], 0, 0, 0);
  o[0] = __builtin_amdgcn_mfma_f32_32x32x16_bf16(pa3, PK(f.l[3], f.h[3]), o[0], 0, 0, 0);
  SBAR(); v_reads<1>(f, vb); SBAR();
  lacc = __builtin_amdgcn_mfma_f32_32x32x16_bf16(pa0, ones, lacc, 0, 0, 0);
  lacc = __builtin_amdgcn_mfma_f32_32x32x16_bf16(pa1, ones, lacc, 0, 0, 0);
  lacc = __builtin_amdgcn_mfma_f32_32x32x16_bf16(pa2, ones, lacc, 0, 0, 0);
  lacc = __builtin_amdgcn_mfma_f32_32x32x16_bf16(pa3, ones, lacc, 0, 0, 0);
  asm volatile("s_waitcnt lgkmcnt(0)" ::: "memory"); SBAR();
  o[1] = __builtin_amdgcn_mfma_f32_32x32x16_bf16(pa0, PK(f.l[0], f.h[0]), o[1], 0, 0, 0);
  o[1] = __builtin_amdgcn_mfma_f32_32x32x16_bf16(pa1, PK(f.l[1], f.h[1]), o[1], 0, 0, 0);
  o[1] = __builtin_amdgcn_mfma_f32_32x32x16_bf16(pa2, PK(f.l[2], f.h[2]), o[1], 0, 0, 0);
  o[1] = __builtin_amdgcn_mfma_f32_32x32x16_bf16(pa3, PK(f.l[3], f.h[3]), o[1], 0, 0, 0);
#undef PK
}
struct Unit {
  const unsigned short* Q; const unsigned short* K; const unsigned short* KR; const unsigned short* V; unsigned short* O;
  int ldq, ldk, NT, kstart, q0;
  float C, thr_raw, sinkl2;
};
__device__ __forceinline__ void wmask(f32x16& p0, f32x16& p1, int tilepos, int qpos, int hi) {
#pragma unroll
  for (int r = 0; r < 16; ++r) { const int k0 = tilepos + crow(r, hi); int d0 = qpos - k0; d0 = d0 < 0 ? -d0 : d0; int d1 = qpos - (k0 + 32); d1 = d1 < 0 ? -d1 : d1;
    if (d0 > 128) p0[r] = -1e30f; if (d1 > 128) p1[r] = -1e30f; }
}
template <int DQK, bool WINDOW>
__device__ __forceinline__ void attn_unit(const Unit& U, char* lds) {
  const int tid = opaque_tid(), wid = __builtin_amdgcn_readfirstlane(tid >> 6), lane = tid & 63, r32 = lane & 31, hi = lane >> 5;
  char* V_lds = lds; char* K_lds = lds + 3 * SHM_V;
  float* ws = (float*)(lds + 3 * SHM_V + 3 * SHM_K) + wid * 64; float* li_l = ws; float* al_l = ws + 32;
  const float thr = 11.5415603f;
  float m_reg = 0.f; f32x16 o[2] = {}; f32x16 lacc = {}; f32x16 negm = {}; bf16x8 qr[DQK / 16];
  const unsigned short* Qw = U.Q + (long)(wid * QBLK + r32) * U.ldq + hi * 8;
#pragma unroll
  for (int d0 = 0; d0 < DQK / 16; ++d0) qr[d0] = *reinterpret_cast<const bf16x8*>(Qw + d0 * 16);
  const int sr = tid >> 3, sc = (tid & 7) * 8, vst0 = v_st(sr, sc), kst0 = KSWZ(sr, sc * 2);
  const int srr = (tid >> 2) & 63, scr = (tid & 3) * 8, kst1 = KSWZ(srr, (64 + scr) * 2);
  const bool do_r = (DQK == 96) && (tid < 256);
  const int vb0 = (int)(uintptr_t)V_lds + v_rd_base(lane);
  const int ldk = U.ldk, kstart = U.kstart;
  const int qpos = U.q0 + wid * QBLK + r32; const int qlo = U.q0 + wid * QBLK;
  struct { bf16x8 vs, ks, rs; } sr_[3];
#define KROW(j) ((long)(64 * (j) + ((j) >= 4 ? kstart : 0)))
#define SLOAD(i, j) do { const long kr_ = KROW(j); sr_[i].vs = *reinterpret_cast<const bf16x8*>(U.V + (kr_ + sr) * ldk + sc); \
    sr_[i].ks = *reinterpret_cast<const bf16x8*>(U.K + (kr_ + sr) * ldk + sc); \
    if (DQK == 96) { if (do_r) sr_[i].rs = *reinterpret_cast<const bf16x8*>(U.KR + (kr_ + srr) * 32 + scr); } } while (0)
#define SWRITE(soff, i) do { *(bf16x8*)(V_lds + (soff) + vst0) = sr_[i].vs; *(bf16x8*)(K_lds + (soff) + kst0) = sr_[i].ks; \
    if (DQK == 96) { if (do_r) *(bf16x8*)(K_lds + (soff) + kst1) = sr_[i].rs; } } while (0)
#define RESC(a) do { if (__any((a) < 1.f)) { if (hi == 0) al_l[r32] = (a); asm volatile("s_waitcnt lgkmcnt(0)" ::: "memory"); \
    _Pragma("unroll") for (int r = 0; r < 16; ++r) { const float f_ = al_l[crow(r, hi)]; o[0][r] *= f_; o[1][r] *= f_; lacc[r] *= f_; } } } while (0)
#define WMASK(P0, P1, j) do { if (WINDOW) { if ((j) >= 4) wmask(P0, P1, kstart + 64 * ((j) - 4), qpos, hi); } } while (0)
#define QKM(P0, P1, KP, j, SK) do { SK = false; \
    if (WINDOW && (j) >= 4) { const int tp_ = kstart + 64 * ((j) - 4); \
      if (tp_ + 63 < qlo - 128 || tp_ > qlo + 31 + 128) { SK = true; _Pragma("unroll") for (int r_ = 0; r_ < 16; ++r_) { P0[r_] = 0.f; P1[r_] = 0.f; } } \
      else { qkt<DQK>(P0, P1, KP, qr, negm, r32, hi); if (!(tp_ >= qlo + 31 - 128 && tp_ + 63 <= qlo + 128)) wmask(P0, P1, tp_, qpos, hi); } } \
    else qkt<DQK>(P0, P1, KP, qr, negm, r32, hi); } while (0)
#define LIVE(SK) (!(WINDOW && (SK)))
#define ROT() do { const int t_ = s_prev; s_prev = s_cur; s_cur = s_next; s_next = t_; } while (0)
  static_assert(SHM_V == SHM_K, "one slot offset serves both rings");
  f32x16 pA0, pA1, pB0, pB1; float alA, alB; bool skA = false, skB = false; bf16x8 pa0, pa1, pa2, pa3; const int NT = U.NT; VFrag vf;
  int s_prev = 2 * SHM_V, s_cur = 0, s_next = SHM_V;
  SLOAD(1, 0); SLOAD(2, 1); if (2 < NT) SLOAD(0, 2);
  SWRITE(0, 1); SWRITE(SHM_V, 2);
  __syncthreads();
  qkt<DQK>(pA0, pA1, K_lds, qr, negm, r32, hi); partialSM<true>(pA0, pA1, m_reg, negm, alA, thr);
  ROT();
  for (int j = 1; j + 1 < NT; j += 2) {
    SWRITE(s_next, 0); if (j + 2 < NT) SLOAD(0, j + 2);
    SBAR(); QKM(pB0, pB1, K_lds + s_cur, j, skB);
    if (LIVE(skA)) { v_reads<0>(vf, vb0 + s_prev); finishSM(pA0, pA1, pa0, pa1, pa2, pa3); pv_mma(o, lacc, vf, vb0 + s_prev, pa0, pa1, pa2, pa3); }
    if (LIVE(skB)) partialSM<false>(pB0, pB1, m_reg, negm, alB, thr); else alB = 1.f;
    __syncthreads(); RESC(alB); ROT();
    if (j + 2 < NT) SWRITE(s_next, 0); if (j + 3 < NT) SLOAD(0, j + 3);
    SBAR(); QKM(pA0, pA1, K_lds + s_cur, j + 1, skA);
    if (LIVE(skB)) { v_reads<0>(vf, vb0 + s_prev); finishSM(pB0, pB1, pa0, pa1, pa2, pa3); pv_mma(o, lacc, vf, vb0 + s_prev, pa0, pa1, pa2, pa3); }
    if (LIVE(skA)) partialSM<false>(pA0, pA1, m_reg, negm, alA, thr); else alA = 1.f;
    __syncthreads(); RESC(alA); ROT();
  }
  SBAR(); QKM(pB0, pB1, K_lds + s_cur, NT - 1, skB);
  if (LIVE(skA)) { v_reads<0>(vf, vb0 + s_prev); finishSM(pA0, pA1, pa0, pa1, pa2, pa3); pv_mma(o, lacc, vf, vb0 + s_prev, pa0, pa1, pa2, pa3); }
  if (LIVE(skB)) {
    partialSM<false>(pB0, pB1, m_reg, negm, alB, thr);
    RESC(alB);
    SBAR(); v_reads<0>(vf, vb0 + s_cur); SBAR();
    finishSM(pB0, pB1, pa0, pa1, pa2, pa3);
    pv_mma(o, lacc, vf, vb0 + s_cur, pa0, pa1, pa2, pa3);
  }
  if (hi == 0) li_l[r32] = __builtin_amdgcn_exp2f(fmaxf(U.sinkl2 - m_reg, -126.f));
  asm volatile("s_waitcnt lgkmcnt(0)" ::: "memory");
  float rli[16];
#pragma unroll
  for (int r = 0; r < 16; ++r) rli[r] = __builtin_amdgcn_rcpf(lacc[r] + li_l[crow(r, hi)]);
  unsigned short* Ow = U.O + (long)(wid * QBLK) * 1024;
#pragma unroll
  for (int r = 0; r < 16; ++r) { const int orow = crow(r, hi);
#pragma unroll
    for (int d0 = 0; d0 < 2; ++d0) { const float lo = o[d0][r] * rli[r]; const unsigned pk = cvtpk(lo, lo); Ow[(long)orow * 1024 + d0 * 32 + r32] = (unsigned short)(pk & 0xffffu); } }
  __syncthreads();
#undef KROW
#undef SLOAD
#undef SWRITE
#undef RESC
#undef WMASK
#undef QKM
#undef LIVE
#undef ROT
}
#undef SBAR
}
constexpr int DM = 1024, NP_ROWS = 4096, NS_ROWS = 16384, M_ROWS = 20480, EXT_ROWS = 21504, EXT_B = 4352, DFF = 4096;
constexpr float EPS_ = 1e-6f;
constexpr float LOG2_THETA = 13.287712379549449f;
constexpr float INV_2PI = 0.15915494309189535f;
typedef unsigned short bfu;
typedef float f32x4 __attribute__((ext_vector_type(4)));
typedef unsigned u32x4 __attribute__((ext_vector_type(4)));
typedef unsigned u32x2 __attribute__((ext_vector_type(2)));
__device__ __forceinline__ unsigned pkbf(float lo, float hi) { return pg8::cvt_pk_bf16(lo, hi); }
__device__ __forceinline__ void rope_cs(int pos, int i, float inv_den, float& c, float& s) {
    const float f = __builtin_amdgcn_exp2f(-(float)i * (LOG2_THETA * inv_den));
    const float rev = (float)pos * f * INV_2PI;
    c = __builtin_amdgcn_cosf(rev); s = __builtin_amdgcn_sinf(rev);
}
__device__ __forceinline__ int cond_of_row(int row) { return row < NP_ROWS ? 4 : ((row - NP_ROWS) >> 12); }
__device__ __forceinline__ int ext_of_row(int row) { return row < NP_ROWS ? row : (NP_ROWS + ((row - NP_ROWS) >> 12) * EXT_B + 256 + ((row - NP_ROWS) & 4095)); }

#define EPI_FENCE() asm volatile("" ::: "memory")
template <bool NORMC> struct EpiQKV {
    static constexpr bool PERM = false, AFTER_DRAIN = false;
    bfu* Q; bfu* Kb; bfu* Vb; float* stK; float* stV; const float* gq; const float* gk; int nstate;
    __device__ __forceinline__ void operator()(const f32x4 (&acc)[2][2][4][2], const pg8::Unit& u, int wr, int wc, int fr, int fq) const {
        asm volatile("" : "+v"(fr), "+v"(fq));
        const int pn = u.pn; const bool isQ = pn < 4, isK = pn == 4; const bool sample = u.pm >= 16;
        const bool dorope = sample && pn < 5;
        float frq[4];
#pragma unroll
        for (int j = 0; j < 4; ++j) frq[j] = __builtin_amdgcn_exp2f(-(float)(4 * fq + j) * (LOG2_THETA / 16.0f)) * INV_2PI;
        const unsigned cq = 64 * wc + 4 * fq;
#pragma unroll
        for (int ai = 0; ai < 2; ++ai)
#pragma unroll
            for (int m = 0; m < 4; ++m) {
                unsigned row = u.pm * 256 + ai * 128 + wr * 64 + m * 16 + fr; asm volatile("" : "+v"(row));
                f32x4 v[2][2];
#pragma unroll
                for (int bj = 0; bj < 2; ++bj)
#pragma unroll
                    for (int n = 0; n < 2; ++n) v[bj][n] = acc[ai][bj][m][n];
                if (NORMC && pn < 5) {
                    float ss = 0.f;
#pragma unroll
                    for (int bj = 0; bj < 2; ++bj)
#pragma unroll
                        for (int n = 0; n < 2; ++n) ss += (v[bj][n][0] * v[bj][n][0] + v[bj][n][1] * v[bj][n][1]) + (v[bj][n][2] * v[bj][n][2] + v[bj][n][3] * v[bj][n][3]);
                    ss += __shfl_xor(ss, 16); ss += __shfl_xor(ss, 32);
                    const float rstd = 1.0f / sqrtf(ss * (1.0f / 64.0f) + EPS_);
                    const float* g = (isQ ? gq : gk) + 4 * fq;
#pragma unroll
                    for (int bj = 0; bj < 2; ++bj)
#pragma unroll
                        for (int n = 0; n < 2; ++n) { const f32x4 gv = *(const f32x4*)(g + 32 * bj + 16 * n); v[bj][n] = v[bj][n] * rstd * gv; }
                }
                const unsigned t = (row - NP_ROWS) & 4095u;
                if (dorope) {
#pragma unroll
                    for (int bj = 0; bj < 2; ++bj) { const float pos = (float)(bj == 0 ? (t >> 6) : (t & 63u));
#pragma unroll
                        for (int j = 0; j < 4; ++j) { const float rev = pos * frq[j]; const float c = __builtin_amdgcn_cosf(rev), s = __builtin_amdgcn_sinf(rev); const float x1 = v[bj][0][j], x2 = v[bj][1][j];
                            v[bj][0][j] = x1 * c - x2 * s; v[bj][1][j] = x1 * s + x2 * c; } }
                }
                if (isQ) { bfu* p = Q + (row * 1024u + 256u * pn + cq);
#pragma unroll
                    for (int bj = 0; bj < 2; ++bj)
#pragma unroll
                        for (int n = 0; n < 2; ++n) { const f32x4 x = v[bj][n] * (0.125f * 1.4426950408889634f);     u32x2 w; w.x = pkbf(x[0], x[1]); w.y = pkbf(x[2], x[3]); *(u32x2*)(p + 32 * bj + 16 * n) = w; }
                } else {
                    const unsigned e = sample ? (NP_ROWS + ((row - NP_ROWS) >> 12) * EXT_B + 256u + t) : row;
                    bfu* p = (isK ? Kb : Vb) + (e * 256u + cq);
#pragma unroll
                    for (int bj = 0; bj < 2; ++bj)
#pragma unroll
                        for (int n = 0; n < 2; ++n) { const f32x4 x = v[bj][n]; u32x2 w; w.x = pkbf(x[0], x[1]); w.y = pkbf(x[2], x[3]); *(u32x2*)(p + 32 * bj + 16 * n) = w; }
                    if (!sample) { float* st = (isK ? stK : stV) + ((((row >> 8) * nstate) * 256u + (row & 255u)) * 256u + cq);
#pragma unroll
                        for (int bj = 0; bj < 2; ++bj)
#pragma unroll
                            for (int n = 0; n < 2; ++n) *(f32x4*)(st + 32 * bj + 16 * n) = v[bj][n]; }
                }
                EPI_FENCE();
            }
    }
};
struct EpiResid {
    static constexpr bool PERM = true, AFTER_DRAIN = false;
    float* x; const float* gate; bfu* P; const float* xin;
    __device__ __forceinline__ void operator()(const f32x4 (&acc)[2][2][4][2], const pg8::Unit& u, int wr, int wc, int fr, int fq) const {
        asm volatile("" : "+v"(fr), "+v"(fq));
        const int cond = cond_of_row(u.pm * 256); const unsigned c0 = u.pn * 256 + wc * 32 + 8 * fq; const float* g = gate + cond * 6144 + c0;
#pragma unroll
        for (int ai = 0; ai < 2; ++ai)
#pragma unroll
            for (int m = 0; m < 4; ++m) { const unsigned row = u.pm * 256 + ai * 128 + wr * 64 + m * 16 + fr; const unsigned off = row * 1024u + c0;
#pragma unroll
                for (int bj = 0; bj < 2; ++bj) { const f32x4 g0 = *(const f32x4*)(g + bj * 128), g1 = *(const f32x4*)(g + bj * 128 + 4);
                    const f32x4 y0 = g0 * acc[ai][bj][m][0], y1 = g1 * acc[ai][bj][m][1]; const unsigned o2 = off + bj * 128;
                    if (u.split) { u32x4 w; w.x = pkbf(y0[0], y0[1]); w.y = pkbf(y0[2], y0[3]); w.z = pkbf(y1[0], y1[1]); w.w = pkbf(y1[2], y1[3]); *(u32x4*)(P + ((size_t)(u.split - 1) * 4096 * 1024 + o2)) = w; }
                    else { const f32x4 b0 = *(const f32x4*)(xin + o2), b1 = *(const f32x4*)(xin + o2 + 4); *(f32x4*)(x + o2) = b0 + y0; *(f32x4*)(x + o2 + 4) = b1 + y1; } }
                EPI_FENCE(); }
    }
};
struct EpiSqRelu {
    static constexpr bool PERM = true, AFTER_DRAIN = false;
    bfu* O; int ldc;
    __device__ __forceinline__ void operator()(const f32x4 (&acc)[2][2][4][2], const pg8::Unit& u, int wr, int wc, int fr, int fq) const {
        asm volatile("" : "+v"(fr), "+v"(fq));
#pragma unroll
        for (int ai = 0; ai < 2; ++ai)
#pragma unroll
            for (int m = 0; m < 4; ++m) { const unsigned row = u.pm * 256 + ai * 128 + wr * 64 + m * 16 + fr; bfu* p = O + ((size_t)row * ldc + u.pn * 256 + wc * 32 + 8 * fq);
#pragma unroll
                for (int bj = 0; bj < 2; ++bj) { f32x4 v0 = acc[ai][bj][m][0], v1 = acc[ai][bj][m][1];
#pragma unroll
                    for (int j = 0; j < 4; ++j) { const float a = fmaxf(v0[j], 0.f), b = fmaxf(v1[j], 0.f); v0[j] = a * a; v1[j] = b * b; }
                    u32x4 w; w.x = pkbf(v0[0], v0[1]); w.y = pkbf(v0[2], v0[3]); w.z = pkbf(v1[0], v1[1]); w.w = pkbf(v1[2], v1[3]);
                    *(u32x4*)(p + bj * 128) = w; }
                EPI_FENCE(); }
    }
};
struct EpiUKV {
    static constexpr bool PERM = true, AFTER_DRAIN = false;
    bfu* Kn; bfu* Vb;
    __device__ __forceinline__ void operator()(const f32x4 (&acc)[2][2][4][2], const pg8::Unit& u, int wr, int wc, int fr, int fq) const {
        asm volatile("" : "+v"(fr), "+v"(fq));
        bfu* base = (wc < 2 ? Kn : Vb) + (2 * u.pn * 64 + 32 * (wc & 1) + 8 * fq);
#pragma unroll
        for (int ai = 0; ai < 2; ++ai)
#pragma unroll
            for (int m = 0; m < 4; ++m) { const unsigned row = u.pm * 256 + ai * 128 + wr * 64 + m * 16 + fr; bfu* p = base + row * 1024u;
#pragma unroll
                for (int bj = 0; bj < 2; ++bj) { const f32x4 v0 = acc[ai][bj][m][0], v1 = acc[ai][bj][m][1];
                    u32x4 w; w.x = pkbf(v0[0], v0[1]); w.y = pkbf(v0[2], v0[3]); w.z = pkbf(v1[0], v1[1]); w.w = pkbf(v1[2], v1[3]);
                    *(u32x4*)(p + bj * 64) = w; }
                EPI_FENCE(); }
    }
};
struct EpiF32 {
    static constexpr bool PERM = true, AFTER_DRAIN = false;
    bfu* T; int ldc;
    __device__ __forceinline__ void operator()(const f32x4 (&acc)[2][2][4][2], const pg8::Unit& u, int wr, int wc, int fr, int fq) const {
        asm volatile("" : "+v"(fr), "+v"(fq));
#pragma unroll
        for (int ai = 0; ai < 2; ++ai)
#pragma unroll
            for (int m = 0; m < 4; ++m) { const unsigned row = u.pm * 256 + ai * 128 + wr * 64 + m * 16 + fr; bfu* p = T + ((size_t)row * ldc + u.pn * 256 + wc * 32 + 8 * fq);
#pragma unroll
                for (int bj = 0; bj < 2; ++bj) { const f32x4 v0 = acc[ai][bj][m][0], v1 = acc[ai][bj][m][1];
                    u32x4 w; w.x = pkbf(v0[0], v0[1]); w.y = pkbf(v0[2], v0[3]); w.z = pkbf(v1[0], v1[1]); w.w = pkbf(v1[2], v1[3]); *(u32x4*)(p + bj * 128) = w; }
                EPI_FENCE(); }
    }
};
struct EpiUQ {
    static constexpr bool PERM = false, AFTER_DRAIN = false;
    bfu* Q;
    __device__ __forceinline__ void operator()(const f32x4 (&acc)[2][2][4][2], const pg8::Unit& u, int wr, int wc, int fr, int fq) const {
        asm volatile("" : "+v"(fr), "+v"(fq));
        const bool sample = u.pm >= 16;
        float frq[4];
#pragma unroll
        for (int j = 0; j < 4; ++j) frq[j] = __builtin_amdgcn_exp2f(-(float)(4 * (fq & 1) + j) * (LOG2_THETA / 8.0f)) * INV_2PI;
        const bool lowhalf = fq < 2;
#pragma unroll
        for (int ai = 0; ai < 2; ++ai)
#pragma unroll
            for (int m = 0; m < 4; ++m) { unsigned row = u.pm * 256 + ai * 128 + wr * 64 + m * 16 + fr; asm volatile("" : "+v"(row)); const unsigned t = (row - NP_ROWS) & 4095u;
                bfu* p = Q + (row * 1536u + u.pn * 256 + wc * 32 + 4 * fq);
#pragma unroll
                for (int bj = 0; bj < 2; ++bj) {
                    const int g32 = (u.pn * 256 + bj * 128 + wc * 32) >> 5; const bool ropeg = (g32 % 3) == 2;
#pragma unroll
                    for (int n = 0; n < 2; ++n) { f32x4 v = acc[ai][bj][m][n];
                        if (sample && ropeg) { const float pos = (float)(n == 0 ? (t >> 6) : (t & 63u));
#pragma unroll
                            for (int j = 0; j < 4; ++j) { const float other = __shfl_xor(v[j], 32); const float rev = pos * frq[j]; const float c = __builtin_amdgcn_cosf(rev), s = __builtin_amdgcn_sinf(rev);
                                v[j] = lowhalf ? (v[j] * c - other * s) : (other * s + v[j] * c); } }
                        v = v * (0.10206207261596577f * 1.4426950408889634f);
                        u32x2 w; w.x = pkbf(v[0], v[1]); w.y = pkbf(v[2], v[3]);
                        *(u32x2*)(p + bj * 128 + n * 16) = w; } }
                EPI_FENCE(); }
    }
};
#define XB_TMO      128
#define XB_XCNT(j)  (256  + 64 * (j))
#define XB_XSUB(j)  (1280 + 64 * (j))
#define XB_XGEN(j)  (2304 + 64 * (j))
#define XB_TOP      3328
#define XB_TOPGEN   3392
#define XCD_BAR_WORDS 3456
#define XB_SPIN_CAP (1u << 18)

__device__ __forceinline__ unsigned xb_ld(unsigned* p)              { return __hip_atomic_load(p, __ATOMIC_RELAXED, __HIP_MEMORY_SCOPE_AGENT); }
__device__ __forceinline__ unsigned xb_add(unsigned* p, unsigned v) { return __hip_atomic_fetch_add(p, v, __ATOMIC_RELAXED, __HIP_MEMORY_SCOPE_AGENT); }
__device__ __forceinline__ unsigned xb_xcc_id() { return (unsigned)__builtin_amdgcn_s_getreg((3 << 11) | 20) & 0xFu; }
#define XB_SPIN(cond, bar) do { unsigned _sp = 0; while (cond) { __builtin_amdgcn_s_sleep(1); \
    if ((++_sp & 255u) == 0u) { if (xb_ld(&(bar)[XB_TMO])) break; if (_sp > XB_SPIN_CAP) { atomicAdd(&(bar)[XB_TMO], 1u); break; } } } } while (0)

struct XcdBarrier {
    unsigned* bar; unsigned x;
    volatile LAS unsigned* st;
};

__device__ __forceinline__ XcdBarrier xcd_barrier_post(unsigned* bar, volatile LAS unsigned* st) {
    XcdBarrier b; b.bar = bar; b.x = xb_xcc_id(); b.st = st;
    if (threadIdx.x == 0) (void)xb_add(&bar[XB_XCNT(b.x)], 1u);
    return b;
}
__device__ __forceinline__ void xcd_barrier_complete(unsigned* bar, unsigned x, unsigned& nloc, unsigned& nx) {
    const unsigned G = gridDim.x * gridDim.y * gridDim.z;
    unsigned sum, cnt, mine, sp = 0u;
    for (;;) {
        sum = 0u; cnt = 0u; mine = 0u;
#pragma unroll
        for (unsigned j = 0; j < 16; ++j) { const unsigned c = xb_ld(&bar[XB_XCNT(j)]); sum += c; cnt += (c > 0u) ? 1u : 0u; mine = (j == x) ? c : mine; }
        if (sum == G) break;
        __builtin_amdgcn_s_sleep(1);
        if ((++sp & 255u) == 0u) { if (xb_ld(&bar[XB_TMO])) break; if (sp > XB_SPIN_CAP) { atomicAdd(&bar[XB_TMO], 1u); break; } }
    }
    nloc = mine > 0u ? mine : 1u; nx = cnt > 0u ? cnt : 1u;
}

__device__ __forceinline__ void xcd_barrier(const XcdBarrier& b) {
    asm volatile("s_waitcnt vmcnt(0)" ::: "memory");
    __syncthreads();
    if (threadIdx.x == 0) {
        unsigned* bar = b.bar;
        __builtin_amdgcn_s_waitcnt(0);
        unsigned nloc = b.st[0], nx = b.st[1];
        if (nloc == 0u) { xcd_barrier_complete(bar, b.x, nloc, nx); b.st[0] = nloc; b.st[1] = nx; }
        const unsigned old = xb_add(&bar[XB_XSUB(b.x)], 1u);
        const unsigned gen = old / nloc;
        if (old + 1u == (gen + 1u) * nloc) {
            __builtin_amdgcn_fence(__ATOMIC_RELEASE, "agent");
            asm volatile("s_waitcnt vmcnt(0)" ::: "memory");
            const unsigned og = xb_add(&bar[XB_TOP], 1u);
            const unsigned tg = og / nx;
            if (og + 1u == (tg + 1u) * nx) xb_add(&bar[XB_TOPGEN], 1u);
            else XB_SPIN(xb_ld(&bar[XB_TOPGEN]) == tg, bar);
            __builtin_amdgcn_fence(__ATOMIC_ACQUIRE, "agent");
            xb_add(&bar[XB_XGEN(b.x)], 1u);
            asm volatile("s_waitcnt vmcnt(0)" ::: "memory");
        } else {
            XB_SPIN(xb_ld(&bar[XB_XGEN(b.x)]) == gen, bar);
            __builtin_amdgcn_fence(__ATOMIC_ACQUIRE, "agent");
            asm volatile("s_waitcnt vmcnt(0)" ::: "memory");
        }
    }
    __syncthreads();
}

constexpr size_t MiB = 1u << 20;
constexpr size_t WT_MLP_IN = 0;
constexpr size_t WT_MLP_OUT = 4 * (size_t)DM * DFF;
constexpr size_t WT_A_QKV = 8 * (size_t)DM * DFF;
constexpr size_t WT_A_O = WT_A_QKV + 2 * 1536 * 1024;
constexpr size_t WT_C_QKV = WT_A_O + 2 * 1024 * 1024;
constexpr size_t WT_C_O = WT_C_QKV + 1536 * 1024;
constexpr size_t WT_B_DQKV = WT_C_O + 1024 * 1024;
constexpr size_t WT_B_UQ = WT_B_DQKV + 768 * 1024;
constexpr size_t WT_B_UKV = WT_B_UQ + 1536 * 384;
constexpr size_t WT_B_O = WT_B_UKV + 2048 * 256;
constexpr size_t WT_END = WT_B_O + 1024 * 1024;
static_assert(WT_END * 2 <= 88 * MiB, "WT region");
constexpr size_t WS_WT = 0, WS_MODS = 88 * MiB, WS_KR = 89 * MiB, WS_CKVN = 91 * MiB, WS_DQN = 102 * MiB, WS_H = 117 * MiB, WS_R1 = 157 * MiB;
constexpr size_t WS_Q = WS_R1, WS_K = WS_R1 + 60 * MiB, WS_V = WS_K + 42 * MiB, WS_T = WS_R1, WS_HID = WS_R1, WS_CTL = WS_R1 + 160 * MiB, WS_P = WS_CTL + 1 * MiB, WS_END = WS_P + 64 * MiB;

#define GAS1 __attribute__((address_space(1)))
struct Args { const GAS1 float* in[30]; GAS1 float* out; GAS1 unsigned char* ws; int ph_lo, ph_hi; };
struct ArgsH { const float* in[30]; float* out; unsigned char* ws; int ph_lo, ph_hi; };
static_assert(sizeof(Args) == sizeof(ArgsH), "Args layout");

__device__ __forceinline__ float wave_sum(float v) {
#pragma unroll
    for (int o = 1; o < 64; o <<= 1) v += __shfl_xor(v, o);
    return v;
}
template <int MAP>
__device__ __forceinline__ void transpose_item(const float* W, int K, int N, bfu* WT, int row_off, LAS float* scr, int item, int lane) {
    const int nblk = N / 32, kb = item / nblk, nb = item % nblk, k0 = 64 * kb, n0 = 32 * nb;
    { f32x4 tv[8];
#pragma unroll
      for (int i = 0; i < 8; ++i) { const int kk = 8 * i + (lane >> 3); tv[i] = *(const f32x4*)(W + (size_t)(k0 + kk) * N + n0 + (lane & 7) * 4); }
#pragma unroll
      for (int i = 0; i < 8; ++i) { const int kk = 8 * i + (lane >> 3); LAS float* d = scr + kk * 33 + (lane & 7) * 4; d[0] = tv[i][0]; d[1] = tv[i][1]; d[2] = tv[i][2]; d[3] = tv[i][3]; } }
    asm volatile("s_waitcnt lgkmcnt(0)" ::: "memory");
    const int c = lane & 7;
#pragma unroll
    for (int j = 0; j < 4; ++j) { const int n = (lane >> 3) + 8 * j; const LAS float* s = scr + (8 * c) * 33 + n;
        u32x4 o; o.x = pkbf(s[0 * 33], s[1 * 33]); o.y = pkbf(s[2 * 33], s[3 * 33]); o.z = pkbf(s[4 * 33], s[5 * 33]); o.w = pkbf(s[6 * 33], s[7 * 33]);
        int src = n0 + n, dst;
        if (MAP == 1) { const int tile = src >> 8, loc = src & 255, hl = loc >> 6, d = loc & 63; dst = tile * 256 + (d >> 5) * 128 + hl * 32 + (d & 31); } else dst = row_off + src;
        *(u32x4*)(WT + (size_t)dst * K + k0 + 8 * c) = o; }
    asm volatile("s_waitcnt lgkmcnt(0)" ::: "memory");
}
__device__ __forceinline__ void norm_row(const float* xin, float* xrow, const bfu* prow, const float* g, const float* shift, const float* scale, bfu* orow, int lane) {
    f32x4 v[4]; float s = 0.f;
#pragma unroll
    for (int j = 0; j < 4; ++j) { v[j] = *((const f32x4*)xin + lane + 64 * j);
        if (prow) { const u32x2* pp = (const u32x2*)prow + lane + 64 * j;
#pragma unroll
            for (int q = 0; q < 4; ++q) { const u32x2 w = pp[(size_t)q * 1048576]; v[j][0] += __uint_as_float(w.x << 16); v[j][1] += __uint_as_float(w.x & 0xffff0000u); v[j][2] += __uint_as_float(w.y << 16); v[j][3] += __uint_as_float(w.y & 0xffff0000u); }
            *((f32x4*)xrow + lane + 64 * j) = v[j]; } s += (v[j][0] * v[j][0] + v[j][1] * v[j][1]) + (v[j][2] * v[j][2] + v[j][3] * v[j][3]); }
    const float rstd = 1.0f / sqrtf(wave_sum(s) * (1.0f / 1024.0f) + EPS_);
#pragma unroll
    for (int j = 0; j < 4; ++j) { const int c = 4 * lane + 256 * j; const f32x4 gv = *(const f32x4*)(g + c), sh = *(const f32x4*)(shift + c), sc = *(const f32x4*)(scale + c);
        const f32x4 y = v[j] * rstd * gv * (sc + 1.0f) + sh; u32x2 w; w.x = pkbf(y[0], y[1]); w.y = pkbf(y[2], y[3]); *((u32x2*)orow + lane + 64 * j) = w; }
}
__device__ __forceinline__ void cvt_rows(const float* src, size_t src_stride, bfu* dst, size_t dst_stride, int nrows, int ncols, int gtid, int gthreads) {
    const int cpr = ncols / 8;
    for (long i = gtid; i < (long)nrows * cpr; i += gthreads) { const int r = (int)(i / cpr), c = (int)(i % cpr) * 8;
        const f32x4 a = *(const f32x4*)(src + (size_t)r * src_stride + c), b = *(const f32x4*)(src + (size_t)r * src_stride + c + 4);
        u32x4 w; w.x = pkbf(a[0], a[1]); w.y = pkbf(a[2], a[3]); w.z = pkbf(b[0], b[1]); w.w = pkbf(b[2], b[3]); *(u32x4*)(dst + (size_t)r * dst_stride + c) = w; }
}

#ifndef G_ALIGN
#define G_ALIGN true
#endif
#ifndef G_SP2
#define G_SP2 true
#endif
#ifndef QKV_SP2
#define QKV_SP2 true
#endif
struct LdsOrder {
    const LAS int* ul;
    __device__ __forceinline__ bool next(int i, pg8::Unit& u) const {
        if (i >= 16) return false;
        const LAS int* p = ul + i * 8;
        const int ok = __builtin_amdgcn_readfirstlane(p[0]); if (!ok) return false;
        u.pm = __builtin_amdgcn_readfirstlane(p[1]); u.pn = __builtin_amdgcn_readfirstlane(p[2]); u.kt0 = __builtin_amdgcn_readfirstlane(p[3]);
        u.nt = __builtin_amdgcn_readfirstlane(p[4]); u.split = __builtin_amdgcn_readfirstlane(p[5]); return true;
    }
    __device__ __forceinline__ void a_ready(const pg8::Unit&) const {}
    __device__ __forceinline__ void done(const pg8::Unit&) const {}
};
constexpr int LDS_UNITS = 131072;
template <class Epi, bool SP2 = G_SP2, bool SPLIT = false>
__device__ __forceinline__ void run_gemm(LAS unsigned char* lds, const bfu* A, const bfu* Bt, int M, int N, int K, const Epi& E) {
    int Kv = K; asm volatile("" : "+s"(Kv));
    LAS int* ul = (LAS int*)(lds + LDS_UNITS);
    { const int t = opaque_tid();
      if (t < 16) { int G_ = gridDim.x, bx_ = blockIdx.x; pg8::StaticOrder S; S.init(M, N, G_, bx_, Kv / 64, SPLIT); const pg8::Unit u = S.get(t);
          ul[t * 8 + 0] = u.nt > 0 ? 1 : 0; ul[t * 8 + 1] = u.pm; ul[t * 8 + 2] = u.pn; ul[t * 8 + 3] = u.kt0; ul[t * 8 + 4] = u.nt; ul[t * 8 + 5] = u.split; }
      __syncthreads(); }
    pg8::Gemm g{A, Bt, M, N, Kv}; LdsOrder S{ul};
    pg8::gemm_phase<Epi, LdsOrder, G_ALIGN, SP2>(lds, g, S, E);
    __syncthreads();
}

constexpr int LDS_BYTES = 147456, LDS_MISC = 147456 - 64;
constexpr int N_PHASES = 32;
#ifndef REP_ATT
#define REP_ATT 1
#endif
#ifndef REP_UP
#define REP_UP 1
#endif
#ifndef REP_RES
#define REP_RES 1
#endif
#ifndef REP_NORM
#define REP_NORM 1
#endif
#ifndef REP_P0
#define REP_P0 1
#endif
#ifndef PH_MASK
#define PH_MASK 0xffff
#endif
#define EN(k) (((PH_MASK) >> (k)) & 1)

typedef const __attribute__((address_space(4))) Args* KArgsP;
__device__ __forceinline__ KArgsP ka() { KArgsP p = (KArgsP)__builtin_amdgcn_kernarg_segment_ptr(); asm volatile("" : "+s"(p)); return p; }
__global__ void __launch_bounds__(512, 2) mega_fwd(Args args) {
    extern __shared__ __attribute__((aligned(16))) unsigned char lds[];
    cg::grid_group grid = cg::this_grid();
    const int lo = args.ph_lo, hi = args.ph_hi; int ph = 0;
    XcdBarrier xbar; xbar.bar = nullptr; xbar.x = 0; xbar.st = nullptr;
    if (hi - lo > 1) {
        volatile LAS unsigned* misc = (volatile LAS unsigned*)((LAS unsigned char*)lds + LDS_MISC);
        if (threadIdx.x < 16) misc[threadIdx.x] = 0u;
        __syncthreads();
        xbar = xcd_barrier_post((unsigned*)((unsigned char*)args.ws + WS_CTL), misc + 8);
    }
#define INP(i) ((const float*)A->in[i])
#define PHASE_LOCALS KArgsP A = ka(); const int tid = opaque_tid(), lane = tid & 63, wave = __builtin_amdgcn_readfirstlane(tid >> 6); \
    int G = gridDim.x, bx = blockIdx.x; asm volatile("" : "+s"(G), "+s"(bx)); const int vcu = (G % 8 == 0) ? (bx % 8) * (G / 8) + bx / 8 : bx; \
    const int gw = bx * 8 + wave, NGW = G * 8, gtid = bx * 512 + tid, GT = G * 512; (void)lane; (void)vcu; (void)gw; (void)NGW; (void)gtid; (void)GT; \
    LAS unsigned char* const ldsl = (LAS unsigned char*)lds; (void)ldsl; unsigned char* const ws = (unsigned char*)A->ws; float* const X = (float*)A->out; \
    bfu* const WT = (bfu*)(ws + WS_WT); float* const mods = (float*)(ws + WS_MODS); bfu* const KR = (bfu*)(ws + WS_KR); bfu* const CKVN = (bfu*)(ws + WS_CKVN); bfu* const DQN = (bfu*)(ws + WS_DQN); \
    bfu* const HB = (bfu*)(ws + WS_H); bfu* const QB = (bfu*)(ws + WS_Q); bfu* const KB = (bfu*)(ws + WS_K); bfu* const VB = (bfu*)(ws + WS_V); float* const TB = (float*)(ws + WS_T); bfu* const HID = (bfu*)(ws + WS_HID); \
    float* const st_a_k = X + 20971520; float* const st_a_v = X + 23068672; float* const st_b_ckv = X + 25165824; float* const st_b_kr = X + 26214400; float* const st_c_k = X + 26345472; float* const st_c_v = X + 27394048; \
    const float* const modl = mods + (size_t)layer * 5 * 6144; const float* const ng = INP(12) + (size_t)layer * 2 * 1024; \
    (void)WT; (void)KR; (void)CKVN; (void)DQN; (void)HB; (void)QB; (void)KB; (void)VB; (void)TB; (void)HID; (void)st_a_k; (void)st_a_v; (void)st_b_ckv; (void)st_b_kr; (void)st_c_k; (void)st_c_v; (void)modl; (void)ng;
#define PH_BEGIN if (ph >= lo && ph < hi) { PHASE_LOCALS
#ifndef REP_SYNC
#define REP_SYNC 1
#endif
#define PH_END if (ph + 1 < hi) { for (int rs_ = 0; rs_ < REP_SYNC; ++rs_) { if (ph == 0) grid.sync(); else xcd_barrier(xbar); } } } ++ph;

    { const int layer = 0;
    PH_BEGIN
    if constexpr (EN(0)) for (int rep_ = 0; rep_ < REP_P0; ++rep_) {
        if (rep_) __syncthreads();
        LAS float* scr = (LAS float*)(ldsl + wave * 16384);
        for (int seg = 0; seg < 20; ++seg) {
            const float* W; int K, N, map = 0, roff = 0; size_t dsto;
            if (seg < 4)       { W = INP(13) + (size_t)seg * DM * DFF; K = DM; N = DFF; dsto = WT_MLP_IN + (size_t)seg * DM * DFF; }
            else if (seg < 8)  { W = INP(14) + (size_t)(seg - 4) * DM * DFF; K = DFF; N = DM; dsto = WT_MLP_OUT + (size_t)(seg - 4) * DM * DFF; }
            else if (seg < 10) { W = INP(15) + (size_t)(seg - 8) * 1024 * 1536; K = 1024; N = 1536; dsto = WT_A_QKV + (size_t)(seg - 8) * 1536 * 1024; map = 1; }
            else if (seg < 12) { W = INP(17) + (size_t)(seg - 10) * 1024 * 1024; K = 1024; N = 1024; dsto = WT_A_O + (size_t)(seg - 10) * 1024 * 1024; }
            else if (seg == 12) { W = INP(25); K = 1024; N = 1536; dsto = WT_C_QKV; map = 1; }
            else if (seg == 13) { W = INP(28); K = 1024; N = 1024; dsto = WT_C_O; }
            else if (seg == 14) { W = INP(18); K = 1024; N = 384; dsto = WT_B_DQKV; }
            else if (seg == 15) { W = INP(21); K = 1024; N = 288; dsto = WT_B_DQKV; roff = 384; }
            else if (seg == 16) { W = INP(20); K = 384; N = 1536; dsto = WT_B_UQ; }
            else if (seg == 17) { W = INP(23); K = 256; N = 2048; dsto = WT_B_UKV; }
            else if (seg == 18) { W = INP(24); K = 1024; N = 1024; dsto = WT_B_O; }
            else break;
            const int nitems = (K / 64) * (N / 32);
            if (map == 1) { for (int it = gw; it < nitems; it += NGW) transpose_item<1>(W, K, N, WT + dsto, 0, scr, it, lane); }
            else          { for (int it = gw; it < nitems; it += NGW) transpose_item<0>(W, K, N, WT + dsto, roff, scr, it, lane); }
        }
        for (int i = gtid; i < 96 * 1024 / 8; i += GT) *(u32x4*)(WT + WT_B_DQKV + (size_t)672 * 1024 + (size_t)i * 8) = (u32x4){0u, 0u, 0u, 0u};
        __syncthreads();
        LAS float* sc = (LAS float*)ldsl;
        LAS float* part = (LAS float*)(ldsl + 20480);
        for (int i = tid; i < 5 * 1024; i += 512) { const int cnd = i >> 10, k = i & 1023; const float v = cnd < 4 ? INP(2)[cnd * 1024 + k] : INP(9)[k]; sc[i] = v / (1.0f + __expf(-v)); }
        __syncthreads();
        for (int item = bx; item < 4 * 192; item += G) {
            const int l = item / 192, cb = item % 192, col = cb * 32 + (lane & 31), kh = (lane >> 5) * 64; const float* Wl = INP(10) + (size_t)l * 1024 * 6144;
            float a0 = 0.f, a1 = 0.f, a2 = 0.f, a3 = 0.f, a4 = 0.f;
#pragma unroll 8
            for (int kk = 0; kk < 64; ++kk) { const int k = wave * 128 + kh + kk; const float w = Wl[(size_t)k * 6144 + col];
                a0 += sc[k] * w; a1 += sc[1024 + k] * w; a2 += sc[2048 + k] * w; a3 += sc[3072 + k] * w; a4 += sc[4096 + k] * w; }
            a0 += __shfl_xor(a0, 32); a1 += __shfl_xor(a1, 32); a2 += __shfl_xor(a2, 32); a3 += __shfl_xor(a3, 32); a4 += __shfl_xor(a4, 32);
            if (lane < 32) { part[(wave * 5 + 0) * 32 + lane] = a0; part[(wave * 5 + 1) * 32 + lane] = a1; part[(wave * 5 + 2) * 32 + lane] = a2; part[(wave * 5 + 3) * 32 + lane] = a3; part[(wave * 5 + 4) * 32 + lane] = a4; }
            __syncthreads();
            if (tid < 160) { const int cnd = tid >> 5, ln = tid & 31; float s = INP(11)[l * 6144 + cb * 32 + ln];
#pragma unroll
                for (int w8 = 0; w8 < 8; ++w8) s += part[(w8 * 5 + cnd) * 32 + ln];
                mods[((size_t)l * 5 + cnd) * 6144 + cb * 32 + ln] = s; }
            __syncthreads();
        }
    }
    PH_END
    }

    for (int layer = 0; layer < 4; ++layer) {
        const int kind = layer % 3, jj = layer / 3;
        PH_BEGIN
        if constexpr (EN(1))
        for (int rep_ = 0; rep_ < REP_NORM; ++rep_)
        for (int r = gw; r < M_ROWS; r += NGW) { const float* mc = modl + cond_of_row(r) * 6144; const bfu* pr = (G == 256 && layer > 0 && r < NP_ROWS) ? (const bfu*)(ws + WS_P) + (size_t)r * 1024 : nullptr; const float* xi = layer > 0 ? X + (size_t)r * 1024 : (r < NP_ROWS ? INP(0) + (size_t)r * 1024 : INP(1) + (size_t)(r - NP_ROWS) * 1024); norm_row(xi, X + (size_t)r * 1024, pr, ng, mc, mc + 1024, HB + (size_t)r * 1024, lane); }
        if constexpr (EN(1))
        for (int b = 0; b < 4; ++b) {
            const size_t e0 = NP_ROWS + (size_t)b * EXT_B;
            if (kind == 0)      { cvt_rows(INP(3) + (size_t)(b * 2 + jj) * 65536, 256, KB + e0 * 256, 256, 256, 256, gtid, GT); cvt_rows(INP(4) + (size_t)(b * 2 + jj) * 65536, 256, VB + e0 * 256, 256, 256, 256, gtid, GT); }
            else if (kind == 2) { cvt_rows(INP(7) + (size_t)b * 65536, 256, KB + e0 * 256, 256, 256, 256, gtid, GT); cvt_rows(INP(8) + (size_t)b * 65536, 256, VB + e0 * 256, 256, 256, 256, gtid, GT); }
            else                { cvt_rows(INP(5) + (size_t)b * 65536, 256, CKVN + e0 * 256, 256, 256, 256, gtid, GT); cvt_rows(INP(6) + (size_t)b * 8192, 32, KR + e0 * 32, 32, 256, 32, gtid, GT); }
        }
        PH_END
        if (kind == 1) {
            PH_BEGIN
            if constexpr (EN(2)) { EpiF32 E{(bfu*)TB, 1024}; run_gemm(ldsl, HB, WT + WT_B_DQKV, M_ROWS, 768, 1024, E); }
            PH_END
            PH_BEGIN
            if constexpr (EN(3))
            for (int r = gw; r < M_ROWS; r += NGW) {
                const bfu* tr = (const bfu*)TB + (size_t)r * 1024; f32x4 v[3];
#pragma unroll
                for (int k = 0; k < 3; ++k) { const u32x2 w = *(const u32x2*)(tr + 4 * lane + 256 * k); v[k][0] = __uint_as_float(w.x << 16); v[k][1] = __uint_as_float(w.x & 0xffff0000u); v[k][2] = __uint_as_float(w.y << 16); v[k][3] = __uint_as_float(w.y & 0xffff0000u); }
                float sq = (v[0][0] * v[0][0] + v[0][1] * v[0][1]) + (v[0][2] * v[0][2] + v[0][3] * v[0][3]);
                const float s1 = (v[1][0] * v[1][0] + v[1][1] * v[1][1]) + (v[1][2] * v[1][2] + v[1][3] * v[1][3]);
                const float s2 = (v[2][0] * v[2][0] + v[2][1] * v[2][1]) + (v[2][2] * v[2][2] + v[2][3] * v[2][3]);
                float skv = 0.f;
                if (lane < 32) { sq += s1; skv = s2; } else { skv = s1; }
                sq = wave_sum(sq); skv = wave_sum(skv);
                const float rq = 1.0f / sqrtf(sq * (1.0f / 384.0f) + EPS_), rkv = 1.0f / sqrtf(skv * (1.0f / 256.0f) + EPS_);
                const bool sample = r >= NP_ROWS; const int e = ext_of_row(r); const int t = (r - NP_ROWS) & 4095;
                { const f32x4 g = *(const f32x4*)(INP(19) + 4 * lane); const f32x4 y = v[0] * rq * g; u32x2 w; w.x = pkbf(y[0], y[1]); w.y = pkbf(y[2], y[3]); *(u32x2*)(DQN + (size_t)r * 384 + 4 * lane) = w; }
                if (lane < 32) {
                    { const f32x4 g = *(const f32x4*)(INP(19) + 256 + 4 * lane); const f32x4 y = v[1] * rq * g; u32x2 w; w.x = pkbf(y[0], y[1]); w.y = pkbf(y[2], y[3]); *(u32x2*)(DQN + (size_t)r * 384 + 256 + 4 * lane) = w; }
                    { const int c = 128 + 4 * lane; const f32x4 g = *(const f32x4*)(INP(22) + c); const f32x4 y = v[2] * rkv * g; u32x2 w; w.x = pkbf(y[0], y[1]); w.y = pkbf(y[2], y[3]); *(u32x2*)(CKVN + (size_t)e * 256 + c) = w;
                      if (!sample) *(f32x4*)(st_b_ckv + (size_t)r * 256 + c) = y; }
                } else {
                    { const int c = 4 * (lane - 32); const f32x4 g = *(const f32x4*)(INP(22) + c); const f32x4 y = v[1] * rkv * g; u32x2 w; w.x = pkbf(y[0], y[1]); w.y = pkbf(y[2], y[3]); *(u32x2*)(CKVN + (size_t)e * 256 + c) = w;
                      if (!sample) *(f32x4*)(st_b_ckv + (size_t)r * 256 + c) = y; }
                }
                { f32x4 y = v[2]; const int l8 = lane - 32;
                  f32x4 oth; oth[0] = __shfl_xor(y[0], 2); oth[1] = __shfl_xor(y[1], 2); oth[2] = __shfl_xor(y[2], 2); oth[3] = __shfl_xor(y[3], 2);
                  if (lane >= 32 && lane < 40) {
                      if (sample) { const int pos = l8 < 4 ? (t >> 6) : (t & 63); const bool first = (l8 & 2) == 0;
#pragma unroll
                          for (int j = 0; j < 4; ++j) { float c, s; rope_cs(pos, 4 * (l8 & 1) + j, 1.0f / 8.0f, c, s); y[j] = first ? (y[j] * c - oth[j] * s) : (oth[j] * s + y[j] * c); } }
                      else *(f32x4*)(st_b_kr + (size_t)r * 32 + 4 * l8) = y;
                      u32x2 w; w.x = pkbf(y[0], y[1]); w.y = pkbf(y[2], y[3]); *(u32x2*)(KR + (size_t)e * 32 + 4 * l8) = w; } }
            }
            PH_END
            PH_BEGIN
            if constexpr (EN(4)) { EpiUQ E{QB}; run_gemm(ldsl, DQN, WT + WT_B_UQ, M_ROWS, 1536, 384, E); }
            if constexpr (EN(5)) { EpiUKV E{KB, VB}; run_gemm(ldsl, CKVN, WT + WT_B_UKV, EXT_ROWS, 2048, 256, E); }
            PH_END
        } else if (kind == 0) {
            PH_BEGIN
            if constexpr (EN(6)) { EpiQKV<false> E{QB, KB, VB, st_a_k + (size_t)jj * 65536, st_a_v + (size_t)jj * 65536, nullptr, nullptr, 2}; run_gemm(ldsl, HB, WT + WT_A_QKV + (size_t)jj * 1536 * 1024, M_ROWS, 1536, 1024, E); }
            PH_END
        } else {
            PH_BEGIN
            if constexpr (EN(7)) { EpiQKV<true> E{QB, KB, VB, st_c_k, st_c_v, INP(26), INP(27), 1}; run_gemm<EpiQKV<true>, QKV_SP2>(ldsl, HB, WT + WT_C_QKV, M_ROWS, 1536, 1024, E); }
            PH_END
        }
        PH_BEGIN
        for (int rep_ = 0; rep_ < REP_ATT; ++rep_)
        for (int i = 0; i < 5; ++i) {
            const int ui = i * G + vcu; if (ui >= 1280) break;
            att::Unit U; int b, h, qb; bool prompt = ui >= 1024;
            if (!prompt) { if (kind == 1) { qb = ui & 15; h = (ui >> 4) & 15; b = ui >> 8; } else { qb = ui & 15; const int g4 = (ui >> 4) & 3, kvh = (ui >> 6) & 3; b = ui >> 8; h = kvh * 4 + g4; } }
            else { const int u2 = ui - 1024; qb = 0; h = u2 & 15; b = u2 >> 4; if (kind != 1) { h = ((u2 >> 2) & 3) * 4 + (u2 & 3); } }
            const int r0 = prompt ? b * 256 : NP_ROWS + b * 4096 + qb * 256; const size_t ebase = prompt ? (size_t)b * 256 : NP_ROWS + (size_t)b * EXT_B;
            U.O = HB + (size_t)r0 * 1024 + h * 64; U.q0 = qb * 256; U.kstart = 0; U.sinkl2 = -1e30f;
            if (kind == 1) { U.Q = QB + (size_t)r0 * 1536 + h * 96; U.ldq = 1536; U.K = KB + ebase * 1024 + h * 64; U.V = VB + ebase * 1024 + h * 64; U.KR = KR + ebase * 32; U.ldk = 1024;
                U.NT = prompt ? 4 : 68; U.C = 0.10206207261596577f * 1.4426950408889634f; U.thr_raw = 8.0f / 0.10206207261596577f; }
            else { const int kvh = h >> 2; U.Q = QB + (size_t)r0 * 1024 + h * 64; U.ldq = 1024; U.K = KB + ebase * 256 + kvh * 64; U.V = VB + ebase * 256 + kvh * 64; U.KR = nullptr; U.ldk = 256;
                U.NT = prompt ? 4 : 68; U.C = 0.125f * 1.4426950408889634f; U.thr_raw = 64.0f;
                if (kind == 0) { U.sinkl2 = INP(16)[jj * 16 + h] * 1.4426950408889634f;
                    if (!prompt) { const int q0 = qb * 256; const int ks = q0 - 128 < 0 ? 0 : q0 - 128; const int ke = q0 + 384 > 4096 ? 4096 : q0 + 384; U.kstart = ks; U.NT = 4 + (ke - ks) / 64; } } }
            if (kind == 1) { if constexpr (EN(8)) att::attn_unit<96, false>(U, (char*)lds); }
            else if (kind == 0) { if constexpr (EN(9)) att::attn_unit<64, true>(U, (char*)lds); }
            else { if constexpr (EN(10)) att::attn_unit<64, false>(U, (char*)lds); }
        }
        PH_END
        PH_BEGIN
        if constexpr (EN(11)) { const bfu* wo = WT + (kind == 0 ? WT_A_O + (size_t)jj * 1024 * 1024 : kind == 1 ? WT_B_O : WT_C_O); EpiResid E{X, modl + 2048, (bfu*)(ws + WS_P), layer == 0 ? INP(1) - (size_t)NP_ROWS * 1024 : (const float*)X}; run_gemm<EpiResid, G_SP2, true>(ldsl, HB, wo, M_ROWS, 1024, 1024, E); }
        PH_END
        PH_BEGIN
        if constexpr (EN(1))
        for (int rep_ = 0; rep_ < REP_NORM; ++rep_)
        for (int r = gw; r < M_ROWS; r += NGW) { const float* mc = modl + cond_of_row(r) * 6144; const bfu* pr = (G == 256 && r < NP_ROWS) ? (const bfu*)(ws + WS_P) + (size_t)r * 1024 : nullptr; const float* xi = (layer == 0 && r < NP_ROWS) ? INP(0) + (size_t)r * 1024 : X + (size_t)r * 1024; norm_row(xi, X + (size_t)r * 1024, pr, ng + 1024, mc + 3072, mc + 4096, HB + (size_t)r * 1024, lane); }
        PH_END
        PH_BEGIN
        for (int rep_ = 0; rep_ < REP_UP; ++rep_)
        if constexpr (EN(12)) { EpiSqRelu E{HID, DFF}; run_gemm(ldsl, HB, WT + WT_MLP_IN + (size_t)layer * DM * DFF, M_ROWS, DFF, DM, E); }
        PH_END
        PH_BEGIN
        if constexpr (EN(11)) { EpiResid E{X, modl + 5120, (bfu*)(ws + WS_P), (const float*)X}; run_gemm<EpiResid, G_SP2, true>(ldsl, HID, WT + WT_MLP_OUT + (size_t)layer * DM * DFF, M_ROWS, DM, DFF, E); }
        PH_END
    }
    { const int layer = 0;
    PH_BEGIN
    if constexpr (EN(1))
    for (int r = gw; r < M_ROWS; r += NGW) {
        float* xr = X + (size_t)r * 1024; f32x4 v[4]; float s = 0.f;
#pragma unroll
        for (int j = 0; j < 4; ++j) { v[j] = *((const f32x4*)xr + lane + 64 * j);
            if (G == 256 && r < NP_ROWS) { const u32x2* pp = (const u32x2*)((const bfu*)(ws + WS_P) + (size_t)r * 1024) + lane + 64 * j;
#pragma unroll
                for (int q = 0; q < 4; ++q) { const u32x2 w = pp[(size_t)q * 1048576]; v[j][0] += __uint_as_float(w.x << 16); v[j][1] += __uint_as_float(w.x & 0xffff0000u); v[j][2] += __uint_as_float(w.y << 16); v[j][3] += __uint_as_float(w.y & 0xffff0000u); } }
            s += (v[j][0] * v[j][0] + v[j][1] * v[j][1]) + (v[j][2] * v[j][2] + v[j][3] * v[j][3]); }
        const float rstd = 1.0f / sqrtf(wave_sum(s) * (1.0f / 1024.0f) + EPS_);
#pragma unroll
        for (int j = 0; j < 4; ++j) { const f32x4 g = *(const f32x4*)(INP(29) + 4 * lane + 256 * j); *((f32x4*)xr + lane + 64 * j) = v[j] * rstd * g; }
    }
    PH_END
    }
#undef PH_BEGIN
#undef PH_END
}

#ifndef MK_MULTI
#define MK_MULTI 0
#endif
extern "C" void kernel_launch(void* const* d_in, const int* in_sizes, int n_in, void* d_out, int out_size, void* d_ws, size_t ws_size, hipStream_t stream) {
    static int grid = 0;
    if (grid == 0) {
        if (n_in != 30 || ws_size < WS_END) { fprintf(stderr, "kernel_launch: n_in %d ws %zu (need %zu)\n", n_in, ws_size, (size_t)WS_END); grid = -1; return; }
        int dev = 0, cus = 0, per_cu = 0;
        hipGetDevice(&dev); hipDeviceGetAttribute(&cus, hipDeviceAttributeMultiprocessorCount, dev);
        if (hipFuncSetAttribute((const void*)mega_fwd, hipFuncAttributeMaxDynamicSharedMemorySize, LDS_BYTES) != hipSuccess) { fprintf(stderr, "kernel_launch: hipFuncSetAttribute failed\n"); grid = -1; return; }
        hipOccupancyMaxActiveBlocksPerMultiprocessor(&per_cu, (const void*)mega_fwd, 512, LDS_BYTES);
        if (per_cu < 1) { fprintf(stderr, "kernel_launch: occupancy query says %d\n", per_cu); per_cu = 1; }
        (void)hipGetLastError();
        grid = cus * 1;
        if (cus != 256) { fprintf(stderr, "kernel_launch: the phase program is laid out for the 256 CUs of MI355X, got %d\n", cus); grid = -1; return; }
    }
    if (grid < 0) return;
    ArgsH a{};
    for (int i = 0; i < 30; ++i) a.in[i] = (const float*)d_in[i];
    a.out = (float*)d_out; a.ws = (unsigned char*)d_ws;
    if (hipMemsetAsync((char*)d_ws + WS_CTL, 0, 16384, stream) != hipSuccess) { fprintf(stderr, "memset failed\n"); return; }
#if MK_MULTI
    for (int p = 0; p < N_PHASES; ++p) { a.ph_lo = p; a.ph_hi = p + 1; void* kargs[] = {&a}; hipError_t e = hipLaunchKernel((const void*)mega_fwd, dim3(grid), dim3(512), kargs, LDS_BYTES, stream); if (e != hipSuccess) { fprintf(stderr, "launch %d failed: %s\n", p, hipGetErrorString(e)); break; } }
#else
    a.ph_lo = 0; a.ph_hi = N_PHASES;
    void* kargs[] = {&a};
    hipError_t e = hipLaunchCooperativeKernel((const void*)mega_fwd, dim3(grid), dim3(512), kargs, LDS_BYTES, stream);
    if (e != hipSuccess) fprintf(stderr, "cooperative launch failed: %s (grid %d)\n", hipGetErrorString(e), grid);
#endif
}
```
